# Optimizing an MI355X kernel written in HIP

```python
import math
import jax, jax.numpy as jnp
from jax import lax
import numpy as np

D_MODEL = 1024
BATCH = 32
SEQ = 256
DEPTH = 2
DEC_BATCH = 4
DEC_SEQ = 2048
PAST_LEN = 256

F32 = jnp.float32
EPS = 1e-6
GRID_W = 64

HY_WIDTH = 256
HY_ORDER = 2
HY_SHORT = 3
HY_EMB = 33
HY_BANDS = (HY_EMB - 1) // 2
HY_FFN = 64
HY_FAST_DECAY = 0.3
HY_SLOW_DECAY = 1.5
HY_TARGET = 1e-2

MLA_HEADS = 4
MLA_Q_LORA = 256
MLA_KV_LORA = 128
MLA_NOPE = 64
MLA_ROPE = 32
MLA_V = 64
ROPE_BASE = 10000.0
Q_BLOCK = 128

RET_HEADS = 4
RET_DK = 64
RET_DV = 64
RET_CHUNK = 128

CONF_WIDTH = 256
CONF_KERNEL = 31

D_FF = ((8 * D_MODEL // 3 + 255) // 256) * 256

N_BRANCH = 4
HY_COLS = 3 * HY_WIDTH
MLA_COLS = MLA_Q_LORA + MLA_KV_LORA + MLA_ROPE
RET_COLS = 2 * RET_HEADS * RET_DK + 2 * RET_HEADS * RET_DV
CONF_COLS = 2 * CONF_WIDTH
IN_COLS = HY_COLS + MLA_COLS + RET_COLS + CONF_COLS
IN_SPLITS = [HY_COLS, HY_COLS + MLA_COLS, HY_COLS + MLA_COLS + RET_COLS]

kernel_name = 'hybrid_diffusion_prefix_trunk_step'


def rmsnorm(x, g):
    xf = x.astype(F32)
    y = xf * lax.rsqrt(jnp.mean(xf * xf, axis=-1, keepdims=True) + EPS)
    return (y * g.astype(F32)).astype(x.dtype)


def layernorm(x, g=None, b=None):
    xf = x.astype(F32)
    mu = jnp.mean(xf, axis=-1, keepdims=True)
    xc = xf - mu
    y = xc * lax.rsqrt(jnp.mean(xc * xc, axis=-1, keepdims=True) + EPS)
    if g is not None:
        y = y * g.astype(F32) + b.astype(F32)
    return y.astype(x.dtype)


def depthwise_conv(x, w, b):
    K = w.shape[0]
    y = lax.conv_general_dilated(
        x, w[:, None, :].astype(x.dtype), window_strides=(1,),
        padding=[(K // 2, K // 2)], dimension_numbers=('NWC', 'WIO', 'NWC'),
        feature_group_count=x.shape[-1])
    return y + b.astype(x.dtype)


def axial_rope_tables(L):
    rows = L // GRID_W
    row = jnp.repeat(jnp.arange(rows), GRID_W).astype(F32)
    col = jnp.tile(jnp.arange(GRID_W), rows).astype(F32)
    per_axis = MLA_ROPE // 4
    inv = ROPE_BASE ** (-jnp.arange(per_axis, dtype=F32) / per_axis)
    ang = jnp.concatenate([row[:, None] * inv, col[:, None] * inv], axis=-1)
    return jnp.cos(ang), jnp.sin(ang)


def apply_rope(x, cos, sin):
    xf = x.astype(F32)
    h = xf.shape[-1] // 2
    x1, x2 = xf[..., :h], xf[..., h:]
    return jnp.concatenate([x1 * cos - x2 * sin, x1 * sin + x2 * cos], axis=-1).astype(x.dtype)


def hyena_filters(L, w1, b1, w2, b2, w3):
    t = jnp.linspace(0.0, 1.0, L, dtype=F32)[:, None]
    w = 2.0 * math.pi * jnp.arange(L, dtype=F32)[:, None] / L
    f = jnp.linspace(1e-4, HY_BANDS - 1, HY_BANDS, dtype=F32)[None, :]
    z = jnp.concatenate([t, jnp.cos(f * w), -jnp.sin(f * w)], axis=-1)
    h = jnp.sin(z @ w1.astype(F32) + b1.astype(F32))
    h = jnp.sin(h @ w2.astype(F32) + b2.astype(F32))
    h = (h @ w3.astype(F32)).reshape(L, HY_ORDER, 2, HY_WIDTH)
    max_decay = math.log(HY_TARGET) / HY_FAST_DECAY
    min_decay = math.log(HY_TARGET) / HY_SLOW_DECAY
    deltas = jnp.abs(jnp.linspace(min_decay, max_decay, HY_WIDTH, dtype=F32))
    h = h * jnp.exp(-t[:, :, None, None] * deltas)
    return h / jnp.sum(jnp.abs(h), axis=(0, 2), keepdims=True)


def long_conv(v, h_fwd, h_bwd, bias):
    L, C = h_fwd.shape
    k = jnp.concatenate([h_fwd, jnp.zeros((1, C), F32), h_bwd[:0:-1]], axis=0)
    vf = jnp.fft.rfft(v.astype(F32), n=2 * L, axis=1)
    kf = jnp.fft.rfft(k, axis=0)
    y = jnp.fft.irfft(vf * kf[None], n=2 * L, axis=1)[:, :L]
    return (y + v.astype(F32) * bias.astype(F32)).astype(v.dtype)


def hyena_mixer(u, p):
    L = u.shape[1]
    z = depthwise_conv(u, p['hy_conv_w'], p['hy_conv_b'])
    v, x1, x2 = jnp.split(z, 3, axis=-1)
    filt = hyena_filters(L, p['hy_w1'], p['hy_b1'], p['hy_w2'], p['hy_b2'], p['hy_w3'])
    gates = (x1, x2)
    for o in range(HY_ORDER):
        v = gates[o] * long_conv(v, filt[:, o, 0], filt[:, o, 1], p['hy_bias'][o])
    return v


def block_attention(q_nope, q_rope, k_nope, k_rope, v):
    B, L, H, _ = q_nope.shape
    nb = L // Q_BLOCK
    scale = (MLA_NOPE + MLA_ROPE) ** -0.5
    qn = q_nope.reshape(B, nb, Q_BLOCK, H, MLA_NOPE).transpose(1, 0, 2, 3, 4)
    qr = q_rope.reshape(B, nb, Q_BLOCK, H, MLA_ROPE).transpose(1, 0, 2, 3, 4)

    def one_block(args):
        qn_b, qr_b = args
        s = (jnp.einsum('bqhd,bkhd->bhqk', qn_b, k_nope)
             + jnp.einsum('bqhr,bkr->bhqk', qr_b, k_rope))
        pr = jax.nn.softmax(s.astype(F32) * scale, axis=-1)
        return jnp.einsum('bhqk,bkhd->bqhd', pr.astype(v.dtype), v)

    o = lax.map(one_block, (qn, qr))
    return o.transpose(1, 0, 2, 3, 4).reshape(B, L, H * MLA_V)


def retention_scan(q, k, v, log_g, S0):
    B, L, H, _ = q.shape
    n = L // RET_CHUNK
    idx = jnp.arange(RET_CHUNK, dtype=F32)
    diff = idx[:, None] - idx[None, :]
    decay_in = jnp.where(diff >= 0, jnp.exp(jnp.maximum(diff, 0.0)[None] * log_g[:, None, None]), 0.0)
    decay_q = jnp.exp((idx[:, None] + 1.0) * log_g[None, :])
    decay_k = jnp.exp((RET_CHUNK - 1.0 - idx)[:, None] * log_g[None, :])
    decay_c = jnp.exp(RET_CHUNK * log_g)

    def chunk(a):
        return a.reshape(B, n, RET_CHUNK, H, a.shape[-1]).transpose(1, 0, 2, 3, 4)

    def step(S, blk):
        qc, kc, vc = blk
        att = jnp.einsum('bnhd,bmhd->bhnm', qc, kc) * decay_in
        o = (jnp.einsum('bhnm,bmhe->bnhe', att, vc)
             + jnp.einsum('bnhd,bhde->bnhe', qc, S) * decay_q[None, :, :, None])
        S = S * decay_c[None, :, None, None] + jnp.einsum('bmhd,bmhe->bhde', kc * decay_k[None, :, :, None], vc)
        return S, o

    S, o = lax.scan(step, S0, (chunk(q), chunk(k), chunk(v)))
    return o.transpose(1, 0, 2, 3, 4).reshape(B, L, H, v.shape[-1]), S


def retention_mixer(u, decay_logit, S0):
    B, L, _ = u.shape
    qk = RET_HEADS * RET_DK
    vd = RET_HEADS * RET_DV
    q, k, v, g = jnp.split(u, [qk, 2 * qk, 2 * qk + vd], axis=-1)
    q = q.astype(F32).reshape(B, L, RET_HEADS, RET_DK)
    k = k.astype(F32).reshape(B, L, RET_HEADS, RET_DK) * (RET_DK ** -0.5)
    v = v.astype(F32).reshape(B, L, RET_HEADS, RET_DV)
    log_g = jax.nn.log_sigmoid(decay_logit.astype(F32))
    S0 = S0.astype(F32)
    o_f, S_f = retention_scan(q, k, v, log_g[0], S0[:, 0])
    o_b, S_b = retention_scan(q[:, ::-1], k[:, ::-1], v[:, ::-1], log_g[1], S0[:, 1])
    o = layernorm(o_f + o_b[:, ::-1])
    y = jax.nn.silu(g.astype(F32)) * o.reshape(B, L, vd)
    return y.astype(u.dtype), jnp.stack([S_f, S_b], axis=1).astype(u.dtype)


def conformer_mixer(u, p):
    a, b = jnp.split(u, 2, axis=-1)
    z = a * jax.nn.sigmoid(b)
    z = depthwise_conv(z, p['conf_dw_w'], p['conf_dw_b'])
    z = layernorm(z, p['conf_ln_g'], p['conf_ln_b'])
    return jax.nn.silu(z)


def trunk_layer(x, cond, p, ctx_kv=None, ctx_state=None):
    B, L, _ = x.shape
    latent = ctx_kv is not None
    mod = (jax.nn.silu(cond) @ p['ada_w'] + p['ada_b'])[:, None, :]
    sh1, sc1, g1, sh2, sc2, g2 = jnp.split(mod, 6, axis=-1)
    h = rmsnorm(x, p['norm1_g']) * (1 + sc1) + sh1
    proj = h @ p['w_in']
    u_hy, u_mla, u_ret, u_conf = jnp.split(proj, IN_SPLITS, axis=-1)

    y_hy = hyena_mixer(u_hy, p)

    cq, ckv, krope = jnp.split(u_mla, [MLA_Q_LORA, MLA_Q_LORA + MLA_KV_LORA], axis=-1)
    ckv = rmsnorm(ckv, p['mla_kv_norm'])
    q = (rmsnorm(cq, p['mla_q_norm']) @ p['mla_w_uq']).reshape(B, L, MLA_HEADS, MLA_NOPE + MLA_ROPE)
    q_nope, q_rope = q[..., :MLA_NOPE], q[..., MLA_NOPE:]
    if latent:
        cos, sin = axial_rope_tables(L)
        q_rope = apply_rope(q_rope, cos[:, None, :], sin[:, None, :])
        keys_ckv = jnp.concatenate([ckv, ctx_kv[0].astype(ckv.dtype)], axis=1)
        keys_rope = jnp.concatenate([apply_rope(krope, cos, sin), ctx_kv[1].astype(krope.dtype)], axis=1)
    else:
        keys_ckv, keys_rope = ckv, krope
    kv = (keys_ckv @ p['mla_w_ukv']).reshape(B, keys_ckv.shape[1], MLA_HEADS, MLA_NOPE + MLA_V)
    y_mla = block_attention(q_nope, q_rope, kv[..., :MLA_NOPE], keys_rope, kv[..., MLA_NOPE:])

    S0 = ctx_state if latent else jnp.zeros((B, 2, RET_HEADS, RET_DK, RET_DV), F32)
    y_ret, S = retention_mixer(u_ret, p['ret_decay'], S0)

    y_conf = conformer_mixer(u_conf, p)

    gates = jax.nn.sigmoid(h @ p['gate_w'] + p['gate_b'])
    g_hy, g_mla, g_ret, g_conf = jnp.split(gates, N_BRANCH, axis=-1)
    merged = (g_hy * (y_hy @ p['hy_out']) + g_mla * (y_mla @ p['mla_out'])
              + g_ret * (y_ret @ p['ret_out']) + g_conf * (y_conf @ p['conf_out']))
    x = x + g1 * (merged @ p['w_o'])

    h2 = rmsnorm(x, p['norm2_g']) * (1 + sc2) + sh2
    a, b = jnp.split(h2 @ p['ffn_w1'], 2, axis=-1)
    x = x + g2 * ((jax.nn.silu(a) * b) @ p['ffn_w2'])
    return x, ckv, krope, S


def setup_inputs(seed: int = 0) -> dict:
    key = jax.random.key(seed)
    ks = iter(jax.random.split(key, 48))

    def nrm(shape, scale):
        return jax.random.normal(next(ks), shape, F32) * scale

    def gain(shape):
        return 1.0 + nrm(shape, 0.05)

    D = D_MODEL
    pr = 2.0 ** (-5.0 - np.arange(RET_HEADS))
    base = np.log((1.0 - pr) / pr).astype(np.float32)
    ret_decay = jnp.asarray(base)[None, None, :] + nrm((DEPTH, 2, RET_HEADS), 0.1)
    return {
        'x_prompt': nrm((BATCH, SEQ, D), 1.0),
        'x_sample': nrm((DEC_BATCH, DEC_SEQ, D), 1.0),
        'cache_mla_ckv': nrm((DEC_BATCH, DEPTH, PAST_LEN, MLA_KV_LORA), 1.0),
        'cache_mla_krope': nrm((DEC_BATCH, DEPTH, PAST_LEN, MLA_ROPE), 1.0),
        'state_ret': nrm((DEC_BATCH, DEPTH, 2, RET_HEADS, RET_DK, RET_DV), 1.0),
        'c': nrm((DEC_BATCH, D), 1.0),
        'c_ctx': nrm((D,), 1.0),
        'ada_w': nrm((DEPTH, D, 6 * D), 0.5 * D ** -0.5),
        'ada_b': nrm((DEPTH, 6 * D), 0.02),
        'norm1_g': gain((DEPTH, D)),
        'w_in': nrm((DEPTH, D, IN_COLS), D ** -0.5),
        'hy_conv_w': nrm((DEPTH, HY_SHORT, HY_COLS), HY_SHORT ** -0.5),
        'hy_conv_b': nrm((DEPTH, HY_COLS), 0.02),
        'hy_w1': nrm((DEPTH, HY_EMB, HY_FFN), 1.0),
        'hy_b1': nrm((DEPTH, HY_FFN), 0.1),
        'hy_w2': nrm((DEPTH, HY_FFN, HY_FFN), HY_FFN ** -0.5),
        'hy_b2': nrm((DEPTH, HY_FFN), 0.1),
        'hy_w3': nrm((DEPTH, HY_FFN, HY_ORDER * 2 * HY_WIDTH), HY_FFN ** -0.5),
        'hy_bias': nrm((DEPTH, HY_ORDER, HY_WIDTH), 0.5),
        'hy_out': nrm((DEPTH, HY_WIDTH, D), HY_WIDTH ** -0.5),
        'mla_q_norm': gain((DEPTH, MLA_Q_LORA)),
        'mla_w_uq': nrm((DEPTH, MLA_Q_LORA, MLA_HEADS * (MLA_NOPE + MLA_ROPE)), MLA_Q_LORA ** -0.5),
        'mla_kv_norm': gain((DEPTH, MLA_KV_LORA)),
        'mla_w_ukv': nrm((DEPTH, MLA_KV_LORA, MLA_HEADS * (MLA_NOPE + MLA_V)), MLA_KV_LORA ** -0.5),
        'mla_out': nrm((DEPTH, MLA_HEADS * MLA_V, D), (MLA_HEADS * MLA_V) ** -0.5),
        'ret_decay': ret_decay,
        'ret_out': nrm((DEPTH, RET_HEADS * RET_DV, D), (RET_HEADS * RET_DV) ** -0.5),
        'conf_dw_w': nrm((DEPTH, CONF_KERNEL, CONF_WIDTH), CONF_KERNEL ** -0.5),
        'conf_dw_b': nrm((DEPTH, CONF_WIDTH), 0.02),
        'conf_ln_g': gain((DEPTH, CONF_WIDTH)),
        'conf_ln_b': nrm((DEPTH, CONF_WIDTH), 0.02),
        'conf_out': nrm((DEPTH, CONF_WIDTH, D), CONF_WIDTH ** -0.5),
        'gate_w': nrm((DEPTH, D, N_BRANCH * D), D ** -0.5),
        'gate_b': nrm((DEPTH, N_BRANCH * D), 0.02),
        'w_o': nrm((DEPTH, D, D), D ** -0.5),
        'norm2_g': gain((DEPTH, D)),
        'ffn_w1': nrm((DEPTH, D, 2 * D_FF), D ** -0.5),
        'ffn_w2': nrm((DEPTH, D_FF, D), D_FF ** -0.5),
        'final_norm_g': gain((D,)),
    }


def reference(x_prompt, x_sample, cache_mla_ckv, cache_mla_krope, state_ret, c, c_ctx,
              ada_w, ada_b, norm1_g, w_in, hy_conv_w, hy_conv_b, hy_w1, hy_b1, hy_w2, hy_b2,
              hy_w3, hy_bias, hy_out, mla_q_norm, mla_w_uq, mla_kv_norm, mla_w_ukv, mla_out,
              ret_decay, ret_out, conf_dw_w, conf_dw_b, conf_ln_g, conf_ln_b, conf_out,
              gate_w, gate_b, w_o, norm2_g, ffn_w1, ffn_w2, final_norm_g):
    xp, xs = x_prompt, x_sample
    ckvs, kropes, rets = [], [], []
    for l in range(DEPTH):
        p = {
            'ada_w': ada_w[l], 'ada_b': ada_b[l], 'norm1_g': norm1_g[l], 'w_in': w_in[l],
            'hy_conv_w': hy_conv_w[l], 'hy_conv_b': hy_conv_b[l], 'hy_w1': hy_w1[l], 'hy_b1': hy_b1[l],
            'hy_w2': hy_w2[l], 'hy_b2': hy_b2[l], 'hy_w3': hy_w3[l], 'hy_bias': hy_bias[l],
            'hy_out': hy_out[l], 'mla_q_norm': mla_q_norm[l], 'mla_w_uq': mla_w_uq[l],
            'mla_kv_norm': mla_kv_norm[l], 'mla_w_ukv': mla_w_ukv[l], 'mla_out': mla_out[l],
            'ret_decay': ret_decay[l], 'ret_out': ret_out[l], 'conf_dw_w': conf_dw_w[l],
            'conf_dw_b': conf_dw_b[l], 'conf_ln_g': conf_ln_g[l], 'conf_ln_b': conf_ln_b[l],
            'conf_out': conf_out[l], 'gate_w': gate_w[l], 'gate_b': gate_b[l], 'w_o': w_o[l],
            'norm2_g': norm2_g[l], 'ffn_w1': ffn_w1[l], 'ffn_w2': ffn_w2[l],
        }
        xp, ckv_l, krope_l, ret_l = trunk_layer(xp, c_ctx[None, :], p)
        ckvs.append(ckv_l)
        kropes.append(krope_l)
        rets.append(ret_l)
        xs, _, _, _ = trunk_layer(xs, c, p, ctx_kv=(cache_mla_ckv[:, l], cache_mla_krope[:, l]),
                                  ctx_state=state_ret[:, l])
    y_prompt = rmsnorm(xp, final_norm_g)
    y_sample = rmsnorm(xs, final_norm_g)
    new_mla_ckv = jnp.stack(ckvs, axis=1)
    new_mla_krope = jnp.stack(kropes, axis=1)
    new_ret_state = jnp.stack(rets, axis=1)
    return (y_prompt, y_sample, new_mla_ckv, new_mla_krope, new_ret_state)
```

```cpp
#include <hip/hip_runtime.h>
#include <hip/hip_cooperative_groups.h>
#include <cstdio>
namespace cg = cooperative_groups;

#define LAS __attribute__((address_space(3)))
typedef unsigned short bf16_t;
typedef short bf16x8 __attribute__((ext_vector_type(8)));
typedef short bf16x4 __attribute__((ext_vector_type(4)));
typedef float f32x4 __attribute__((ext_vector_type(4)));
typedef float f32x2 __attribute__((ext_vector_type(2)));
typedef float f32x16 __attribute__((ext_vector_type(16)));
typedef unsigned u32x4 __attribute__((ext_vector_type(4)));
typedef unsigned u32x2 __attribute__((ext_vector_type(2)));

constexpr int M = 16384, D = 1024, MC = 8192, NKEY = 17408, DFF = 2816;
constexpr int LDS_BYTES = 131072 + 512;
constexpr int NT = 512;
#ifndef DBG_FFN
#define DBG_FFN 1
#define DBG_WO 1
#define DBG_HYCONV 1
#endif
#ifndef MK_PER_PHASE
#define MK_PER_PHASE 0
#endif
#ifndef DUP_MASK
#define DUP_MASK 0u
#endif
#ifndef EXTRA_BAR
#define EXTRA_BAR 0
#endif
#ifndef DBG_MASK
#define DBG_MASK 0
#define DBG_GATEHALF 0
#endif

constexpr size_t WS_BAR = 0;
constexpr size_t WS_MOD = 16384;
constexpr size_t WS_ROPE = WS_MOD + 245760;
constexpr size_t WS_S0T = WS_ROPE + 262144;
constexpr size_t WS_HP = WS_S0T + 524288;
constexpr size_t WS_RG = WS_HP + 294912;
constexpr size_t RG_LAYER = 4718592;
constexpr size_t WS_W = WS_RG + 2 * RG_LAYER;
constexpr size_t W_PROJ = 0, W_GATE = W_PROJ + 5767168, W_O = W_GATE + 8388608, W_1 = W_O + 2097152, W_2 = W_1 + 11534336,
                 W_BOUT = W_2 + 5767168, W_UQ = W_BOUT + 2097152, W_UK = W_UQ + 262144, W_UV = W_UK + 131072, W_TOTAL = W_UV + 131072;
constexpr size_t WS_HB = WS_W + W_TOTAL;
constexpr size_t WS_YB = WS_HB + 33554432;
constexpr size_t WS_AR = WS_YB + 33554432;
constexpr size_t A_UHY = 0, A_UMLA = A_UHY + 25165824, A_UCONF = A_UMLA + 13631488, A_URET = A_UCONF + 16777216,
                 A_ZT = A_URET + 33554432, A_CQN = A_ZT + 25165824, A_CKN = A_CQN + 8388608, A_KR = A_CKN + 8912896,
                 A_RVT = A_KR + 1114112, A_END = A_RVT + 8388608;
constexpr size_t A_Q = 0, A_KN = A_Q + 12582912, A_VT = A_KN + 8912896;
constexpr size_t A_GT = 0, A_ACT = 0, A_HRAW = 0;
constexpr size_t WS_NEED = WS_AR + A_END;
static_assert(A_VT + 8912896 <= A_UCONF, "alias");
static_assert(WS_NEED <= 268435456ull, "ws");

struct Params { const float* in[39]; float* out; unsigned char* ws; int ph_lo, ph_hi; };

__device__ __forceinline__ unsigned cvt_pk_bf16(float lo, float hi) { unsigned r; asm("v_cvt_pk_bf16_f32 %0, %1, %2" : "=v"(r) : "v"(lo), "v"(hi)); return r; }
__device__ __forceinline__ bf16_t f2bf(float f) { return (bf16_t)(cvt_pk_bf16(f, 0.f) & 0xffffu); }
__device__ __forceinline__ float bf2f(bf16_t b) { return __uint_as_float(((unsigned)b) << 16); }
__device__ __forceinline__ float bflo(unsigned w) { return __uint_as_float(w << 16); }
__device__ __forceinline__ float bfhi(unsigned w) { return __uint_as_float(w & 0xffff0000u); }
__device__ __forceinline__ float sigmoidf_(float x) { return __builtin_amdgcn_rcpf(1.0f + __expf(-x)); }
__device__ __forceinline__ int lane_id_v() { int l; asm volatile("v_mbcnt_lo_u32_b32 %0, -1, 0\n\tv_mbcnt_hi_u32_b32 %0, -1, %0" : "=v"(l)); return l; }
__device__ __forceinline__ float shx(float v, int mask, int lane) { return __int_as_float(__builtin_amdgcn_ds_bpermute((lane ^ mask) << 2, __float_as_int(v))); }
__device__ __forceinline__ float wave_sum_l(float v, int lane) {
#pragma unroll
    for (int o = 32; o >= 1; o >>= 1) v += shx(v, o, lane);
    return v;
}
__device__ __forceinline__ int midx_of_row(int row) { return row < MC ? 0 : 1 + ((row - MC) >> 11); }

namespace pg8 {
constexpr int BM = 256, BK = 64, HALF = 128, HTB = HALF * BK * 2, STAGE_BYTES = 8 * HTB, NXCD = 8, WGM = 8;
__host__ __device__ __forceinline__ int lds_byte(int r, int c) { const int st = (r >> 4) * 2 + (c >> 5), rr = r & 15, cc = c & 31, ob = rr * 64 + cc * 2; return st * 1024 + (ob ^ (((ob >> 9) & 1) << 5)); }
__host__ __device__ __forceinline__ void stage_rc(int b, int& R, int& C) { const int st = b / 1024, sb = b % 1024, swz = sb ^ (((sb >> 9) & 1) << 5); R = (st >> 1) * 16 + swz / 64; C = (st & 1) * 32 + (swz % 64) / 2; }
__host__ __device__ __forceinline__ int perm32(int rho) { const int n = rho >> 4, i = rho & 15; return 8 * (i >> 2) + 4 * n + (i & 3); }
struct Unit { int pm, pn; };
struct Gemm { const bf16_t* A; const bf16_t* Bt; int M, N, K; };
struct StaticOrder {
    int nM, nN, nwg, G, c;
    __device__ void init(int M_, int N_, int G_, int c_) { nM = M_ / BM; nN = N_ / BM; nwg = nM * nN; G = G_; c = c_; }
    __device__ bool next(int i, Unit& u) const {
        const long L = (long)i * G + c; if (L >= nwg) return false;
        int wgid = (int)L; { const int q = nwg / NXCD, r = nwg % NXCD, xcd = wgid % NXCD, off = wgid / NXCD; wgid = (xcd < r ? xcd * (q + 1) : r * (q + 1) + (xcd - r) * q) + off; }
        const int nig = WGM * nN, gid = wgid / nig, fm = gid * WGM, gsz = (nM - fm) < WGM ? (nM - fm) : WGM;
        u.pm = fm + ((wgid % nig) % gsz); u.pn = (wgid % nig) / gsz; return true;
    }
};

template <class Epi>
__device__ __forceinline__ void gemm_phase(LAS unsigned char* lds, const Gemm g, const StaticOrder& S, const Epi& E, int wid_in) {
    int ln_ = lane_id_v(); int w_ = wid_in; asm volatile("" : "+s"(w_));
    const int wid = w_, lane = ln_, tid = wid * 64 + lane, wr = wid >> 2, wc = wid & 3, fr = lane & 15, fq = lane >> 4;
    const int K = g.K, nt = K / BK;
    unsigned voffA[2], voffB[2];
#pragma unroll
    for (int i = 0; i < 2; ++i) { int R, C; stage_rc(tid * 16 + i * 8192, R, C); const int Rb = Epi::PERM ? ((R & ~31) + perm32(R & 31)) : R;
        voffA[i] = (unsigned)(R * K + C) * 2u; voffB[i] = (unsigned)(Rb * K + C) * 2u; }
    const size_t kstep = (size_t)(BK * 2);
    const size_t hstep = (size_t)HALF * K * 2;
    const size_t tstep = 2 * hstep;
    const unsigned ldsw = (unsigned)wid * 1024u;
    const int aoff = lds_byte(wr * 64 + fr, fq * 8), boff = lds_byte(wc * 32 + fr, fq * 8);
#define PG8_SA(b, h) (((b) * 2 + (h)) * HTB)
#define PG8_SB(b, h) ((4 + (b) * 2 + (h)) * HTB)
#define PG8_STAGE(bufoff, gbase, voff) do { _Pragma("unroll") for (int _i = 0; _i < 2; ++_i) \
        __builtin_amdgcn_global_load_lds((const unsigned*)((const char*)(gbase) + (voff)[_i]), (LAS unsigned*)(lds + (bufoff) + ldsw + _i * 8192), 16, 0, 0); } while (0)
#define PG8_LDA(dst, b, h) do { _Pragma("unroll") for (int m = 0; m < 4; ++m) _Pragma("unroll") for (int k = 0; k < 2; ++k) dst[m][k] = *(const LAS bf16x8*)(lds + PG8_SA(b, h) + aoff + m * 2048 + k * 1024); } while (0)
#define PG8_LDB(dst, b, h) do { _Pragma("unroll") for (int n = 0; n < 2; ++n) _Pragma("unroll") for (int k = 0; k < 2; ++k) dst[n][k] = *(const LAS bf16x8*)(lds + PG8_SB(b, h) + boff + n * 2048 + k * 1024); } while (0)
#define PG8_MMA(ai, bj, At, Bt) do { __builtin_amdgcn_s_setprio(1); _Pragma("unroll") for (int m = 0; m < 4; ++m) _Pragma("unroll") for (int n = 0; n < 2; ++n) _Pragma("unroll") for (int k = 0; k < 2; ++k) \
        acc[ai][bj][m][n] = __builtin_amdgcn_mfma_f32_16x16x32_bf16(Bt[n][k], At[m][k], acc[ai][bj][m][n], 0, 0, 0); __builtin_amdgcn_s_setprio(0); } while (0)
#define PG8_WAIT_V(n) asm volatile("s_waitcnt vmcnt(" #n ")" ::: "memory")
#define PG8_WAIT_L(n) asm volatile("s_waitcnt lgkmcnt(" #n ")" ::: "memory")
#define PG8_BAR __builtin_amdgcn_s_barrier()
#define PG8_SCHED __builtin_amdgcn_sched_barrier(0)
    Unit cur, nxt; int ui = 0;
    if (!S.next(0, cur)) return;
    f32x4 acc[2][2][4][2];
#pragma unroll
    for (int a = 0; a < 2; ++a)
#pragma unroll
        for (int b = 0; b < 2; ++b)
#pragma unroll
            for (int m = 0; m < 4; ++m)
#pragma unroll
                for (int n = 0; n < 2; ++n) acc[a][b][m][n] = (f32x4){0.f, 0.f, 0.f, 0.f};
    bf16x8 At[4][2], B0[2][2], B1[2][2];
    const char* cA = (const char*)g.A + (size_t)cur.pm * tstep; const char* cB = (const char*)g.Bt + (size_t)cur.pn * tstep;
    PG8_STAGE(PG8_SB(0, 0), cB, voffB); PG8_STAGE(PG8_SA(0, 0), cA, voffA); PG8_STAGE(PG8_SB(0, 1), cB + hstep, voffB); PG8_STAGE(PG8_SA(0, 1), cA + hstep, voffA);
    if (wr == 1) PG8_BAR;
    PG8_WAIT_V(4); PG8_BAR;
    PG8_STAGE(PG8_SB(1, 0), cB + kstep, voffB); PG8_STAGE(PG8_SA(1, 0), cA + kstep, voffA); PG8_STAGE(PG8_SB(1, 1), cB + hstep + kstep, voffB);
    PG8_WAIT_V(6); PG8_BAR;
    for (;;) {
        const bool has_next = S.next(ui + 1, nxt);
        const char* nA = has_next ? (const char*)g.A + (size_t)nxt.pm * tstep : cA; const char* nB = has_next ? (const char*)g.Bt + (size_t)nxt.pn * tstep : cB;
        for (int t = 0; t < nt; t += 2) {
            const bool last = (t == nt - 2);
            const char* a1 = cA + (size_t)(t + 1) * kstep;
            const char* a2 = last ? nA : cA + (size_t)(t + 2) * kstep; const char* b2 = last ? nB : cB + (size_t)(t + 2) * kstep;
            const char* a3 = a2 + kstep; const char* b3 = b2 + kstep;
            PG8_LDB(B0, 0, 0); PG8_SCHED; PG8_LDA(At, 0, 0); PG8_STAGE(PG8_SA(1, 1), a1 + hstep, voffA);
            PG8_WAIT_L(8); PG8_BAR; PG8_WAIT_L(0); PG8_MMA(0, 0, At, B0); PG8_BAR; PG8_SCHED;
            PG8_LDB(B1, 0, 1); PG8_STAGE(PG8_SB(0, 0), b2, voffB);
            PG8_BAR; PG8_WAIT_L(0); PG8_MMA(0, 1, At, B1); PG8_BAR;
            PG8_LDA(At, 0, 1); PG8_STAGE(PG8_SA(0, 0), a2, voffA);
            PG8_BAR; PG8_WAIT_L(0); PG8_MMA(1, 0, At, B0); PG8_BAR; PG8_SCHED;
            PG8_STAGE(PG8_SB(0, 1), b2 + hstep, voffB);
            PG8_WAIT_V(6); PG8_BAR; PG8_MMA(1, 1, At, B1); PG8_BAR;
            PG8_LDB(B0, 1, 0); PG8_SCHED; PG8_LDA(At, 1, 0); PG8_STAGE(PG8_SA(0, 1), a2 + hstep, voffA);
            PG8_WAIT_L(8); PG8_BAR; PG8_WAIT_L(0); PG8_MMA(0, 0, At, B0); PG8_BAR; PG8_SCHED;
            PG8_LDB(B1, 1, 1); PG8_STAGE(PG8_SB(1, 0), b3, voffB);
            PG8_BAR; PG8_WAIT_L(0); PG8_MMA(0, 1, At, B1); PG8_BAR;
            PG8_LDA(At, 1, 1); PG8_STAGE(PG8_SA(1, 0), a3, voffA);
            PG8_BAR; PG8_WAIT_L(0); PG8_MMA(1, 0, At, B0); PG8_BAR; PG8_SCHED;
            PG8_STAGE(PG8_SB(1, 1), b3 + hstep, voffB);
            PG8_WAIT_V(6); PG8_BAR; PG8_MMA(1, 1, At, B1); PG8_BAR;
        }
        { const int ln2 = lane_id_v(); E(acc, cur, wr, wc, ln2 & 15, ln2 >> 4); }
        if (!has_next) break;
#pragma unroll
        for (int a = 0; a < 2; ++a)
#pragma unroll
            for (int b = 0; b < 2; ++b)
#pragma unroll
                for (int m = 0; m < 4; ++m)
#pragma unroll
                    for (int n = 0; n < 2; ++n) acc[a][b][m][n] = (f32x4){0.f, 0.f, 0.f, 0.f};
        cur = nxt; cA = nA; cB = nB; ++ui;
    }
    PG8_WAIT_V(0);
    if (wr == 0) PG8_BAR;
    PG8_BAR;
#undef PG8_SA
#undef PG8_SB
#undef PG8_STAGE
#undef PG8_LDA
#undef PG8_LDB
#undef PG8_MMA
#undef PG8_WAIT_V
#undef PG8_WAIT_L
#undef PG8_BAR
#undef PG8_SCHED
}

typedef f32x4 Acc[2][2][4][2];

struct EpiProj {
    static constexpr bool PERM = true;
    bf16_t *uhy, *umla, *uret, *uconf;
    __device__ __forceinline__ void operator()(const Acc& acc, const Unit& u, int wr, int wc, int fr, int fq) const {
        const int row0 = u.pm * BM + wr * 64 + fr;
#pragma unroll
        for (int bj = 0; bj < 2; ++bj) {
            const int c0 = u.pn * BM + bj * HALF + wc * 32 + 8 * fq;
            bf16_t* p; int pitch;
            if (c0 < 768) { p = uhy + c0; pitch = 768; }
            else if (c0 < 1184) { p = umla + (c0 - 768); pitch = 416; }
            else if (c0 < 2208) { p = uret + (c0 - 1184); pitch = 1024; }
            else if (c0 < 2720) { p = uconf + (c0 - 2208); pitch = 512; }
            else continue;
#pragma unroll
            for (int ai = 0; ai < 2; ++ai)
#pragma unroll
                for (int m = 0; m < 4; ++m) {
                    const f32x4 v0 = acc[ai][bj][m][0], v1 = acc[ai][bj][m][1];
                    u32x4 w; w.x = cvt_pk_bf16(v0[0], v0[1]); w.y = cvt_pk_bf16(v0[2], v0[3]); w.z = cvt_pk_bf16(v1[0], v1[1]); w.w = cvt_pk_bf16(v1[2], v1[3]);
                    *(u32x4*)(p + (size_t)(row0 + ai * HALF + m * 16) * pitch) = w;
                }
        }
    }
};
struct EpiGate {
    static constexpr bool PERM = true;
    unsigned char* O; int ldc;
    __device__ __forceinline__ void operator()(const Acc& acc, const Unit& u, int wr, int wc, int fr, int fq) const {
        const int row0 = u.pm * BM + wr * 64 + fr;
#pragma unroll
        for (int bj = 0; bj < 2; ++bj) {
            const int c0 = u.pn * BM + bj * HALF + wc * 32 + 8 * fq;
#pragma unroll
            for (int ai = 0; ai < 2; ++ai)
#pragma unroll
                for (int m = 0; m < 4; ++m) {
                    f32x4 v0 = acc[ai][bj][m][0], v1 = acc[ai][bj][m][1];
#pragma unroll
                    for (int j = 0; j < 4; ++j) { v0[j] = fminf(fmaxf(v0[j], -240.f), 240.f); v1[j] = fminf(fmaxf(v1[j], -240.f), 240.f); }
                    int w0 = 0, w1 = 0;
                    w0 = __builtin_amdgcn_cvt_pk_fp8_f32(v0[0], v0[1], w0, false); w0 = __builtin_amdgcn_cvt_pk_fp8_f32(v0[2], v0[3], w0, true);
                    w1 = __builtin_amdgcn_cvt_pk_fp8_f32(v1[0], v1[1], w1, false); w1 = __builtin_amdgcn_cvt_pk_fp8_f32(v1[2], v1[3], w1, true);
                    *(u32x2*)(O + (size_t)(row0 + ai * HALF + m * 16) * ldc + c0) = (u32x2){(unsigned)w0, (unsigned)w1};
                }
        }
    }
};
struct EpiPlain {
    static constexpr bool PERM = false;
    bf16_t* O; int ldc; int ncols;
    __device__ __forceinline__ void operator()(const Acc& acc, const Unit& u, int wr, int wc, int fr, int fq) const {
        const int row0 = u.pm * BM + wr * 64 + fr;
#pragma unroll
        for (int bj = 0; bj < 2; ++bj) {
            const int c0 = u.pn * BM + bj * HALF + wc * 32 + 4 * fq;
            if (c0 >= ncols) continue;
#pragma unroll
            for (int ai = 0; ai < 2; ++ai)
#pragma unroll
                for (int m = 0; m < 4; ++m) {
                    bf16_t* p = O + (size_t)(row0 + ai * HALF + m * 16) * ldc + c0;
#pragma unroll
                    for (int n = 0; n < 2; ++n) { const f32x4 v = acc[ai][bj][m][n]; u32x2 w; w.x = cvt_pk_bf16(v[0], v[1]); w.y = cvt_pk_bf16(v[2], v[3]); *(u32x2*)(p + 16 * n) = w; }
                }
        }
    }
};
struct EpiFfn1 {
    static constexpr bool PERM = true;
    bf16_t* O;
    __device__ __forceinline__ void operator()(const Acc& acc, const Unit& u, int wr, int wc, int fr, int fq) const {
        const int row0 = u.pm * BM + wr * 64 + fr;
#pragma unroll
        for (int bj = 0; bj < 2; ++bj) {
            const int c0 = (u.pn * BM + bj * HALF + wc * 32 + 8 * fq) >> 1;
#pragma unroll
            for (int ai = 0; ai < 2; ++ai)
#pragma unroll
                for (int m = 0; m < 4; ++m) {
                    const f32x4 a = acc[ai][bj][m][0], b = acc[ai][bj][m][1];
                    float o[4];
#pragma unroll
                    for (int j = 0; j < 4; ++j) o[j] = a[j] * sigmoidf_(a[j]) * b[j];
                    u32x2 w; w.x = cvt_pk_bf16(o[0], o[1]); w.y = cvt_pk_bf16(o[2], o[3]);
                    *(u32x2*)(O + (size_t)(row0 + ai * HALF + m * 16) * DFF + c0) = w;
                }
        }
    }
};
struct EpiResid {
    static constexpr bool PERM = false;
    bf16_t* X; const float* gmod;
    __device__ __forceinline__ void operator()(const Acc& acc, const Unit& u, int wr, int wc, int fr, int fq) const {
        const int row0 = u.pm * BM + wr * 64 + fr, col0 = u.pn * BM + wc * 32 + 4 * fq;
        const float* gp = gmod + (size_t)midx_of_row(u.pm * BM) * 6144;
        f32x4 gv[2][2];
#pragma unroll
        for (int bj = 0; bj < 2; ++bj)
#pragma unroll
            for (int n = 0; n < 2; ++n) gv[bj][n] = *(const f32x4*)(gp + col0 + bj * HALF + n * 16);
#pragma unroll
        for (int ai = 0; ai < 2; ++ai) {
            u32x2 xw[4][2][2];
#pragma unroll
            for (int m = 0; m < 4; ++m)
#pragma unroll
                for (int bj = 0; bj < 2; ++bj)
#pragma unroll
                    for (int n = 0; n < 2; ++n) xw[m][bj][n] = *(const u32x2*)(X + (size_t)(row0 + ai * HALF + m * 16) * D + col0 + bj * HALF + n * 16);
#pragma unroll
            for (int m = 0; m < 4; ++m)
#pragma unroll
                for (int bj = 0; bj < 2; ++bj)
#pragma unroll
                    for (int n = 0; n < 2; ++n) { const u32x2 w = xw[m][bj][n];
                        const f32x4 xv = (f32x4){bflo(w.x), bfhi(w.x), bflo(w.y), bfhi(w.y)} + gv[bj][n] * acc[ai][bj][m][n];
                        u32x2 o; o.x = cvt_pk_bf16(xv[0], xv[1]); o.y = cvt_pk_bf16(xv[2], xv[3]);
                        *(u32x2*)(X + (size_t)(row0 + ai * HALF + m * 16) * D + col0 + bj * HALF + n * 16) = o; }
        }
    }
};
}

struct Ctx {
    const LAS unsigned* tab; float* out; unsigned char* ws; LAS unsigned char* ldsL; unsigned char* lds; int tid, lane, wid, bid, G;
};
__device__ __forceinline__ const float* tab_ptr(const LAS unsigned* tab, int i) { unsigned lo = tab[2 * i], hi = tab[2 * i + 1]; lo = __builtin_amdgcn_readfirstlane(lo); hi = __builtin_amdgcn_readfirstlane(hi); return (const float*)(((unsigned long long)hi << 32) | lo); }
#define INF(i) tab_ptr(C.tab, (i))
__device__ __forceinline__ int launder_s(int v0) { int v = __builtin_amdgcn_readfirstlane(v0); asm volatile("" : "+s"(v)); return v; }
__device__ __forceinline__ int uni(int v) { return __builtin_amdgcn_readfirstlane(v); }
__device__ __forceinline__ Ctx launder(const Ctx& C0) { Ctx C = C0; int ln = lane_id_v(); int w = uni(C0.wid); asm volatile("" : "+s"(w)); C.lane = ln; C.wid = w; C.tid = w * 64 + ln;
    unsigned long long pw = (unsigned long long)C0.ws; unsigned plo = (unsigned)uni((int)(unsigned)pw), phi = (unsigned)uni((int)(unsigned)(pw >> 32)); asm volatile("" : "+s"(plo), "+s"(phi)); C.ws = (unsigned char*)(((unsigned long long)phi << 32) | plo);
    int b = uni(C0.bid), g = uni(C0.G); asm volatile("" : "+s"(b), "+s"(g)); C.bid = b; C.G = g;
    unsigned tb = (unsigned)uni((int)(unsigned)(unsigned long long)C0.tab); asm volatile("" : "+s"(tb)); C.tab = (const LAS unsigned*)(unsigned long long)tb; return C; }

__device__ __forceinline__ void p0_mod(const Ctx& C0) { const Ctx C = launder(C0); const float* in5 = INF(5); const float* in6 = INF(6); const float* in7 = INF(7); const float* in8 = INF(8);
    float* scond = (float*)C.lds;
    float* part = scond + 5 * 1024;
    float* MOD = (float*)(C.ws + WS_MOD);
    bool have = false;
    for (int task = C.bid; task < 192; task += C.G) {
        if (!have) {
            for (int i = C.tid; i < 5 * 1024; i += NT) { const int m = i >> 10, k = i & 1023; const float x = (m == 0) ? in6[k] : in5[(m - 1) * 1024 + k]; scond[i] = x * sigmoidf_(x); }
            have = true; __syncthreads();
        }
        const int l = task / 96, j0 = (task % 96) * 64;
        const float* aw = in7 + (size_t)l * 1024 * 6144 + j0 + C.lane;
        float a[5] = {0.f, 0.f, 0.f, 0.f, 0.f};
        const int k0 = C.wid * 128;
#pragma unroll 8
        for (int k = 0; k < 128; ++k) { const float w = aw[(size_t)(k0 + k) * 6144];
#pragma unroll
            for (int m = 0; m < 5; ++m) a[m] += scond[m * 1024 + k0 + k] * w; }
#pragma unroll
        for (int m = 0; m < 5; ++m) part[(C.wid * 5 + m) * 64 + C.lane] = a[m];
        __syncthreads();
        if (C.tid < 320) { const int m = C.tid >> 6, j = C.tid & 63; float s = in8[l * 6144 + j0 + j];
#pragma unroll
            for (int w = 0; w < 8; ++w) s += part[(w * 5 + m) * 64 + j];
            MOD[((size_t)l * 5 + m) * 6144 + j0 + j] = s; }
        __syncthreads();
    }
    __syncthreads();
}

__device__ __forceinline__ void p0_filters(const Ctx& C0) { const Ctx C = launder(C0); const float* in13 = INF(13); const float* in14 = INF(14); const float* in15 = INF(15); const float* in16 = INF(16); const float* in17 = INF(17);
    float* zs = (float*)C.lds;
    float* h1s = zs + 8 * 4 * 64;
    float* h2s = h1s + 8 * 4 * 64;
    float* red = h2s + 8 * 4 * 64;
    float* HR = (float*)(C.ws + WS_AR + A_HRAW);
    float* HP = (float*)(C.ws + WS_HP);
    for (int task = (C.bid + 64) % C.G; task < 144; task += C.G) {
        const int l = task / 72, ch = task % 72, Lsel = ch < 8 ? 0 : 1, chunk = Lsel ? ch - 8 : ch, L = Lsel ? 2048 : 256;
        const int tb = chunk * 32 + C.wid * 4;
        float* zw = zs + C.wid * 256; float* h1w = h1s + C.wid * 256; float* h2w = h2s + C.wid * 256;
        if (C.lane < 33) {
#pragma unroll
            for (int tt = 0; tt < 4; ++tt) {
                const int t = tb + tt; const float w = (6.2831855f * (float)t) / (float)L;
                float z;
                if (C.lane == 0) z = (float)t / (float)(L - 1);
                else { const int bi = (C.lane - 1) & 15; const float f = 1e-4f + (float)bi * ((15.0f - 1e-4f) / 15.0f); const float a = f * w; z = (C.lane <= 16) ? cosf(a) : -sinf(a); }
                zw[tt * 64 + C.lane] = z;
            }
        }
        __builtin_amdgcn_wave_barrier();
        { float a[4]; const float b = in14[l * 64 + C.lane];
#pragma unroll
          for (int tt = 0; tt < 4; ++tt) a[tt] = b;
#pragma unroll 3
          for (int k = 0; k < 33; ++k) { const float w = in13[(l * 33 + k) * 64 + C.lane];
#pragma unroll
              for (int tt = 0; tt < 4; ++tt) a[tt] += zw[tt * 64 + k] * w; }
#pragma unroll
          for (int tt = 0; tt < 4; ++tt) h1w[tt * 64 + C.lane] = sinf(a[tt]); }
        __builtin_amdgcn_wave_barrier();
        { float a[4]; const float b = in16[l * 64 + C.lane];
#pragma unroll
          for (int tt = 0; tt < 4; ++tt) a[tt] = b;
#pragma unroll 4
          for (int k = 0; k < 64; ++k) { const float w = in15[(l * 64 + k) * 64 + C.lane];
#pragma unroll
              for (int tt = 0; tt < 4; ++tt) a[tt] += h1w[tt * 64 + k] * w; }
#pragma unroll
          for (int tt = 0; tt < 4; ++tt) h2w[tt * 64 + C.lane] = sinf(a[tt]); }
        __builtin_amdgcn_wave_barrier();
        const float* w3 = in17 + (size_t)l * 64 * 1024;
        float* hr = HR + ((size_t)l * 2304 + (Lsel ? 256 : 0)) * 1024;
#pragma unroll 1
        for (int q = 0; q < 8; ++q) {
            float psum = 0.f;
#pragma unroll 1
            for (int dir = 0; dir < 2; ++dir) {
                float a[4] = {0.f, 0.f, 0.f, 0.f};
                const int col = C.lane + 64 * ((q >> 2) * 8 + dir * 4 + (q & 3));
#pragma unroll 8
                for (int k = 0; k < 64; ++k) { const float w = w3[k * 1024 + col];
#pragma unroll
                    for (int tt = 0; tt < 4; ++tt) a[tt] += h2w[tt * 64 + k] * w; }
                const int c = col & 255;
                const float delta = fabsf(-3.0701134573f + (float)c * ((-15.3505672866f + 3.0701134573f) / 255.0f));
#pragma unroll
                for (int tt = 0; tt < 4; ++tt) {
                    const int t = tb + tt; const float tl = (float)t / (float)(L - 1);
                    const float v = a[tt] * __expf(-tl * delta);
                    hr[(size_t)t * 1024 + col] = v;
                    psum += fabsf(v);
                }
            }
            red[(C.wid * 8 + q) * 64 + C.lane] = psum;
        }
        __syncthreads();
        { const int o = C.tid >> 8, c = C.tid & 255, r4 = c >> 6, ln = c & 63; float s = 0.f;
#pragma unroll
          for (int w = 0; w < 8; ++w) s += red[(w * 8 + o * 4 + r4) * 64 + ln];
          HP[((size_t)l * 72 + ch) * 512 + C.tid] = s; }
        __syncthreads();
    }
    __syncthreads();
}

__device__ __forceinline__ void p0_misc(const Ctx& C0) { const Ctx C = launder(C0); const float* in4 = INF(4);
    float* rope = (float*)(C.ws + WS_ROPE);
    const int gt = C.bid * NT + C.tid, gs = C.G * NT;
    for (int i = gt; i < 32768; i += gs) {
        const int t = i >> 4, k = i & 15; const int pos = (k < 8) ? (t >> 6) : (t & 63);
        const float inv = powf(10000.0f, -(float)(k & 7) / 8.0f);
        const float a = (float)pos * inv;
        rope[i] = cosf(a); rope[32768 + i] = sinf(a);
    }
    bf16_t* s0t = (bf16_t*)(C.ws + WS_S0T);
    for (int i = gt; i < 64 * 4096; i += gs) { const int mat = i >> 12, dv = (i >> 6) & 63, dk = i & 63; s0t[i] = f2bf(in4[mat * 4096 + dk * 64 + dv]); }
}

__device__ __forceinline__ void conv_tile(const float* src, int ld, int kvalid, int k0, int colsrc  , bf16_t* dstrow  , float scale) {
    float vv[64];
    const int cs = colsrc < 0 ? 0 : colsrc;
#pragma unroll
    for (int j = 0; j < 64; ++j) { const int k = k0 + j, kc = k < kvalid ? k : kvalid - 1; vv[j] = src[(size_t)kc * ld + cs]; }
    unsigned w[32];
#pragma unroll
    for (int j = 0; j < 32; ++j) {
        const float a = (colsrc >= 0 && k0 + 2 * j < kvalid) ? vv[2 * j] : 0.f, b = (colsrc >= 0 && k0 + 2 * j + 1 < kvalid) ? vv[2 * j + 1] : 0.f;
        w[j] = cvt_pk_bf16(a * scale, b * scale);
    }
#pragma unroll
    for (int j = 0; j < 8; ++j) { u32x4 v; v.x = w[4 * j]; v.y = w[4 * j + 1]; v.z = w[4 * j + 2]; v.w = w[4 * j + 3]; *(u32x4*)(dstrow + 8 * j) = v; }
}
__device__ __forceinline__ void convert_weights(const Ctx& C0, int l0) { const int l = launder_s(l0); const Ctx C = launder(C0);
    unsigned char* W = C.ws + WS_W;
    constexpr int T0 = 704, T1 = T0 + 1024, T2 = T1 + 256, T3 = T2 + 1408, T4 = T3 + 704, T5 = T4 + 256, T6 = T5 + 32, T7 = T6 + 16, T8 = T7 + 16;
    for (int t = C.bid * 8 + C.wid; t < T8; t += C.G * 8) {
        const float* src; int ld, kvalid, k0, col; bf16_t* dst; float scale = 1.0f;
        if (t < T0) { const int nt = t % 44, kt = t / 44, n = nt * 64 + C.lane; src = INF(10) + (size_t)l * 1024 * 2720; ld = 2720; kvalid = 1024; k0 = kt * 64; col = n < 2720 ? n : -1; dst = (bf16_t*)(W + W_PROJ) + (size_t)n * 1024 + k0; }
        else if (t < T1) { const int u = t - T0, nt = u % 64, kt = u / 64, n = nt * 64 + C.lane; src = INF(32) + (size_t)l * 1024 * 4096; ld = 4096; kvalid = 1024; k0 = kt * 64; col = n; dst = (bf16_t*)(W + W_GATE) + (size_t)n * 1024 + k0; }
        else if (t < T2) { const int u = t - T1, nt = u % 16, kt = u / 16, n = nt * 64 + C.lane; src = INF(34) + (size_t)l * 1024 * 1024; ld = 1024; kvalid = 1024; k0 = kt * 64; col = n; dst = (bf16_t*)(W + W_O) + (size_t)n * 1024 + k0; }
        else if (t < T3) { const int u = t - T2, nt = u % 88, kt = u / 88, n = nt * 64 + C.lane; src = INF(36) + (size_t)l * 1024 * 5632; ld = 5632; kvalid = 1024; k0 = kt * 64;
            const int g = n >> 3, e = n & 7; col = (e < 4) ? 4 * g + e : 2816 + 4 * g + (e - 4); dst = (bf16_t*)(W + W_1) + (size_t)n * 1024 + k0; }
        else if (t < T4) { const int u = t - T3, nt = u % 16, kt = u / 16, n = nt * 64 + C.lane; src = INF(37) + (size_t)l * 2816 * 1024; ld = 1024; kvalid = 2816; k0 = kt * 64; col = n; dst = (bf16_t*)(W + W_2) + (size_t)n * 2816 + k0; }
        else if (t < T5) { const int u = t - T4, br = u / 64, v = u % 64, nt = v / 4, kt = v % 4, n = nt * 64 + C.lane; const int ii = (br == 0) ? 19 : (br == 1) ? 24 : (br == 2) ? 26 : 31;
            src = INF(ii) + (size_t)l * 256 * 1024; ld = 1024; kvalid = 256; k0 = kt * 64; col = n; dst = (bf16_t*)(W + W_BOUT) + ((size_t)br * 1024 + n) * 256 + k0; }
        else if (t < T6) { const int u = t - T5, nt = u / 4, kt = u % 4, n = nt * 64 + C.lane; src = INF(21) + (size_t)l * 256 * 384; ld = 384; kvalid = 256; k0 = kt * 64; col = n < 384 ? n : -1; dst = (bf16_t*)(W + W_UQ) + (size_t)n * 256 + k0; scale = 0.10206207261596577f * 1.4426950408889634f; }
        else if (t < T7) { const int u = t - T6, nt = u / 4, kt = u % 4, n = nt * 64 + C.lane; src = INF(23) + (size_t)l * 128 * 512; ld = 512; kvalid = 128; k0 = kt * 64; col = (n >> 6) * 128 + (n & 63); dst = (bf16_t*)(W + W_UK) + (size_t)n * 256 + k0; }
        else { const int u = t - T7, nt = u / 4, kt = u % 4, n = nt * 64 + C.lane; src = INF(23) + (size_t)l * 128 * 512; ld = 512; kvalid = 128; k0 = kt * 64; col = (n >> 6) * 128 + 64 + (n & 63); dst = (bf16_t*)(W + W_UV) + (size_t)n * 256 + k0; }
        conv_tile(src, ld, kvalid, k0, col, dst, scale);
    }
}

__device__ __forceinline__ bf16_t* rg_ptr(unsigned char* ws, int l, int p, int o, int c) {
    return (bf16_t*)(ws + WS_RG + (size_t)l * RG_LAYER) + (p ? (size_t)2 * 256 * 512 : 0) + (size_t)(o * 256 + c) * (p ? 4096 : 512);
}
__device__ __forceinline__ void build_rg(const Ctx& C0) { const Ctx C = launder(C0);
    float* tile = (float*)C.lds;
    float* invn = tile + 64 * 65;
    const float* HR = (const float*)(C.ws + WS_AR + A_HRAW);
    const float* HP = (const float*)(C.ws + WS_HP);
    for (int task = C.bid; task < 1152; task += C.G) {
        const int l = task / 576, u = task % 576;
        int p, o, cg, mc;
        if (u < 64) { p = 0; o = u / 32; cg = (u / 8) % 4; mc = u % 8; } else { const int v = u - 64; p = 1; o = v / 256; cg = (v / 64) % 4; mc = v % 64; }
        const int L = p ? 2048 : 256, nch = p ? 64 : 8, chb = p ? 8 : 0, c0 = cg * 64, m0 = mc * 64;
        {
          const int cch_ = C.tid & 63, part = C.tid >> 6; float hv[8];
#pragma unroll
          for (int q = 0; q < 8; ++q) { const int k = part + 8 * q; hv[q] = (k < nch) ? HP[((size_t)l * 72 + chb + k) * 512 + o * 256 + c0 + cch_] : 0.f; }
          invn[part * 64 + cch_] = ((hv[0] + hv[1]) + (hv[2] + hv[3])) + ((hv[4] + hv[5]) + (hv[6] + hv[7])); }
        const float* hr = HR + ((size_t)l * 2304 + (p ? 256 : 0)) * 1024;
#pragma unroll
        for (int jj = 0; jj < 8; ++jj) {
            const int j = C.wid * 8 + jj, m = m0 + j, n = L - m;
            float v = 0.f;
            if (m != 0) { const int t = n >= 0 ? n : -n, dir = n >= 0 ? 0 : 1; v = hr[(size_t)t * 1024 + o * 512 + dir * 256 + c0 + C.lane]; }
            tile[j * 65 + C.lane] = v;
        }
        __syncthreads();
        { const int cc = C.tid >> 3, jg = C.tid & 7;
          float sn = 0.f;
#pragma unroll
          for (int q = 0; q < 8; ++q) sn += invn[q * 64 + cc];
          const float s = 1.0f / sn;
          u32x4 w; float f[8];
#pragma unroll
          for (int e = 0; e < 8; ++e) f[e] = tile[(jg * 8 + e) * 65 + cc] * s;
          w.x = cvt_pk_bf16(f[0], f[1]); w.y = cvt_pk_bf16(f[2], f[3]); w.z = cvt_pk_bf16(f[4], f[5]); w.w = cvt_pk_bf16(f[6], f[7]);
          *(u32x4*)(rg_ptr(C.ws, l, p, o, c0 + cc) + m0 + jg * 8) = w; }
        __syncthreads();
    }
}

__device__ __forceinline__ void norm_phase(const Ctx& C0, int l0, int which) { const int l = launder_s(l0); const Ctx C = launder(C0); const float* in0 = INF(0); const float* in1 = INF(1); const float* in9 = INF(9); const float* in35 = INF(35);
    bf16_t* X = (bf16_t*)(C.ws + WS_HB);
    bf16_t* Hb = (bf16_t*)C.out;
    const float* MOD = (const float*)(C.ws + WS_MOD) + (size_t)l * 5 * 6144;
    const float* g = (which == 0 ? in9 : in35) + l * 1024;
    const int shoff = which == 0 ? 0 : 3072, scoff = shoff + 1024;
    const bool first = (which == 0 && l == 0);
    f32x4 gg[4];
#pragma unroll
    for (int i = 0; i < 4; ++i) gg[i] = *(const f32x4*)(g + i * 256 + C.lane * 4);
    for (int rp = C.bid * 8 + C.wid; rp < M / 2; rp += C.G * 8) {
        f32x4 v[2][4]; float ss[2] = {0.f, 0.f};
#pragma unroll
        for (int q = 0; q < 2; ++q) { const int row = rp + q * (M / 2);
            if (first) { const float* src = row < MC ? in0 + (size_t)row * D : in1 + (size_t)(row - MC) * D;
#pragma unroll
                for (int i = 0; i < 4; ++i) v[q][i] = *(const f32x4*)(src + i * 256 + C.lane * 4);
            } else { const bf16_t* src = X + (size_t)row * D;
#pragma unroll
                for (int i = 0; i < 4; ++i) { const u32x2 w = *(const u32x2*)(src + i * 256 + C.lane * 4); v[q][i] = (f32x4){bflo(w.x), bfhi(w.x), bflo(w.y), bfhi(w.y)}; } } }
#pragma unroll
        for (int q = 0; q < 2; ++q)
#pragma unroll
            for (int i = 0; i < 4; ++i) ss[q] += v[q][i][0] * v[q][i][0] + v[q][i][1] * v[q][i][1] + v[q][i][2] * v[q][i][2] + v[q][i][3] * v[q][i][3];
#pragma unroll
        for (int o = 32; o >= 1; o >>= 1) { const float t0 = shx(ss[0], o, C.lane), t1 = shx(ss[1], o, C.lane); ss[0] += t0; ss[1] += t1; }
#pragma unroll
        for (int q = 0; q < 2; ++q) { const int row = rp + q * (M / 2);
            const float rstd = rsqrtf(ss[q] * (1.0f / 1024.0f) + 1e-6f);
            const float* mp = MOD + (size_t)midx_of_row(row) * 6144;
#pragma unroll
            for (int i = 0; i < 4; ++i) {
                const int c = i * 256 + C.lane * 4;
                if (first) { u32x2 xw; xw.x = cvt_pk_bf16(v[q][i][0], v[q][i][1]); xw.y = cvt_pk_bf16(v[q][i][2], v[q][i][3]); *(u32x2*)(X + (size_t)row * D + c) = xw; }
                const f32x4 sh = *(const f32x4*)(mp + shoff + c), sc = *(const f32x4*)(mp + scoff + c);
                const f32x4 y = (v[q][i] * rstd * gg[i]) * (sc + 1.0f) + sh;
                u32x2 w; w.x = cvt_pk_bf16(y[0], y[1]); w.y = cvt_pk_bf16(y[2], y[3]);
                *(u32x2*)(Hb + (size_t)row * D + c) = w;
            } }
    }
}
__device__ __forceinline__ void final_norm(const Ctx& C0) { const Ctx C = launder(C0); const float* in38 = INF(38);
    const bf16_t* X = (const bf16_t*)(C.ws + WS_HB); float* Y = C.out; const float* g = in38;
    for (int row = C.bid * 8 + C.wid; row < M; row += C.G * 8) {
        const bf16_t* src = X + (size_t)row * D;
        f32x4 v[4]; float ss = 0.f;
#pragma unroll
        for (int i = 0; i < 4; ++i) { const u32x2 w = *(const u32x2*)(src + i * 256 + C.lane * 4); v[i] = (f32x4){bflo(w.x), bfhi(w.x), bflo(w.y), bfhi(w.y)}; ss += v[i][0] * v[i][0] + v[i][1] * v[i][1] + v[i][2] * v[i][2] + v[i][3] * v[i][3]; }
        ss = wave_sum_l(ss, C.lane);
        const float rstd = rsqrtf(ss * (1.0f / 1024.0f) + 1e-6f);
#pragma unroll
        for (int i = 0; i < 4; ++i) { const int c = i * 256 + C.lane * 4; *(f32x4*)(Y + (size_t)row * D + c) = v[i] * rstd * *(const f32x4*)(g + c); }
    }
}

__device__ __forceinline__ void prep_phase(const Ctx& C0, int l0) { const int l = launder_s(l0); const Ctx C = launder(C0); const float* in2 = INF(2); const float* in3 = INF(3); const float* in11 = INF(11); const float* in12 = INF(12); const float* in20 = INF(20); const float* in22 = INF(22); const float* in27 = INF(27); const float* in28 = INF(28); const float* in29 = INF(29); const float* in30 = INF(30);
    unsigned char* AR = C.ws + WS_AR;
    const bf16_t* UHY = (const bf16_t*)(AR + A_UHY); const bf16_t* UMLA = (const bf16_t*)(AR + A_UMLA);
    const bf16_t* UCONF = (const bf16_t*)(AR + A_UCONF); const bf16_t* URET = (const bf16_t*)(AR + A_URET);
    bf16_t* ZT = (bf16_t*)(AR + A_ZT); bf16_t* CQN = (bf16_t*)(AR + A_CQN); bf16_t* CKN = (bf16_t*)(AR + A_CKN);
    bf16_t* KR = (bf16_t*)(AR + A_KR); bf16_t* RVT = (bf16_t*)(AR + A_RVT);
    bf16_t* YCONF = (bf16_t*)((unsigned char*)C.out + 33554432) + (size_t)3 * M * 256;
    const float* rope = (const float*)(C.ws + WS_ROPE);
    float* out = C.out;
    for (int ti = C.bid; ti < M / 64; ti += C.G) {
        const int r0 = ti * 64; const bool lat = r0 >= MC;
        const int L = lat ? 2048 : 256, sb = lat ? MC + ((r0 - MC) >> 11) * 2048 : (r0 >> 8) * 256, t0 = r0 - sb, b = lat ? (r0 - MC) >> 11 : r0 >> 8;
        {
            bf16_t* us = (bf16_t*)C.lds;
#pragma unroll 4
            for (int q = C.tid; q < 66 * 96; q += NT) { const int rr = q / 96, cc = q % 96; const int t = t0 + rr - 1;
                u32x4 v = (u32x4){0u, 0u, 0u, 0u}; if (t >= 0 && t < L) v = *(const u32x4*)(UHY + (size_t)(sb + t) * 768 + cc * 8);
                *(u32x4*)(us + rr * 768 + cc * 8) = v; }
            __syncthreads();
            const float* cw = in11 + l * 3 * 768; const float* cb = in12 + l * 768;
            for (int it = C.tid; it < 768 * 8; it += NT) { const int ch = it % 768, tg = it / 768;
                const float w0 = cw[ch], w1 = cw[768 + ch], w2 = cw[1536 + ch], bb = cb[ch];
                float u[10];
#pragma unroll
                for (int e = 0; e < 10; ++e) u[e] = bf2f(us[(tg * 8 + e) * 768 + ch]);
                float z[8];
#pragma unroll
                for (int e = 0; e < 8; ++e) z[e] = w0 * u[e] + w1 * u[e + 1] + w2 * u[e + 2] + bb;
                u32x4 w; w.x = cvt_pk_bf16(z[0], z[1]); w.y = cvt_pk_bf16(z[2], z[3]); w.z = cvt_pk_bf16(z[4], z[5]); w.w = cvt_pk_bf16(z[6], z[7]);
                *(u32x4*)(ZT + ((size_t)(lat ? 768 : 0) + ch) * 8192 + (r0 - (lat ? MC : 0)) + tg * 8) = w; }
            __syncthreads();
        }
        {
            const int rw0 = r0 + C.wid * 8;
            u32x2 cqv[8]; unsigned ckw[8]; float krx[8], rcs[8], rsn[8];
#pragma unroll
            for (int tt = 0; tt < 8; ++tt) { const bf16_t* um = UMLA + (size_t)(rw0 + tt) * 416;
                cqv[tt] = *(const u32x2*)(um + C.lane * 4); ckw[tt] = *(const unsigned*)(um + 256 + C.lane * 2); krx[tt] = bf2f(um[384 + (C.lane & 31)]);
                rcs[tt] = 1.f; rsn[tt] = 0.f;
                if (lat) { const int t = rw0 + tt - sb; rcs[tt] = rope[t * 16 + (C.lane & 15)]; rsn[tt] = rope[32768 + t * 16 + (C.lane & 15)]; } }
            const f32x4 gq = *(const f32x4*)(in20 + l * 256 + C.lane * 4); const f32x2 gk = *(const f32x2*)(in22 + l * 128 + C.lane * 2);
            float s1[8], s2[8], oth[8];
#pragma unroll
            for (int tt = 0; tt < 8; ++tt) { const float x0 = bflo(cqv[tt].x), x1 = bfhi(cqv[tt].x), x2 = bflo(cqv[tt].y), x3 = bfhi(cqv[tt].y), k0 = bflo(ckw[tt]), k1 = bfhi(ckw[tt]);
                s1[tt] = x0 * x0 + x1 * x1 + x2 * x2 + x3 * x3; s2[tt] = k0 * k0 + k1 * k1; oth[tt] = shx(krx[tt], 16, C.lane); }
#pragma unroll
            for (int o = 32; o >= 1; o >>= 1) {
                float t1[8], t2[8];
#pragma unroll
                for (int tt = 0; tt < 8; ++tt) { t1[tt] = shx(s1[tt], o, C.lane); t2[tt] = shx(s2[tt], o, C.lane); }
#pragma unroll
                for (int tt = 0; tt < 8; ++tt) { s1[tt] += t1[tt]; s2[tt] += t2[tt]; }
            }
#pragma unroll
            for (int tt = 0; tt < 8; ++tt) {
                const int row = rw0 + tt, t = row - sb; const size_t keyrow = lat ? (size_t)MC + b * 2304 + t : (size_t)row;
                { const float x0 = bflo(cqv[tt].x), x1 = bfhi(cqv[tt].x), x2 = bflo(cqv[tt].y), x3 = bfhi(cqv[tt].y); const float rs = rsqrtf(s1[tt] * (1.0f / 256.0f) + 1e-6f);
                  u32x2 o; o.x = cvt_pk_bf16(x0 * rs * gq[0], x1 * rs * gq[1]); o.y = cvt_pk_bf16(x2 * rs * gq[2], x3 * rs * gq[3]);
                  *(u32x2*)(CQN + (size_t)row * 256 + C.lane * 4) = o; }
                { const float x0 = bflo(ckw[tt]), x1 = bfhi(ckw[tt]); const float rs = rsqrtf(s2[tt] * (1.0f / 128.0f) + 1e-6f);
                  const float y0 = x0 * rs * gk[0], y1 = x1 * rs * gk[1];
                  *(unsigned*)(CKN + keyrow * 256 + C.lane * 2) = cvt_pk_bf16(y0, y1);
                  *(unsigned*)(CKN + keyrow * 256 + 128 + C.lane * 2) = 0u;
                  if (!lat) *(f32x2*)(out + 16777216 + (((size_t)b * 2 + l) * 256 + t) * 128 + C.lane * 2) = (f32x2){y0, y1}; }
                { const float x = krx[tt]; float y = x;
                  if (lat) y = (C.lane & 16) ? (oth[tt] * rsn[tt] + x * rcs[tt]) : (x * rcs[tt] - oth[tt] * rsn[tt]);
                  if (C.lane < 32) { KR[keyrow * 32 + C.lane] = f2bf(y); if (!lat) out[18874368 + (((size_t)b * 2 + l) * 256 + t) * 32 + C.lane] = x; } }
            }
        }
        {
            bf16_t* vs = (bf16_t*)C.lds;
#pragma unroll 4
            for (int q = C.tid; q < 64 * 32; q += NT) { const int rr = q >> 5, cc = q & 31; *(u32x4*)(vs + rr * 264 + cc * 8) = *(const u32x4*)(URET + (size_t)(r0 + rr) * 1024 + 512 + cc * 8); }
            __syncthreads();
            for (int it = C.tid; it < 256 * 8; it += NT) { const int col = it & 255, tg = it >> 8; unsigned short e[8];
#pragma unroll
                for (int k = 0; k < 8; ++k) e[k] = vs[(tg * 8 + k) * 264 + col];
                u32x4 w; w.x = e[0] | ((unsigned)e[1] << 16); w.y = e[2] | ((unsigned)e[3] << 16); w.z = e[4] | ((unsigned)e[5] << 16); w.w = e[6] | ((unsigned)e[7] << 16);
                *(u32x4*)(RVT + (size_t)col * M + r0 + tg * 8) = w; }
            __syncthreads();
        }
        {
            bf16_t* zb = (bf16_t*)C.lds;
            float* cbuf = (float*)(C.lds + 94 * 256 * 2);
#pragma unroll 4
            for (int q = C.tid; q < 94 * 64; q += NT) { const int rr = q >> 6, cc = q & 63; const int t = t0 + rr - 15;
                u32x2 o = (u32x2){0u, 0u};
                if (t >= 0 && t < L) { const bf16_t* up = UCONF + (size_t)(sb + t) * 512 + cc * 4; const u32x2 a = *(const u32x2*)up, g = *(const u32x2*)(up + 256);
                    o.x = cvt_pk_bf16(bflo(a.x) * sigmoidf_(bflo(g.x)), bfhi(a.x) * sigmoidf_(bfhi(g.x))); o.y = cvt_pk_bf16(bflo(a.y) * sigmoidf_(bflo(g.y)), bfhi(a.y) * sigmoidf_(bfhi(g.y))); }
                *(u32x2*)(zb + rr * 256 + cc * 4) = o; }
            __syncthreads();
            { const int c = C.tid & 255, th = C.tid >> 8; const float* dw = in27 + (size_t)l * 31 * 256 + c; const float bb = in28[l * 256 + c];
              float a[32];
#pragma unroll
              for (int i = 0; i < 32; ++i) a[i] = bb;
              for (int j = 0; j < 31; ++j) { const float w = dw[j * 256];
#pragma unroll
                  for (int i = 0; i < 32; ++i) a[i] += w * bf2f(zb[(th * 32 + i + j) * 256 + c]); }
#pragma unroll
              for (int i = 0; i < 32; ++i) cbuf[(th * 32 + i) * 256 + c] = a[i]; }
            __syncthreads();
            for (int tt = 0; tt < 8; ++tt) { const int tr = C.wid * 8 + tt; const f32x4 v = *(const f32x4*)(cbuf + tr * 256 + C.lane * 4);
                const float mu = wave_sum_l(v[0] + v[1] + v[2] + v[3], C.lane) * (1.0f / 256.0f);
                const f32x4 d = v - mu; const float var = wave_sum_l(d[0] * d[0] + d[1] * d[1] + d[2] * d[2] + d[3] * d[3], C.lane) * (1.0f / 256.0f);
                const float rs = rsqrtf(var + 1e-6f);
                const f32x4 g = *(const f32x4*)(in29 + l * 256 + C.lane * 4), be = *(const f32x4*)(in30 + l * 256 + C.lane * 4);
                f32x4 y = d * rs * g + be;
#pragma unroll
                for (int j = 0; j < 4; ++j) y[j] = y[j] * sigmoidf_(y[j]);
                u32x2 w; w.x = cvt_pk_bf16(y[0], y[1]); w.y = cvt_pk_bf16(y[2], y[3]);
                *(u32x2*)(YCONF + (size_t)(r0 + tr) * 256 + C.lane * 4) = w; }
            __syncthreads();
        }
    }
    for (int r = C.bid * 8 + C.wid; r < 1024; r += C.G * 8) { const int b = r >> 8, j = r & 255; const size_t keyrow = (size_t)MC + b * 2304 + 2048 + j;
        const f32x2 v = *(const f32x2*)(in2 + (((size_t)b * 2 + l) * 256 + j) * 128 + C.lane * 2);
        *(unsigned*)(CKN + keyrow * 256 + C.lane * 2) = cvt_pk_bf16(v[0], v[1]); *(unsigned*)(CKN + keyrow * 256 + 128 + C.lane * 2) = 0u;
        if (C.lane < 32) KR[keyrow * 32 + C.lane] = f2bf(in3[(((size_t)b * 2 + l) * 256 + j) * 32 + C.lane]); }
}

__device__ __forceinline__ void hyena_phase(const Ctx& C0, int l0) { const int l = launder_s(l0); const Ctx C = launder(C0); const float* in18 = INF(18);
    const bf16_t* ZT = (const bf16_t*)(C.ws + WS_AR + A_ZT);
    bf16_t* YHY = (bf16_t*)((unsigned char*)C.out + 33554432);
    LAS unsigned char* vS = C.ldsL;
    LAS unsigned char* R0 = C.ldsL + 20480;
    LAS unsigned char* R1 = R0 + 8256;
    const int n = C.lane & 31, hf = C.lane >> 5;
    const int Bk = 32 * C.wid + n;
    for (int item = C.bid; item < 256; item += C.G) {
      u32x4 pd; unsigned pe;
#define HY_RLOAD(P_, O_) do { const bf16_t* rg_ = rg_ptr(C.ws, l, (P_), (O_), item); const int nch_ = ((P_) ? 4096 : 512) >> 3; pd = (u32x4){0u, 0u, 0u, 0u}; pe = 0u; \
          if (C.tid < nch_) { pd = *(const u32x4*)(rg_ + C.tid * 8); if (C.tid + 1 < nch_) pe = *(const unsigned*)(rg_ + C.tid * 8 + 8); } } while (0)
      HY_RLOAD(1, 0);
      for (int s = 0; s < 4; ++s) {
        const int p = 1 - (s >> 1), o = s & 1, c = item;
        const int L = p ? 2048 : 256, Lb = L >> 5, L2 = 2 * L;
        const bf16_t* zv = ZT + ((size_t)p * 768 + c) * 8192;
        const bf16_t* zx1 = zv + (size_t)256 * 8192; const bf16_t* zx2 = zv + (size_t)512 * 8192;
        if (o == 0) {
            __syncthreads();
            for (int q = C.tid; q < 1024; q += NT) *(LAS u32x4*)(vS + (q >> 2) * 80 + (q & 3) * 16) = *(const u32x4*)(zv + q * 8);
        }
        {
            if (C.tid <= (L2 >> 3)) {
                *(LAS u32x4*)(R0 + C.tid * 16) = pd;
                u32x4 sft; sft.x = (pd.x >> 16) | (pd.y << 16); sft.y = (pd.y >> 16) | (pd.z << 16); sft.z = (pd.z >> 16) | (pd.w << 16); sft.w = (pd.w >> 16) | (pe << 16);
                *(LAS u32x4*)(R1 + C.tid * 16) = sft;
            }
            __syncthreads();
            if (s < 3) HY_RLOAD(1 - ((s + 1) >> 1), (s + 1) & 1);
            f32x16 acc;
#pragma unroll
            for (int r = 0; r < 16; ++r) acc[r] = 0.f;
            const LAS unsigned* Rc = (const LAS unsigned*)((n & 1) ? R1 : R0);
            const int T = Bk & (Lb - 1);
            const int Tlo = (32 * C.wid) & (Lb - 1), Thi = Lb >= 32 ? Tlo + 31 : Lb - 1, Tl0 = Lb >= 32 ? Tlo : 0;
            const int dlo = Tl0 - (Lb - 1), dhi = Thi;
            for (int d = dlo; d <= dhi; ++d) {
                const int s0 = L - 32 * d - n + 8 * hf, dw = s0 >> 1;
                u32x4 a0, a1;
                a0.x = Rc[dw]; a0.y = Rc[dw + 1]; a0.z = Rc[dw + 2]; a0.w = Rc[dw + 3];
                a1.x = Rc[dw + 8]; a1.y = Rc[dw + 9]; a1.z = Rc[dw + 10]; a1.w = Rc[dw + 11];
                const int Ts = T - d;
                const bool valid = (Ts >= 0) && (Ts < Lb);
                const int sblk = valid ? (Bk - d) : 0;
                u32x4 b0 = *(const LAS u32x4*)(vS + sblk * 80 + hf * 16), b1 = *(const LAS u32x4*)(vS + sblk * 80 + 32 + hf * 16);
                if (!valid) { b0 = (u32x4){0u, 0u, 0u, 0u}; b1 = b0; }
                acc = __builtin_amdgcn_mfma_f32_32x32x16_bf16(__builtin_bit_cast(bf16x8, a0), __builtin_bit_cast(bf16x8, b0), acc, 0, 0, 0);
                acc = __builtin_amdgcn_mfma_f32_32x32x16_bf16(__builtin_bit_cast(bf16x8, a1), __builtin_bit_cast(bf16x8, b1), acc, 0, 0, 0);
            }
            __syncthreads();
            const float bias = in18[((size_t)l * 2 + o) * 256 + c];
            const bf16_t* zg = o == 0 ? zx1 : zx2;
#pragma unroll
            for (int g4 = 0; g4 < 4; ++g4) {
                const int i0 = 8 * g4 + 4 * hf; const int tf = 32 * Bk + i0;
                LAS u32x2* vp = (LAS u32x2*)(vS + Bk * 80 + i0 * 2);
                const u32x2 vv = *vp; const u32x2 gg = *(const u32x2*)(zg + tf);
                const float y0 = (acc[4 * g4 + 0] + bias * bflo(vv.x)) * bflo(gg.x), y1 = (acc[4 * g4 + 1] + bias * bfhi(vv.x)) * bfhi(gg.x);
                const float y2 = (acc[4 * g4 + 2] + bias * bflo(vv.y)) * bflo(gg.y), y3 = (acc[4 * g4 + 3] + bias * bfhi(vv.y)) * bfhi(gg.y);
                if (o == 0) { u32x2 w; w.x = cvt_pk_bf16(y0, y1); w.y = cvt_pk_bf16(y2, y3); *vp = w; }
                else { bf16_t* yp = YHY + (size_t)((p ? MC : 0) + tf) * 256 + c; yp[0] = f2bf(y0); yp[256] = f2bf(y1); yp[512] = f2bf(y2); yp[768] = f2bf(y3); }
            }
            __syncthreads();
        }
      }
    }
#undef HY_RLOAD
    __syncthreads();
}

__device__ void mla_item(const Ctx& C0, int item, bool lat) { const Ctx C = launder(C0);
    const unsigned char* AR = C.ws + WS_AR;
    const bf16_t* Q = (const bf16_t*)(AR + A_Q); const bf16_t* KN = (const bf16_t*)(AR + A_KN); const bf16_t* KR = (const bf16_t*)(AR + A_KR); const bf16_t* VT = (const bf16_t*)(AR + A_VT);
    bf16_t* Y = (bf16_t*)((unsigned char*)C.out + 33554432) + (size_t)1 * M * 256;
    int b, h, qt; if (lat) { b = item >> 8; h = (item >> 6) & 3; qt = item & 63; } else { b = item >> 5; h = (item >> 3) & 3; qt = item & 7; }
    const int row0 = (lat ? MC + b * 2048 : b * 256) + qt * 32, key0 = lat ? MC + b * 2304 : b * 256, nk = lat ? 2304 : 256;
    const int n = C.lane & 31, hf = C.lane >> 5;
    bf16x8 qf[6];
#pragma unroll
    for (int ks = 0; ks < 6; ++ks) qf[ks] = *(const bf16x8*)(Q + (size_t)(row0 + n) * 384 + h * 96 + ks * 16 + hf * 8);
    if (lat) {
        const float* rope = (const float*)(C.ws + WS_ROPE); const int t = qt * 32 + n;
        const f32x4 c0 = *(const f32x4*)(rope + t * 16 + hf * 8), c1 = *(const f32x4*)(rope + t * 16 + hf * 8 + 4);
        const f32x4 s0 = *(const f32x4*)(rope + 32768 + t * 16 + hf * 8), s1 = *(const f32x4*)(rope + 32768 + t * 16 + hf * 8 + 4);
        bf16x8 a = qf[4], bq = qf[5]; float o1v[8], o2v[8];
#pragma unroll
        for (int j = 0; j < 8; ++j) { const float x1 = bf2f((bf16_t)a[j]), x2 = bf2f((bf16_t)bq[j]); const float cs = j < 4 ? c0[j & 3] : c1[j & 3], sn = j < 4 ? s0[j & 3] : s1[j & 3];
            o1v[j] = x1 * cs - x2 * sn; o2v[j] = x1 * sn + x2 * cs; }
        u32x4 wa, wb; wa.x = cvt_pk_bf16(o1v[0], o1v[1]); wa.y = cvt_pk_bf16(o1v[2], o1v[3]); wa.z = cvt_pk_bf16(o1v[4], o1v[5]); wa.w = cvt_pk_bf16(o1v[6], o1v[7]);
        wb.x = cvt_pk_bf16(o2v[0], o2v[1]); wb.y = cvt_pk_bf16(o2v[2], o2v[3]); wb.z = cvt_pk_bf16(o2v[4], o2v[5]); wb.w = cvt_pk_bf16(o2v[6], o2v[7]);
        qf[4] = __builtin_bit_cast(bf16x8, wa); qf[5] = __builtin_bit_cast(bf16x8, wb);
    }
    float mrun = -1e30f, lrun = 0.f; f32x16 o0, o1;
#pragma unroll
    for (int r = 0; r < 16; ++r) { o0[r] = 0.f; o1[r] = 0.f; }
    const bf16_t* vt0 = VT + (size_t)(h * 64 + n) * NKEY + key0 + 4 * hf; const bf16_t* vt1 = vt0 + (size_t)32 * NKEY;
    for (int kt = 0; kt < nk; kt += 32) {
        const size_t key = (size_t)key0 + kt + n;
        bf16x8 kf[6];
#pragma unroll
        for (int ks = 0; ks < 4; ++ks) kf[ks] = *(const bf16x8*)(KN + key * 256 + h * 64 + ks * 16 + hf * 8);
        kf[4] = *(const bf16x8*)(KR + key * 32 + hf * 8); kf[5] = *(const bf16x8*)(KR + key * 32 + 16 + hf * 8);
        bf16x4 va[2][2][2];
#pragma unroll
        for (int s2 = 0; s2 < 2; ++s2) { va[0][s2][0] = *(const bf16x4*)(vt0 + kt + 16 * s2); va[0][s2][1] = *(const bf16x4*)(vt0 + kt + 16 * s2 + 8);
                                         va[1][s2][0] = *(const bf16x4*)(vt1 + kt + 16 * s2); va[1][s2][1] = *(const bf16x4*)(vt1 + kt + 16 * s2 + 8); }
        f32x16 s;
#pragma unroll
        for (int r = 0; r < 16; ++r) s[r] = 0.f;
#pragma unroll
        for (int ks = 0; ks < 6; ++ks) s = __builtin_amdgcn_mfma_f32_32x32x16_bf16(kf[ks], qf[ks], s, 0, 0, 0);
        float mx = s[0];
#pragma unroll
        for (int r = 1; r < 16; ++r) mx = fmaxf(mx, s[r]);
        mx = fmaxf(mx, shx(mx, 32, C.lane));
        const float mnew = fmaxf(mrun, mx), alpha = exp2f(mrun - mnew); mrun = mnew;
        float ls = 0.f;
#pragma unroll
        for (int r = 0; r < 16; ++r) { s[r] = exp2f(s[r] - mnew); ls += s[r]; }
        lrun = lrun * alpha + ls;
#pragma unroll
        for (int r = 0; r < 16; ++r) { o0[r] *= alpha; o1[r] *= alpha; }
#pragma unroll
        for (int s2 = 0; s2 < 2; ++s2) {
            u32x4 pw; pw.x = cvt_pk_bf16(s[8 * s2], s[8 * s2 + 1]); pw.y = cvt_pk_bf16(s[8 * s2 + 2], s[8 * s2 + 3]); pw.z = cvt_pk_bf16(s[8 * s2 + 4], s[8 * s2 + 5]); pw.w = cvt_pk_bf16(s[8 * s2 + 6], s[8 * s2 + 7]);
            const bf16x8 pf = __builtin_bit_cast(bf16x8, pw);
            const bf16x8 v0 = __builtin_shufflevector(va[0][s2][0], va[0][s2][1], 0, 1, 2, 3, 4, 5, 6, 7), v1 = __builtin_shufflevector(va[1][s2][0], va[1][s2][1], 0, 1, 2, 3, 4, 5, 6, 7);
            o0 = __builtin_amdgcn_mfma_f32_32x32x16_bf16(v0, pf, o0, 0, 0, 0);
            o1 = __builtin_amdgcn_mfma_f32_32x32x16_bf16(v1, pf, o1, 0, 0, 0);
        }
    }
    lrun += shx(lrun, 32, C.lane);
    const float inv = 1.0f / lrun;
    bf16_t* yp = Y + (size_t)(row0 + n) * 256 + h * 64 + 4 * hf;
#pragma unroll
    for (int g4 = 0; g4 < 4; ++g4) {
        u32x2 w0, w1; w0.x = cvt_pk_bf16(o0[4 * g4] * inv, o0[4 * g4 + 1] * inv); w0.y = cvt_pk_bf16(o0[4 * g4 + 2] * inv, o0[4 * g4 + 3] * inv);
        w1.x = cvt_pk_bf16(o1[4 * g4] * inv, o1[4 * g4 + 1] * inv); w1.y = cvt_pk_bf16(o1[4 * g4 + 2] * inv, o1[4 * g4 + 3] * inv);
        *(u32x2*)(yp + 8 * g4) = w0; *(u32x2*)(yp + 32 + 8 * g4) = w1;
    }
}

__device__ __forceinline__ float log2_sigmoid(float x) { return -log1pf(__expf(-x)) * 1.4426950408889634f; }
__device__ void ret_item(const Ctx& C0, int l0, int item, bool lat) { const int l = launder_s(l0); const Ctx C = launder(C0); const float* in25 = INF(25);
    const unsigned char* AR = C.ws + WS_AR;
    const bf16_t* URET = (const bf16_t*)(AR + A_URET); const bf16_t* RVT = (const bf16_t*)(AR + A_RVT);
    const bf16_t* S0T = (const bf16_t*)(C.ws + WS_S0T);
    bf16_t* Y = (bf16_t*)((unsigned char*)C.out + 33554432) + (size_t)2 * M * 256;
    int b, h, qt; if (lat) { b = item >> 8; h = (item >> 6) & 3; qt = item & 63; } else { b = item >> 5; h = (item >> 3) & 3; qt = item & 7; }
    const int L = lat ? 2048 : 256, sb = lat ? MC + b * 2048 : b * 256, row0 = sb + qt * 32;
    const int n = C.lane & 31, hf = C.lane >> 5;
    const float lgf = log2_sigmoid(in25[(l * 2 + 0) * 4 + h]), lgb = log2_sigmoid(in25[(l * 2 + 1) * 4 + h]);
    bf16x8 qf[4];
#pragma unroll
    for (int ks = 0; ks < 4; ++ks) qf[ks] = *(const bf16x8*)(URET + (size_t)(row0 + n) * 1024 + h * 64 + ks * 16 + hf * 8);
    f32x16 o0, o1;
#pragma unroll
    for (int r = 0; r < 16; ++r) { o0[r] = 0.f; o1[r] = 0.f; }
    const int tq = qt * 32 + n;
    const bf16_t* vt0 = RVT + (size_t)(h * 64 + n) * M + sb + 4 * hf; const bf16_t* vt1 = vt0 + (size_t)32 * M;
    for (int kt = 0; kt < L; kt += 32) {
        bf16x8 kf[4];
#pragma unroll
        for (int ks = 0; ks < 4; ++ks) kf[ks] = *(const bf16x8*)(URET + (size_t)(sb + kt + n) * 1024 + 256 + h * 64 + ks * 16 + hf * 8);
        bf16x4 va[2][2][2];
#pragma unroll
        for (int s2 = 0; s2 < 2; ++s2) { va[0][s2][0] = *(const bf16x4*)(vt0 + kt + 16 * s2); va[0][s2][1] = *(const bf16x4*)(vt0 + kt + 16 * s2 + 8);
                                         va[1][s2][0] = *(const bf16x4*)(vt1 + kt + 16 * s2); va[1][s2][1] = *(const bf16x4*)(vt1 + kt + 16 * s2 + 8); }
        f32x16 s;
#pragma unroll
        for (int r = 0; r < 16; ++r) s[r] = 0.f;
#pragma unroll
        for (int ks = 0; ks < 4; ++ks) s = __builtin_amdgcn_mfma_f32_32x32x16_bf16(kf[ks], qf[ks], s, 0, 0, 0);
#pragma unroll
        for (int r = 0; r < 16; ++r) { const int sp = kt + 8 * (r >> 2) + 4 * hf + (r & 3); const int dd = tq - sp;
            const float w = dd > 0 ? exp2f(lgf * (float)dd) : (dd < 0 ? exp2f(lgb * (float)(-dd)) : 2.0f);
            s[r] = s[r] * w * 0.125f; }
#pragma unroll
        for (int s2 = 0; s2 < 2; ++s2) {
            u32x4 pw; pw.x = cvt_pk_bf16(s[8 * s2], s[8 * s2 + 1]); pw.y = cvt_pk_bf16(s[8 * s2 + 2], s[8 * s2 + 3]); pw.z = cvt_pk_bf16(s[8 * s2 + 4], s[8 * s2 + 5]); pw.w = cvt_pk_bf16(s[8 * s2 + 6], s[8 * s2 + 7]);
            const bf16x8 pf = __builtin_bit_cast(bf16x8, pw);
            const bf16x8 v0 = __builtin_shufflevector(va[0][s2][0], va[0][s2][1], 0, 1, 2, 3, 4, 5, 6, 7), v1 = __builtin_shufflevector(va[1][s2][0], va[1][s2][1], 0, 1, 2, 3, 4, 5, 6, 7);
            o0 = __builtin_amdgcn_mfma_f32_32x32x16_bf16(v0, pf, o0, 0, 0, 0);
            o1 = __builtin_amdgcn_mfma_f32_32x32x16_bf16(v1, pf, o1, 0, 0, 0);
        }
    }
    if (lat) {
#pragma unroll
        for (int dir = 0; dir < 2; ++dir) {
            const bf16_t* st = S0T + ((((size_t)b * 2 + l) * 2 + dir) * 4 + h) * 4096;
            f32x16 a0, a1;
#pragma unroll
            for (int r = 0; r < 16; ++r) { a0[r] = 0.f; a1[r] = 0.f; }
#pragma unroll
            for (int ks = 0; ks < 4; ++ks) {
                const bf16x8 s0 = *(const bf16x8*)(st + (size_t)n * 64 + ks * 16 + hf * 8), s1 = *(const bf16x8*)(st + (size_t)(32 + n) * 64 + ks * 16 + hf * 8);
                a0 = __builtin_amdgcn_mfma_f32_32x32x16_bf16(s0, qf[ks], a0, 0, 0, 0);
                a1 = __builtin_amdgcn_mfma_f32_32x32x16_bf16(s1, qf[ks], a1, 0, 0, 0);
            }
            const float w = dir == 0 ? exp2f(lgf * (float)(tq + 1)) : exp2f(lgb * (float)(L - tq));
#pragma unroll
            for (int r = 0; r < 16; ++r) { o0[r] += w * a0[r]; o1[r] += w * a1[r]; }
        }
    }
    float sm = 0.f;
#pragma unroll
    for (int r = 0; r < 16; ++r) sm += o0[r] + o1[r];
    sm += shx(sm, 32, C.lane);
    const float mu = sm * (1.0f / 64.0f);
    float vr = 0.f;
#pragma unroll
    for (int r = 0; r < 16; ++r) { const float d0 = o0[r] - mu, d1 = o1[r] - mu; vr += d0 * d0 + d1 * d1; }
    vr += shx(vr, 32, C.lane);
    const float rs = rsqrtf(vr * (1.0f / 64.0f) + 1e-6f);
    const bf16_t* gp = URET + (size_t)(row0 + n) * 1024 + 768 + h * 64 + 4 * hf;
    bf16_t* yp = Y + (size_t)(row0 + n) * 256 + h * 64 + 4 * hf;
#pragma unroll
    for (int g4 = 0; g4 < 4; ++g4) {
        const u32x2 ga = *(const u32x2*)(gp + 8 * g4), gb = *(const u32x2*)(gp + 32 + 8 * g4);
        const float g0[4] = {bflo(ga.x), bfhi(ga.x), bflo(ga.y), bfhi(ga.y)}, g1[4] = {bflo(gb.x), bfhi(gb.x), bflo(gb.y), bfhi(gb.y)};
        float y0[4], y1[4];
#pragma unroll
        for (int j = 0; j < 4; ++j) { y0[j] = (o0[4 * g4 + j] - mu) * rs * (g0[j] * sigmoidf_(g0[j])); y1[j] = (o1[4 * g4 + j] - mu) * rs * (g1[j] * sigmoidf_(g1[j])); }
        u32x2 w0, w1; w0.x = cvt_pk_bf16(y0[0], y0[1]); w0.y = cvt_pk_bf16(y0[2], y0[3]); w1.x = cvt_pk_bf16(y1[0], y1[1]); w1.y = cvt_pk_bf16(y1[2], y1[3]);
        *(u32x2*)(yp + 8 * g4) = w0; *(u32x2*)(yp + 32 + 8 * g4) = w1;
    }
}


template <bool IS_RET>
__device__ __forceinline__ void att_block(const Ctx& C0, int l0, bool lat, int b, int h, int qblk) { const int l = launder_s(l0); const Ctx C = launder(C0);
    const unsigned char* AR = C.ws + WS_AR;
    const bf16_t* Q = (const bf16_t*)(AR + A_Q); const bf16_t* KN = (const bf16_t*)(AR + A_KN); const bf16_t* KR = (const bf16_t*)(AR + A_KR); const bf16_t* VT = (const bf16_t*)(AR + A_VT);
    const bf16_t* URET = (const bf16_t*)(AR + A_URET); const bf16_t* RVT = (const bf16_t*)(AR + A_RVT);
    constexpr int KP = 208, VP = 264, KBYTES = 128 * KP, SBYTES = KBYTES + 64 * VP;
    const int L = lat ? 2048 : 256, sb = lat ? MC + b * 2048 : b * 256;
    const int row0 = sb + qblk * 256 + C.wid * 32;
    const int key0 = IS_RET ? sb : (lat ? MC + b * 2304 : b * 256), nk = IS_RET ? L : (lat ? 2304 : 256);
    const int n = C.lane & 31, hf = C.lane >> 5;
    constexpr int NKS = IS_RET ? 4 : 6;
    bf16x8 qf[NKS];
    if (IS_RET) {
#pragma unroll
        for (int ks = 0; ks < 4; ++ks) qf[ks] = *(const bf16x8*)(URET + (size_t)(row0 + n) * 1024 + h * 64 + ks * 16 + hf * 8);
    } else {
#pragma unroll
        for (int ks = 0; ks < NKS; ++ks) qf[ks] = *(const bf16x8*)(Q + (size_t)(row0 + n) * 384 + h * 96 + ks * 16 + hf * 8);
        if (lat) {
            const float* rope = (const float*)(C.ws + WS_ROPE); const int t = row0 - sb + n;
            const f32x4 c0 = *(const f32x4*)(rope + t * 16 + hf * 8), c1 = *(const f32x4*)(rope + t * 16 + hf * 8 + 4);
            const f32x4 s0 = *(const f32x4*)(rope + 32768 + t * 16 + hf * 8), s1 = *(const f32x4*)(rope + 32768 + t * 16 + hf * 8 + 4);
            bf16x8 a = qf[NKS - 2], bq = qf[NKS - 1]; float o1v[8], o2v[8];
#pragma unroll
            for (int j = 0; j < 8; ++j) { const float x1 = bf2f((bf16_t)a[j]), x2 = bf2f((bf16_t)bq[j]); const float cs = j < 4 ? c0[j & 3] : c1[j & 3], sn = j < 4 ? s0[j & 3] : s1[j & 3];
                o1v[j] = x1 * cs - x2 * sn; o2v[j] = x1 * sn + x2 * cs; }
            u32x4 wa, wb; wa.x = cvt_pk_bf16(o1v[0], o1v[1]); wa.y = cvt_pk_bf16(o1v[2], o1v[3]); wa.z = cvt_pk_bf16(o1v[4], o1v[5]); wa.w = cvt_pk_bf16(o1v[6], o1v[7]);
            wb.x = cvt_pk_bf16(o2v[0], o2v[1]); wb.y = cvt_pk_bf16(o2v[2], o2v[3]); wb.z = cvt_pk_bf16(o2v[4], o2v[5]); wb.w = cvt_pk_bf16(o2v[6], o2v[7]);
            qf[NKS - 2] = __builtin_bit_cast(bf16x8, wa); qf[NKS - 1] = __builtin_bit_cast(bf16x8, wb);
        }
    }
    float lgf = 0.f, lgb = 0.f;
    if (IS_RET) { const float* in25 = INF(25); lgf = log2_sigmoid(in25[(l * 2 + 0) * 4 + h]); lgb = log2_sigmoid(in25[(l * 2 + 1) * 4 + h]); }
    const int tq = row0 - sb + n;
    const int q0w = qblk * 256 + C.wid * 32;
    float mrun = -1e30f, lrun = 0.f; f32x16 o0, o1;
#pragma unroll
    for (int r = 0; r < 16; ++r) { o0[r] = 0.f; o1[r] = 0.f; }
    const int skey = C.tid >> 3, sch = C.tid & 7, rkey = C.tid >> 2, rch = C.tid & 3;
    u32x4 gk0, gk1, gr, gv0, gv1;
#define ATT_GLOAD(kt) do { \
        if (IS_RET) { \
            gk0 = *(const u32x4*)(URET + (size_t)(sb + (kt) + skey) * 1024 + 256 + h * 64 + sch * 8); gk1 = *(const u32x4*)(URET + (size_t)(sb + (kt) + skey + 64) * 1024 + 256 + h * 64 + sch * 8); \
            gv0 = *(const u32x4*)(RVT + (size_t)(h * 64 + skey) * M + sb + (kt) + sch * 8); gv1 = *(const u32x4*)(RVT + (size_t)(h * 64 + skey) * M + sb + (kt) + (sch + 8) * 8); \
        } else { \
            gk0 = *(const u32x4*)(KN + (size_t)(key0 + (kt) + skey) * 256 + h * 64 + sch * 8); gk1 = *(const u32x4*)(KN + (size_t)(key0 + (kt) + skey + 64) * 256 + h * 64 + sch * 8); \
            gv0 = *(const u32x4*)(VT + (size_t)(h * 64 + skey) * NKEY + key0 + (kt) + sch * 8); gv1 = *(const u32x4*)(VT + (size_t)(h * 64 + skey) * NKEY + key0 + (kt) + (sch + 8) * 8); \
            gr = *(const u32x4*)(KR + (size_t)(key0 + (kt) + rkey) * 32 + rch * 8); \
        } } while (0)
#define ATT_LSTORE(buf) do { \
        LAS unsigned char* kb_ = C.ldsL + (buf) * SBYTES; LAS unsigned char* vb_ = kb_ + KBYTES; \
        *(LAS u32x4*)(kb_ + skey * KP + sch * 16) = gk0; *(LAS u32x4*)(kb_ + (skey + 64) * KP + sch * 16) = gk1; \
        *(LAS u32x2*)(vb_ + skey * VP + sch * 16) = (u32x2){gv0.x, gv0.y}; *(LAS u32x2*)(vb_ + skey * VP + sch * 16 + 8) = (u32x2){gv0.z, gv0.w}; \
        *(LAS u32x2*)(vb_ + skey * VP + (sch + 8) * 16) = (u32x2){gv1.x, gv1.y}; *(LAS u32x2*)(vb_ + skey * VP + (sch + 8) * 16 + 8) = (u32x2){gv1.z, gv1.w}; \
        if (!IS_RET) *(LAS u32x4*)(kb_ + rkey * KP + 128 + rch * 16) = gr; } while (0)
    __syncthreads();
    ATT_GLOAD(0); ATT_LSTORE(0);
    __syncthreads();
    const int nst = nk >> 7;
    for (int st = 0; st < nst; ++st) {
        if (st + 1 < nst) ATT_GLOAD((st + 1) * 128);
        const LAS unsigned char* kb = C.ldsL + (st & 1) * SBYTES; const LAS unsigned char* vb = kb + KBYTES;
#pragma unroll
        for (int sub = 0; sub < 4; ++sub) {
            f32x16 s;
#pragma unroll
            for (int r = 0; r < 16; ++r) s[r] = 0.f;
#pragma unroll
            for (int ks = 0; ks < NKS; ++ks) { const bf16x8 kf = *(const LAS bf16x8*)(kb + (sub * 32 + n) * KP + ks * 32 + hf * 16); s = __builtin_amdgcn_mfma_f32_32x32x16_bf16(kf, qf[ks], s, 0, 0, 0); }
            if (IS_RET) {
                const int kt = st * 128 + sub * 32;
                if (kt < q0w) {
                    const float base = lgf * (float)(tq - kt - 4 * hf) - 3.0f;
#pragma unroll
                    for (int r = 0; r < 16; ++r) s[r] = s[r] * __builtin_amdgcn_exp2f(fmaxf(base - lgf * (float)(8 * (r >> 2) + (r & 3)), -126.0f));
                } else if (kt > q0w) {
                    const float base = lgb * (float)(kt + 4 * hf - tq) - 3.0f;
#pragma unroll
                    for (int r = 0; r < 16; ++r) s[r] = s[r] * __builtin_amdgcn_exp2f(fmaxf(base + lgb * (float)(8 * (r >> 2) + (r & 3)), -126.0f));
                } else {
#pragma unroll
                    for (int r = 0; r < 16; ++r) { const int sp = kt + 8 * (r >> 2) + 4 * hf + (r & 3); const int dd = tq - sp;
                        const float w = dd > 0 ? exp2f(lgf * (float)dd) : (dd < 0 ? exp2f(lgb * (float)(-dd)) : 2.0f);
                        s[r] = s[r] * w * 0.125f; }
                }
            } else {
                float mx = s[0];
#pragma unroll
                for (int r = 1; r < 16; ++r) mx = fmaxf(mx, s[r]);
                mx = fmaxf(mx, shx(mx, 32, C.lane));
                const float mnew = fmaxf(mrun, mx);
                if (__ballot(mnew > mrun) != 0ull) {
                    const float alpha = __builtin_amdgcn_exp2f(fmaxf(mrun - mnew, -126.0f)); mrun = mnew; lrun *= alpha;
#pragma unroll
                    for (int r = 0; r < 16; ++r) { o0[r] *= alpha; o1[r] *= alpha; }
                }
                float ls = 0.f;
#pragma unroll
                for (int r = 0; r < 16; ++r) { s[r] = __builtin_amdgcn_exp2f(fmaxf(s[r] - mrun, -126.0f)); ls += s[r]; }
                lrun += ls;
            }
#pragma unroll
            for (int s2 = 0; s2 < 2; ++s2) {
                u32x4 pw; pw.x = cvt_pk_bf16(s[8 * s2], s[8 * s2 + 1]); pw.y = cvt_pk_bf16(s[8 * s2 + 2], s[8 * s2 + 3]); pw.z = cvt_pk_bf16(s[8 * s2 + 4], s[8 * s2 + 5]); pw.w = cvt_pk_bf16(s[8 * s2 + 6], s[8 * s2 + 7]);
                const bf16x8 pf = __builtin_bit_cast(bf16x8, pw);
                const LAS unsigned char* v0p = vb + n * VP + (sub * 32 + 16 * s2 + 4 * hf) * 2; const LAS unsigned char* v1p = v0p + 32 * VP;
                const u32x2 a0 = *(const LAS u32x2*)v0p, a1 = *(const LAS u32x2*)(v0p + 16), b0 = *(const LAS u32x2*)v1p, b1 = *(const LAS u32x2*)(v1p + 16);
                const u32x4 va = (u32x4){a0.x, a0.y, a1.x, a1.y}, vbv = (u32x4){b0.x, b0.y, b1.x, b1.y};
                o0 = __builtin_amdgcn_mfma_f32_32x32x16_bf16(__builtin_bit_cast(bf16x8, va), pf, o0, 0, 0, 0);
                o1 = __builtin_amdgcn_mfma_f32_32x32x16_bf16(__builtin_bit_cast(bf16x8, vbv), pf, o1, 0, 0, 0);
            }
        }
        if (st + 1 < nst) ATT_LSTORE((st + 1) & 1);
        __syncthreads();
    }
    if (!IS_RET) {
        bf16_t* Y = (bf16_t*)((unsigned char*)C.out + 33554432) + (size_t)1 * M * 256;
        lrun += shx(lrun, 32, C.lane);
        const float inv = 1.0f / lrun;
        bf16_t* yp = Y + (size_t)(row0 + n) * 256 + h * 64 + 4 * hf;
#pragma unroll
        for (int g4 = 0; g4 < 4; ++g4) {
            u32x2 w0, w1; w0.x = cvt_pk_bf16(o0[4 * g4] * inv, o0[4 * g4 + 1] * inv); w0.y = cvt_pk_bf16(o0[4 * g4 + 2] * inv, o0[4 * g4 + 3] * inv);
            w1.x = cvt_pk_bf16(o1[4 * g4] * inv, o1[4 * g4 + 1] * inv); w1.y = cvt_pk_bf16(o1[4 * g4 + 2] * inv, o1[4 * g4 + 3] * inv);
            *(u32x2*)(yp + 8 * g4) = w0; *(u32x2*)(yp + 32 + 8 * g4) = w1;
        }
    } else {
        bf16_t* Y = (bf16_t*)((unsigned char*)C.out + 33554432) + (size_t)2 * M * 256;
        if (lat) {
            const bf16_t* S0T = (const bf16_t*)(C.ws + WS_S0T);
#pragma unroll
            for (int dir = 0; dir < 2; ++dir) {
                const bf16_t* stp = S0T + ((((size_t)b * 2 + l) * 2 + dir) * 4 + h) * 4096;
                f32x16 a0, a1;
#pragma unroll
                for (int r = 0; r < 16; ++r) { a0[r] = 0.f; a1[r] = 0.f; }
#pragma unroll
                for (int ks = 0; ks < 4; ++ks) {
                    const bf16x8 s0 = *(const bf16x8*)(stp + (size_t)n * 64 + ks * 16 + hf * 8), s1 = *(const bf16x8*)(stp + (size_t)(32 + n) * 64 + ks * 16 + hf * 8);
                    a0 = __builtin_amdgcn_mfma_f32_32x32x16_bf16(s0, qf[ks], a0, 0, 0, 0);
                    a1 = __builtin_amdgcn_mfma_f32_32x32x16_bf16(s1, qf[ks], a1, 0, 0, 0);
                }
                const float w = dir == 0 ? exp2f(lgf * (float)(tq + 1)) : exp2f(lgb * (float)(L - tq));
#pragma unroll
                for (int r = 0; r < 16; ++r) { o0[r] += w * a0[r]; o1[r] += w * a1[r]; }
            }
        }
        const bf16_t* gp = URET + (size_t)(row0 + n) * 1024 + 768 + h * 64 + 4 * hf;
        u32x2 gav[4], gbv[4];
#pragma unroll
        for (int g4 = 0; g4 < 4; ++g4) { gav[g4] = *(const u32x2*)(gp + 8 * g4); gbv[g4] = *(const u32x2*)(gp + 32 + 8 * g4); }
        float sm = 0.f;
#pragma unroll
        for (int r = 0; r < 16; ++r) sm += o0[r] + o1[r];
        sm += shx(sm, 32, C.lane);
        const float mu = sm * (1.0f / 64.0f);
        float vr = 0.f;
#pragma unroll
        for (int r = 0; r < 16; ++r) { const float d0 = o0[r] - mu, d1 = o1[r] - mu; vr += d0 * d0 + d1 * d1; }
        vr += shx(vr, 32, C.lane);
        const float rs = rsqrtf(vr * (1.0f / 64.0f) + 1e-6f);
        bf16_t* yp = Y + (size_t)(row0 + n) * 256 + h * 64 + 4 * hf;
#pragma unroll
        for (int g4 = 0; g4 < 4; ++g4) {
            const u32x2 ga = gav[g4], gb = gbv[g4];
            const float g0[4] = {bflo(ga.x), bfhi(ga.x), bflo(ga.y), bfhi(ga.y)}, g1[4] = {bflo(gb.x), bfhi(gb.x), bflo(gb.y), bfhi(gb.y)};
            float y0[4], y1[4];
#pragma unroll
            for (int j = 0; j < 4; ++j) { y0[j] = (o0[4 * g4 + j] - mu) * rs * (g0[j] * sigmoidf_(g0[j])); y1[j] = (o1[4 * g4 + j] - mu) * rs * (g1[j] * sigmoidf_(g1[j])); }
            u32x2 w0, w1; w0.x = cvt_pk_bf16(y0[0], y0[1]); w0.y = cvt_pk_bf16(y0[2], y0[3]); w1.x = cvt_pk_bf16(y1[0], y1[1]); w1.y = cvt_pk_bf16(y1[2], y1[3]);
            *(u32x2*)(yp + 8 * g4) = w0; *(u32x2*)(yp + 32 + 8 * g4) = w1;
        }
    }
    __syncthreads();
}

__device__ __forceinline__ void ret_state(const Ctx& C0, int l0) { const int l = launder_s(l0); const Ctx C = launder(C0); const float* in25 = INF(25);
    const bf16_t* URET = (const bf16_t*)(C.ws + WS_AR + A_URET);
    float* out = C.out + 19398656;
    LAS unsigned char* ksm = C.ldsL; LAS unsigned char* vsm = C.ldsL + 256 * 144;
    for (int item = C.bid; item < 256; item += C.G) {
        const int b = item >> 3, h = (item >> 1) & 3, dir = item & 1;
        const float lg = log2_sigmoid(in25[(l * 2 + dir) * 4 + h]);
        __syncthreads();
#pragma unroll
        for (int j = 0; j < 4; ++j) { const int row = (C.tid >> 3) + 64 * j, ch = C.tid & 7; const bf16_t* rp = URET + (size_t)(b * 256 + row) * 1024 + h * 64 + ch * 8;
            *(LAS u32x4*)(ksm + row * 144 + ch * 16) = *(const u32x4*)(rp + 256); *(LAS u32x4*)(vsm + row * 144 + ch * 16) = *(const u32x4*)(rp + 512); }
        __syncthreads();
        const int dk = C.tid >> 3, dv8 = C.tid & 7;
        float a[8];
#pragma unroll
        for (int j = 0; j < 8; ++j) a[j] = 0.f;
#pragma unroll 4
        for (int s = 0; s < 256; ++s) {
            const float w = exp2f(lg * (float)(dir == 0 ? 255 - s : s)) * 0.125f;
            const float kk = bf2f(*(const LAS bf16_t*)(ksm + s * 144 + dk * 2)) * w;
            const u32x4 v = *(const LAS u32x4*)(vsm + s * 144 + dv8 * 16);
            a[0] += kk * bflo(v.x); a[1] += kk * bfhi(v.x); a[2] += kk * bflo(v.y); a[3] += kk * bfhi(v.y);
            a[4] += kk * bflo(v.z); a[5] += kk * bfhi(v.z); a[6] += kk * bflo(v.w); a[7] += kk * bfhi(v.w);
        }
        float* op = out + ((((size_t)b * 2 + l) * 2 + dir) * 4 + h) * 4096 + dk * 64 + dv8 * 8;
        *(f32x4*)op = (f32x4){a[0], a[1], a[2], a[3]}; *(f32x4*)(op + 4) = (f32x4){a[4], a[5], a[6], a[7]};
    }
    __syncthreads();
}

__device__ __forceinline__ void merge_phase(const Ctx& C0, int l0) { const int l = launder_s(l0); const Ctx C = launder(C0); const float* gbias = INF(33) + l * 4096;
    const bf16_t* YB = (const bf16_t*)((unsigned char*)C.out + 33554432); const bf16_t* BO = (const bf16_t*)(C.ws + WS_W + W_BOUT);
    const unsigned char* GT = (const unsigned char*)(C.ws + WS_AR + A_GT); bf16_t* MG = (bf16_t*)C.out;
    constexpr int AP = 72;
    constexpr int ABYTES = 256 * AP * 2, BBYTES = 128 * AP * 2, SBYTES = ABYTES + BBYTES;
    const int wm = C.wid >> 1, wn = C.wid & 1, n = C.lane & 31, hf = C.lane >> 5;
    for (int tile = C.bid; tile < 512; tile += C.G) {
        int pm = tile >> 3, pn = tile & 7;
        if (C.G == 256) { const int x = C.bid & 7, j = C.bid >> 3; pm = x * 4 + (j >> 3) + 32 * (tile >> 8); pn = j & 7; }
        f32x16 acc[2][2], tot[2][2];
#pragma unroll
        for (int a = 0; a < 2; ++a)
#pragma unroll
            for (int b = 0; b < 2; ++b)
#pragma unroll
                for (int r = 0; r < 16; ++r) { acc[a][b][r] = 0.f; tot[a][b][r] = 0.f; }
        u32x4 ra[4], rb[2];
        auto gload = [&](int it) {
            const int br = it >> 2, kc = it & 3;
#pragma unroll
            for (int j = 0; j < 4; ++j) { const int q = C.tid + NT * j, row = q >> 3, kp = q & 7; ra[j] = *(const u32x4*)(YB + ((size_t)br * M + pm * 256 + row) * 256 + kc * 64 + kp * 8); }
#pragma unroll
            for (int j = 0; j < 2; ++j) { const int q = C.tid + NT * j, col = q >> 3, kp = q & 7; rb[j] = *(const u32x4*)(BO + ((size_t)br * 1024 + pn * 128 + col) * 256 + kc * 64 + kp * 8); }
        };
        auto lstore = [&](int buf) {
            LAS unsigned char* sa = C.ldsL + buf * SBYTES; LAS unsigned char* sbp = sa + ABYTES;
#pragma unroll
            for (int j = 0; j < 4; ++j) { const int q = C.tid + NT * j, row = q >> 3, kp = q & 7; *(LAS u32x4*)(sa + (row * AP + kp * 8) * 2) = ra[j]; }
#pragma unroll
            for (int j = 0; j < 2; ++j) { const int q = C.tid + NT * j, col = q >> 3, kp = q & 7; *(LAS u32x4*)(sbp + (col * AP + kp * 8) * 2) = rb[j]; }
        };
        __syncthreads();
        ((LAS float*)(C.ldsL + 2 * SBYTES))[C.tid] = gbias[(C.tid >> 7) * 1024 + pn * 128 + (C.tid & 127)];
        gload(0); lstore(0);
        __syncthreads();
        for (int it = 0; it < 16; ++it) {
            if (it < 15) gload(it + 1);
            unsigned gwq[2][4];
            if ((it & 3) == 3) {
#pragma unroll
                for (int nt = 0; nt < 2; ++nt)
#pragma unroll
                    for (int g4 = 0; g4 < 4; ++g4)
                        gwq[nt][g4] = *(const unsigned*)(GT + ((size_t)pm * 256 + wm * 64 + n) * 4096 + (it >> 2) * 1024 + pn * 128 + wn * 64 + nt * 32 + 4 * hf + 8 * g4);
            }
            const LAS unsigned char* sa = C.ldsL + (it & 1) * SBYTES; const LAS unsigned char* sbp = sa + ABYTES;
#pragma unroll
            for (int kk = 0; kk < 4; ++kk) {
                bf16x8 af[2], bfr[2];
#pragma unroll
                for (int mt = 0; mt < 2; ++mt) af[mt] = *(const LAS bf16x8*)(sa + ((wm * 64 + mt * 32 + n) * AP + kk * 16 + hf * 8) * 2);
#pragma unroll
                for (int nt = 0; nt < 2; ++nt) bfr[nt] = *(const LAS bf16x8*)(sbp + ((wn * 64 + nt * 32 + n) * AP + kk * 16 + hf * 8) * 2);
#pragma unroll
                for (int mt = 0; mt < 2; ++mt)
#pragma unroll
                    for (int nt = 0; nt < 2; ++nt) acc[mt][nt] = __builtin_amdgcn_mfma_f32_32x32x16_bf16(bfr[nt], af[mt], acc[mt][nt], 0, 0, 0);
            }
            if ((it & 3) == 3) {
                const int br = it >> 2;
#pragma unroll
                for (int mt = 0; mt < 2; ++mt) {
                    const size_t R = (size_t)pm * 256 + wm * 64 + mt * 32 + n;
#pragma unroll
                    for (int nt = 0; nt < 2; ++nt) {
#pragma unroll
                        for (int g4 = 0; g4 < 4; ++g4) { const int gw = mt == 0 ? (int)gwq[nt][g4] : (int)*(const unsigned*)(GT + R * 4096 + br * 1024 + pn * 128 + wn * 64 + nt * 32 + 4 * hf + 8 * g4); const f32x4 gb4 = *(const LAS f32x4*)(C.ldsL + 2 * SBYTES + (br * 128 + wn * 64 + nt * 32 + 4 * hf + 8 * g4) * 4);
                            const float q0 = sigmoidf_(__builtin_amdgcn_cvt_f32_fp8(gw, 0) + gb4[0]), q1 = sigmoidf_(__builtin_amdgcn_cvt_f32_fp8(gw, 1) + gb4[1]), q2 = sigmoidf_(__builtin_amdgcn_cvt_f32_fp8(gw, 2) + gb4[2]), q3 = sigmoidf_(__builtin_amdgcn_cvt_f32_fp8(gw, 3) + gb4[3]);
                            tot[mt][nt][4 * g4] += q0 * acc[mt][nt][4 * g4]; tot[mt][nt][4 * g4 + 1] += q1 * acc[mt][nt][4 * g4 + 1];
                            tot[mt][nt][4 * g4 + 2] += q2 * acc[mt][nt][4 * g4 + 2]; tot[mt][nt][4 * g4 + 3] += q3 * acc[mt][nt][4 * g4 + 3]; }
#pragma unroll
                        for (int r = 0; r < 16; ++r) acc[mt][nt][r] = 0.f;
                    }
                }
            }
            if (it < 15) lstore((it + 1) & 1);
            __syncthreads();
        }
#pragma unroll
        for (int mt = 0; mt < 2; ++mt) {
            const size_t R = (size_t)pm * 256 + wm * 64 + mt * 32 + n;
#pragma unroll
            for (int nt = 0; nt < 2; ++nt) {
                bf16_t* op = MG + R * 1024 + pn * 128 + wn * 64 + nt * 32 + 4 * hf;
#pragma unroll
                for (int g4 = 0; g4 < 4; ++g4) { u32x2 w; w.x = cvt_pk_bf16(tot[mt][nt][4 * g4], tot[mt][nt][4 * g4 + 1]); w.y = cvt_pk_bf16(tot[mt][nt][4 * g4 + 2], tot[mt][nt][4 * g4 + 3]); *(u32x2*)(op + 8 * g4) = w; }
            }
        }
    }
    __syncthreads();
}

#define XB_TMO      128
#define XB_XCNT(j)  (256  + 64 * (j))
#define XB_XSUB(j)  (1280 + 64 * (j))
#define XB_XGEN(j)  (2304 + 64 * (j))
#define XB_TOP      3328
#define XB_TOPGEN   3392
#define XCD_BAR_WORDS 3456
#define XB_SPIN_CAP (1u << 20)
__device__ __forceinline__ unsigned xb_ld(unsigned* p)              { return __hip_atomic_load(p, __ATOMIC_RELAXED, __HIP_MEMORY_SCOPE_AGENT); }
__device__ __forceinline__ unsigned xb_add(unsigned* p, unsigned v) { return __hip_atomic_fetch_add(p, v, __ATOMIC_RELAXED, __HIP_MEMORY_SCOPE_AGENT); }
__device__ __forceinline__ unsigned xb_xcc_id() { return (unsigned)__builtin_amdgcn_s_getreg((3 << 11) | 20) & 0xFu; }
#define XB_SPIN(cond, bar) do { unsigned _sp = 0; while (cond) { __builtin_amdgcn_s_sleep(1); \
    if ((++_sp & 255u) == 0u) { if (xb_ld(&(bar)[XB_TMO])) break; if (_sp > XB_SPIN_CAP) { atomicAdd(&(bar)[XB_TMO], 1u); break; } } } } while (0)
__device__ __forceinline__ void xcd_barrier_complete(unsigned* bar, unsigned x, unsigned G, unsigned& nloc, unsigned& nx) {
    unsigned sum, cnt, mine, sp = 0u;
    for (;;) {
        sum = 0u; cnt = 0u; mine = 0u;
#pragma unroll
        for (unsigned j = 0; j < 16; ++j) { const unsigned c = xb_ld(&bar[XB_XCNT(j)]); sum += c; cnt += (c > 0u) ? 1u : 0u; mine = (j == x) ? c : mine; }
        if (sum == G) break;
        __builtin_amdgcn_s_sleep(1);
        if ((++sp & 255u) == 0u) { if (xb_ld(&bar[XB_TMO])) break; if (sp > XB_SPIN_CAP) { atomicAdd(&bar[XB_TMO], 1u); break; } }
    }
    nloc = mine > 0u ? mine : 1u; nx = cnt > 0u ? cnt : 1u;
}
__device__ __forceinline__ void grid_bar(unsigned* bar, volatile LAS unsigned* st, unsigned G, int wid, int lane) {
    asm volatile("s_waitcnt vmcnt(0)" ::: "memory");
    __syncthreads();
    if (wid == 0 && lane == 0) {
        __builtin_amdgcn_s_waitcnt(0);
        const unsigned x = xb_xcc_id();
        unsigned nloc = st[0], nx = st[1];
        if (nloc == 0u) { xcd_barrier_complete(bar, x, G, nloc, nx); st[0] = nloc; st[1] = nx; }
        const unsigned old = xb_add(&bar[XB_XSUB(x)], 1u);
        const unsigned gen = old / nloc;
        if (old + 1u == (gen + 1u) * nloc) {
            __builtin_amdgcn_fence(__ATOMIC_RELEASE, "agent");
            asm volatile("s_waitcnt vmcnt(0)" ::: "memory");
            const unsigned og = xb_add(&bar[XB_TOP], 1u);
            const unsigned tg = og / nx;
            if (og + 1u == (tg + 1u) * nx) xb_add(&bar[XB_TOPGEN], 1u);
            else XB_SPIN(xb_ld(&bar[XB_TOPGEN]) == tg, bar);
            __builtin_amdgcn_fence(__ATOMIC_ACQUIRE, "agent");
            xb_add(&bar[XB_XGEN(x)], 1u);
            asm volatile("s_waitcnt vmcnt(0)" ::: "memory");
        } else {
            XB_SPIN(xb_ld(&bar[XB_XGEN(x)]) == gen, bar);
            __builtin_amdgcn_fence(__ATOMIC_ACQUIRE, "agent");
            asm volatile("s_waitcnt vmcnt(0)" ::: "memory");
        }
    }
    __syncthreads();
}
__global__ void __launch_bounds__(NT, 2) fwd_megakernel(Params prm) {
    extern __shared__ __attribute__((aligned(16))) unsigned char lds[];
    cg::grid_group grid = cg::this_grid();
    LAS unsigned long long* tabw = (LAS unsigned long long*)((LAS unsigned char*)lds + 131072);
    if (threadIdx.x < 39) tabw[threadIdx.x] = (unsigned long long)prm.in[threadIdx.x];
    __syncthreads();
    Ctx Cm; { Ctx& C = Cm; C.tab = (const LAS unsigned*)tabw; C.out = prm.out; C.ws = prm.ws; C.lds = lds; C.ldsL = (LAS unsigned char*)lds; C.tid = threadIdx.x; C.lane = C.tid & 63; C.wid = __builtin_amdgcn_readfirstlane(C.tid >> 6); C.bid = blockIdx.x; C.G = gridDim.x; }
    const Ctx& C = Cm;
    bf16_t* X = (bf16_t*)(prm.ws + WS_HB);
#define PH_PTRS const Ctx C = launder(Cm); const int lq = launder_s(l); (void)lq; unsigned char* ws = C.ws; asm volatile("" : "+s"(ws)); unsigned char* AR = ws + WS_AR; unsigned char* W = ws + WS_W; (void)AR; (void)W;

    const int lo = prm.ph_lo, hi = prm.ph_hi;
    int ph = 0;
    unsigned* barw = (unsigned*)(prm.ws + WS_BAR);
#define GSYNC() do { const Ctx Cb = launder(C); grid_bar(barw, (volatile LAS unsigned*)((LAS unsigned char*)lds + 131072 + 384), (unsigned)Cb.G, Cb.wid, Cb.lane); } while (0)
#define PH_BEGIN if (ph >= lo && ph < hi) { for (int rep_ = 0; rep_ < 1 + (int)((DUP_MASK >> ph) & 1u); ++rep_) { if (rep_) __syncthreads();
#define PH_END } } if (ph >= lo && ph + 1 < hi) { GSYNC(); if (ph == 0) for (int xb_ = 0; xb_ < EXTRA_BAR; ++xb_) GSYNC(); } ++ph;
    if (hi - lo > 1) {
        if (threadIdx.x < 2) ((LAS unsigned*)((LAS unsigned char*)lds + 131072 + 384))[threadIdx.x] = 0u;
        if (blockIdx.x == 0) for (int i = threadIdx.x; i < XCD_BAR_WORDS; i += NT) __hip_atomic_store(barw + i, 0u, __ATOMIC_RELAXED, __HIP_MEMORY_SCOPE_AGENT);
        asm volatile("s_waitcnt vmcnt(0)" ::: "memory"); __builtin_amdgcn_fence(__ATOMIC_RELEASE, "agent"); asm volatile("s_waitcnt vmcnt(0)" ::: "memory");
        grid.sync();
        __builtin_amdgcn_fence(__ATOMIC_ACQUIRE, "agent"); asm volatile("s_waitcnt vmcnt(0)" ::: "memory");
        if (threadIdx.x == 0) (void)xb_add(&barw[XB_XCNT(xb_xcc_id())], 1u);
        __syncthreads();
    }
    PH_BEGIN p0_mod(C); p0_filters(C); p0_misc(C); PH_END
    for (int l = 0; l < 2; ++l) {
        PH_BEGIN
        norm_phase(C, l, 0);
        convert_weights(C, l);
        if (l == 0) build_rg(C);
        PH_END
        PH_BEGIN
        { PH_PTRS pg8::Gemm g{(const bf16_t*)C.out, (const bf16_t*)(W + W_PROJ), M, 2816, 1024}; pg8::StaticOrder S; S.init(M, 2816, C.G, C.bid);
          pg8::EpiProj E{(bf16_t*)(AR + A_UHY), (bf16_t*)(AR + A_UMLA), (bf16_t*)(AR + A_URET), (bf16_t*)(AR + A_UCONF)};
          pg8::gemm_phase<pg8::EpiProj>(C.ldsL, g, S, E, C.wid); }
        PH_END
        PH_BEGIN prep_phase(C, l); PH_END
        PH_BEGIN
        { PH_PTRS pg8::Gemm g{(const bf16_t*)(AR + A_CQN), (const bf16_t*)(W + W_UQ), M, 512, 256}; pg8::StaticOrder S; S.init(M, 512, C.G, C.bid);
          pg8::EpiPlain E{(bf16_t*)(AR + A_Q), 384, 384};
          pg8::gemm_phase<pg8::EpiPlain>(C.ldsL, g, S, E, C.wid); }
        { PH_PTRS pg8::Gemm g{(const bf16_t*)(AR + A_CKN), (const bf16_t*)(W + W_UK), NKEY, 256, 256}; pg8::StaticOrder S; S.init(NKEY, 256, C.G, (C.bid + C.G - 128) % C.G);
          pg8::EpiPlain E{(bf16_t*)(AR + A_KN), 256, 256};
          pg8::gemm_phase<pg8::EpiPlain>(C.ldsL, g, S, E, C.wid); }
        { PH_PTRS pg8::Gemm g{(const bf16_t*)(W + W_UV), (const bf16_t*)(AR + A_CKN), 256, NKEY, 256}; pg8::StaticOrder S; S.init(256, NKEY, C.G, (C.bid + C.G - 196) % C.G);
          pg8::EpiPlain E{(bf16_t*)(AR + A_VT), NKEY, NKEY};
          pg8::gemm_phase<pg8::EpiPlain>(C.ldsL, g, S, E, C.wid); }
        hyena_phase(C, l);
        PH_END
        PH_BEGIN
        { const Ctx Ca = launder(C);
          for (int p0_ = Ca.bid; p0_ < 256; p0_ += Ca.G) {
              const int p = (Ca.G == 256) ? ((p0_ & 7) * 32 + (p0_ >> 3)) : p0_;
              const int q = p & 127; const bool first = p < 128;
              att_block<false>(C, l, first, first ? (q >> 5) : (q >> 2), first ? ((q >> 3) & 3) : (q & 3), first ? (q & 7) : 0);
              att_block<true>(C, l, !first, first ? (q >> 2) : (q >> 5), first ? (q & 3) : ((q >> 3) & 3), first ? 0 : (q & 7));
          }
          ret_state(C, l); }
        PH_END
        PH_BEGIN
        { PH_PTRS pg8::Gemm g{(const bf16_t*)C.out, (const bf16_t*)(W + W_GATE), M, 4096, 1024}; pg8::StaticOrder S; S.init(M, 4096, C.G, C.bid);
          pg8::EpiGate E{(unsigned char*)(AR + A_GT), 4096};
          pg8::gemm_phase<pg8::EpiGate>(C.ldsL, g, S, E, C.wid); }
        PH_END
        PH_BEGIN merge_phase(C, l); PH_END
        PH_BEGIN
        { PH_PTRS pg8::Gemm g{(const bf16_t*)C.out, (const bf16_t*)(W + W_O), M, 1024, 1024}; pg8::StaticOrder S; S.init(M, 1024, C.G, C.bid);
          pg8::EpiResid E{X, (const float*)(ws + WS_MOD) + (size_t)lq * 5 * 6144 + 2048};
          pg8::gemm_phase<pg8::EpiResid>(C.ldsL, g, S, E, C.wid); }
        PH_END
        PH_BEGIN norm_phase(C, l, 1); PH_END
        PH_BEGIN
        { PH_PTRS pg8::Gemm g{(const bf16_t*)C.out, (const bf16_t*)(W + W_1), M, 5632, 1024}; pg8::StaticOrder S; S.init(M, 5632, C.G, C.bid);
          pg8::EpiFfn1 E{(bf16_t*)(AR + A_ACT)};
          pg8::gemm_phase<pg8::EpiFfn1>(C.ldsL, g, S, E, C.wid); }
        PH_END
        PH_BEGIN
        { PH_PTRS pg8::Gemm g{(const bf16_t*)(AR + A_ACT), (const bf16_t*)(W + W_2), M, 1024, 2816}; pg8::StaticOrder S; S.init(M, 1024, C.G, C.bid);
          pg8::EpiResid E{X, (const float*)(ws + WS_MOD) + (size_t)lq * 5 * 6144 + 5120};
          pg8::gemm_phase<pg8::EpiResid>(C.ldsL, g, S, E, C.wid); }
        PH_END
    }
    PH_BEGIN final_norm(C); PH_END
}

extern "C" void kernel_launch(void* const* d_in, const int* in_sizes, int n_in, void* d_out, int out_size, void* d_ws, size_t ws_size, hipStream_t stream) {
    static int grid = 0;
    if (grid == 0) {
        if (n_in != 39 || ws_size < WS_NEED) { fprintf(stderr, "kernel_launch: unexpected n_in %d / ws_size %zu (need %zu)\n", n_in, ws_size, (size_t)WS_NEED); grid = -1; return; }
        int dev = 0, cus = 0, per_cu = 0;
        hipGetDevice(&dev);
        hipDeviceGetAttribute(&cus, hipDeviceAttributeMultiprocessorCount, dev);
        if (hipFuncSetAttribute((const void*)fwd_megakernel, hipFuncAttributeMaxDynamicSharedMemorySize, LDS_BYTES) != hipSuccess) { fprintf(stderr, "kernel_launch: hipFuncSetAttribute failed\n"); grid = -1; return; }
        if (hipOccupancyMaxActiveBlocksPerMultiprocessor(&per_cu, (const void*)fwd_megakernel, NT, LDS_BYTES) != hipSuccess || per_cu < 1) { fprintf(stderr, "kernel_launch: occupancy query gives %d\n", per_cu); per_cu = 1; }
        (void)hipGetLastError();
        grid = cus;
    }
    if (grid < 0) return;
    Params p{};
    for (int i = 0; i < 39; ++i) p.in[i] = (const float*)d_in[i];
    p.out = (float*)d_out; p.ws = (unsigned char*)d_ws;
    if (hipMemsetAsync((unsigned char*)d_ws + WS_BAR, 0, 16384, stream) != hipSuccess) { fprintf(stderr, "memset failed\n"); return; }
#if MK_PER_PHASE
    for (int k = 0; k < 24; ++k) { p.ph_lo = k; p.ph_hi = k + 1; hipLaunchKernelGGL(fwd_megakernel, dim3(grid), dim3(NT), LDS_BYTES, stream, p); }
#else
    p.ph_lo = 0; p.ph_hi = 24;
    void* args[] = {&p};
    hipError_t e = hipLaunchCooperativeKernel((const void*)fwd_megakernel, dim3(grid), dim3(NT), args, LDS_BYTES, stream);
    if (e != hipSuccess) fprintf(stderr, "cooperative launch failed: %s (grid %d)\n", hipGetErrorString(e), grid);
#endif
}
```

```cpp
#include <hip/hip_runtime.h>
#include <hip/hip_cooperative_groups.h>
#include <cstdio>
namespace cg = cooperative_groups;

#define LAS __attribute__((address_space(3)))
typedef unsigned short bf16_t;
typedef short bf16x8 __attribute__((ext_vector_type(8)));
typedef short bf16x4 __attribute__((ext_vector_type(4)));
typedef float f32x4 __attribute__((ext_vector_type(4)));
typedef float f32x2 __attribute__((ext_vector_type(2)));
typedef float f32x16 __attribute__((ext_vector_type(16)));
typedef unsigned u32x4 __attribute__((ext_vector_type(4)));
typedef unsigned u32x2 __attribute__((ext_vector_type(2)));

constexpr int M = 16384, D = 1024, MC = 8192, NKEY = 17408, DFF = 2816;
constexpr int LDS_BYTES = 131072 + 512;
constexpr int NT = 512;
#ifndef DBG_FFN
#define DBG_FFN 1
#define DBG_WO 1
#define DBG_HYCONV 1
#endif
#ifndef MK_PER_PHASE
#define MK_PER_PHASE 0
#endif
#ifndef DUP_MASK
#define DUP_MASK 0u
#endif
#ifndef EXTRA_BAR
#define EXTRA_BAR 0
#endif
#ifndef DBG_MASK
#define DBG_MASK 0
#define DBG_GATEHALF 0
#endif

constexpr size_t WS_BAR = 0;
constexpr size_t WS_MOD = 16384;
constexpr size_t WS_ROPE = WS_MOD + 245760;
constexpr size_t WS_S0T = WS_ROPE + 262144;
constexpr size_t WS_HP = WS_S0T + 524288;
constexpr size_t WS_RG = WS_HP + 294912;
constexpr size_t RG_LAYER = 4718592;
constexpr size_t WS_W = WS_RG + 2 * RG_LAYER;
constexpr size_t W_PROJ = 0, W_GATE = W_PROJ + 5767168, W_O = W_GATE + 8388608, W_1 = W_O + 2097152, W_2 = W_1 + 11534336,
                 W_BOUT = W_2 + 5767168, W_UQ = W_BOUT + 2097152, W_UK = W_UQ + 262144, W_UV = W_UK + 131072, W_TOTAL = W_UV + 131072;
constexpr size_t WS_HB = WS_W + W_TOTAL;
constexpr size_t WS_YB = WS_HB + 33554432;
constexpr size_t WS_AR = WS_YB + 33554432;
constexpr size_t A_UHY = 0, A_UMLA = A_UHY + 25165824, A_UCONF = A_UMLA + 13631488, A_URET = A_UCONF + 16777216,
                 A_ZT = A_URET + 33554432, A_CQN = A_ZT + 25165824, A_CKN = A_CQN + 8388608, A_KR = A_CKN + 8912896,
                 A_RVT = A_KR + 1114112, A_END = A_RVT + 8388608;
constexpr size_t A_Q = 0, A_KN = A_Q + 12582912, A_VT = A_KN + 8912896;
constexpr size_t A_GT = 0, A_ACT = 0, A_HRAW = 0;
constexpr size_t WS_NEED = WS_AR + A_END;
static_assert(A_VT + 8912896 <= A_UCONF, "alias");
static_assert(WS_NEED <= 268435456ull, "ws");

struct Params { const float* in[39]; float* out; unsigned char* ws; int ph_lo, ph_hi; };

__device__ __forceinline__ unsigned cvt_pk_bf16(float lo, float hi) { unsigned r; asm("v_cvt_pk_bf16_f32 %0, %1, %2" : "=v"(r) : "v"(lo), "v"(hi)); return r; }
__device__ __forceinline__ bf16_t f2bf(float f) { return (bf16_t)(cvt_pk_bf16(f, 0.f) & 0xffffu); }
__device__ __forceinline__ float bf2f(bf16_t b) { return __uint_as_float(((unsigned)b) << 16); }
__device__ __forceinline__ float bflo(unsigned w) { return __uint_as_float(w << 16); }
__device__ __forceinline__ float bfhi(unsigned w) { return __uint_as_float(w & 0xffff0000u); }
__device__ __forceinline__ float sigmoidf_(float x) { return __builtin_amdgcn_rcpf(1.0f + __expf(-x)); }
__device__ __forceinline__ int lane_id_v() { int l; asm volatile("v_mbcnt_lo_u32_b32 %0, -1, 0\n\tv_mbcnt_hi_u32_b32 %0, -1, %0" : "=v"(l)); return l; }
__device__ __forceinline__ float shx(float v, int mask, int lane) { return __int_as_float(__builtin_amdgcn_ds_bpermute((lane ^ mask) << 2, __float_as_int(v))); }
__device__ __forceinline__ float wave_sum_l(float v, int lane) {
#pragma unroll
    for (int o = 32; o >= 1; o >>= 1) v += shx(v, o, lane);
    return v;
}
__device__ __forceinline__ int midx_of_row(int row) { return row < MC ? 0 : 1 + ((row - MC) >> 11); }

namespace pg8 {
constexpr int BM = 256, BK = 64, HALF = 128, HTB = HALF * BK * 2, STAGE_BYTES = 8 * HTB, NXCD = 8, WGM = 8;
__host__ __device__ __forceinline__ int lds_byte(int r, int c) { const int st = (r >> 4) * 2 + (c >> 5), rr = r & 15, cc = c & 31, ob = rr * 64 + cc * 2; return st * 1024 + (ob ^ (((ob >> 9) & 1) << 5)); }
__host__ __device__ __forceinline__ void stage_rc(int b, int& R, int& C) { const int st = b / 1024, sb = b % 1024, swz = sb ^ (((sb >> 9) & 1) << 5); R = (st >> 1) * 16 + swz / 64; C = (st & 1) * 32 + (swz % 64) / 2; }
__host__ __device__ __forceinline__ int perm32(int rho) { const int n = rho >> 4, i = rho & 15; return 8 * (i >> 2) + 4 * n + (i & 3); }
struct Unit { int pm, pn; };
struct Gemm { const bf16_t* A; const bf16_t* Bt; int M, N, K; };
struct StaticOrder {
    int nM, nN, nwg, G, c;
    __device__ void init(int M_, int N_, int G_, int c_) { nM = M_ / BM; nN = N_ / BM; nwg = nM * nN; G = G_; c = c_; }
    __device__ bool next(int i, Unit& u) const {
        const long L = (long)i * G + c; if (L >= nwg) return false;
        int wgid = (int)L; { const int q = nwg / NXCD, r = nwg % NXCD, xcd = wgid % NXCD, off = wgid / NXCD; wgid = (xcd < r ? xcd * (q + 1) : r * (q + 1) + (xcd - r) * q) + off; }
        const int nig = WGM * nN, gid = wgid / nig, fm = gid * WGM, gsz = (nM - fm) < WGM ? (nM - fm) : WGM;
        u.pm = fm + ((wgid % nig) % gsz); u.pn = (wgid % nig) / gsz; return true;
    }
};

template <class Epi>
__device__ __forceinline__ void gemm_phase(LAS unsigned char* lds, const Gemm g, const StaticOrder& S, const Epi& E, int wid_in) {
    int ln_ = lane_id_v(); int w_ = wid_in; asm volatile("" : "+s"(w_));
    const int wid = w_, lane = ln_, tid = wid * 64 + lane, wr = wid >> 2, wc = wid & 3, fr = lane & 15, fq = lane >> 4;
    const int K = g.K, nt = K / BK;
    unsigned voffA[2], voffB[2];
#pragma unroll
    for (int i = 0; i < 2; ++i) { int R, C; stage_rc(tid * 16 + i * 8192, R, C); const int Rb = Epi::PERM ? ((R & ~31) + perm32(R & 31)) : R;
        voffA[i] = (unsigned)(R * K + C) * 2u; voffB[i] = (unsigned)(Rb * K + C) * 2u; }
    const size_t kstep = (size_t)(BK * 2);
    const size_t hstep = (size_t)HALF * K * 2;
    const size_t tstep = 2 * hstep;
    const unsigned ldsw = (unsigned)wid * 1024u;
    const int aoff = lds_byte(wr * 64 + fr, fq * 8), boff = lds_byte(wc * 32 + fr, fq * 8);
#define PG8_SA(b, h) (((b) * 2 + (h)) * HTB)
#define PG8_SB(b, h) ((4 + (b) * 2 + (h)) * HTB)
#define PG8_STAGE(bufoff, gbase, voff) do { _Pragma("unroll") for (int _i = 0; _i < 2; ++_i) \
        __builtin_amdgcn_global_load_lds((const unsigned*)((const char*)(gbase) + (voff)[_i]), (LAS unsigned*)(lds + (bufoff) + ldsw + _i * 8192), 16, 0, 0); } while (0)
#define PG8_LDA(dst, b, h) do { _Pragma("unroll") for (int m = 0; m < 4; ++m) _Pragma("unroll") for (int k = 0; k < 2; ++k) dst[m][k] = *(const LAS bf16x8*)(lds + PG8_SA(b, h) + aoff + m * 2048 + k * 1024); } while (0)
#define PG8_LDB(dst, b, h) do { _Pragma("unroll") for (int n = 0; n < 2; ++n) _Pragma("unroll") for (int k = 0; k < 2; ++k) dst[n][k] = *(const LAS bf16x8*)(lds + PG8_SB(b, h) + boff + n * 2048 + k * 1024); } while (0)
#define PG8_MMA(ai, bj, At, Bt) do { __builtin_amdgcn_s_setprio(1); _Pragma("unroll") for (int m = 0; m < 4; ++m) _Pragma("unroll") for (int n = 0; n < 2; ++n) _Pragma("unroll") for (int k = 0; k < 2; ++k) \
        acc[ai][bj][m][n] = __builtin_amdgcn_mfma_f32_16x16x32_bf16(Bt[n][k], At[m][k], acc[ai][bj][m][n], 0, 0, 0); __builtin_amdgcn_s_setprio(0); } while (0)
#define PG8_WAIT_V(n) asm volatile("s_waitcnt vmcnt(" #n ")" ::: "memory")
#define PG8_WAIT_L(n) asm volatile("s_waitcnt lgkmcnt(" #n ")" ::: "memory")
#define PG8_BAR __builtin_amdgcn_s_barrier()
#define PG8_SCHED __builtin_amdgcn_sched_barrier(0)
    Unit cur, nxt; int ui = 0;
    if (!S.next(0, cur)) return;
    f32x4 acc[2][2][4][2];
#pragma unroll
    for (int a = 0; a < 2; ++a)
#pragma unroll
        for (int b = 0; b < 2; ++b)
#pragma unroll
            for (int m = 0; m < 4; ++m)
#pragma unroll
                for (int n = 0; n < 2; ++n) acc[a][b][m][n] = (f32x4){0.f, 0.f, 0.f, 0.f};
    bf16x8 At[4][2], B0[2][2], B1[2][2];
    const char* cA = (const char*)g.A + (size_t)cur.pm * tstep; const char* cB = (const char*)g.Bt + (size_t)cur.pn * tstep;
    PG8_STAGE(PG8_SB(0, 0), cB, voffB); PG8_STAGE(PG8_SA(0, 0), cA, voffA); PG8_STAGE(PG8_SB(0, 1), cB + hstep, voffB); PG8_STAGE(PG8_SA(0, 1), cA + hstep, voffA);
    if (wr == 1) PG8_BAR;
    PG8_WAIT_V(4); PG8_BAR;
    PG8_STAGE(PG8_SB(1, 0), cB + kstep, voffB); PG8_STAGE(PG8_SA(1, 0), cA + kstep, voffA); PG8_STAGE(PG8_SB(1, 1), cB + hstep + kstep, voffB);
    PG8_WAIT_V(6); PG8_BAR;
    for (;;) {
        const bool has_next = S.next(ui + 1, nxt);
        const char* nA = has_next ? (const char*)g.A + (size_t)nxt.pm * tstep : cA; const char* nB = has_next ? (const char*)g.Bt + (size_t)nxt.pn * tstep : cB;
        for (int t = 0; t < nt; t += 2) {
            const bool last = (t == nt - 2);
            const char* a1 = cA + (size_t)(t + 1) * kstep;
            const char* a2 = last ? nA : cA + (size_t)(t + 2) * kstep; const char* b2 = last ? nB : cB + (size_t)(t + 2) * kstep;
            const char* a3 = a2 + kstep; const char* b3 = b2 + kstep;
            PG8_LDB(B0, 0, 0); PG8_SCHED; PG8_LDA(At, 0, 0); PG8_STAGE(PG8_SA(1, 1), a1 + hstep, voffA);
            PG8_WAIT_L(8); PG8_BAR; PG8_WAIT_L(0); PG8_MMA(0, 0, At, B0); PG8_BAR; PG8_SCHED;
            PG8_LDB(B1, 0, 1); PG8_STAGE(PG8_SB(0, 0), b2, voffB);
            PG8_BAR; PG8_WAIT_L(0); PG8_MMA(0, 1, At, B1); PG8_BAR;
            PG8_LDA(At, 0, 1); PG8_STAGE(PG8_SA(0, 0), a2, voffA);
            PG8_BAR; PG8_WAIT_L(0); PG8_MMA(1, 0, At, B0); PG8_BAR; PG8_SCHED;
            PG8_STAGE(PG8_SB(0, 1), b2 + hstep, voffB);
            PG8_WAIT_V(6); PG8_BAR; PG8_MMA(1, 1, At, B1); PG8_BAR;
            PG8_LDB(B0, 1, 0); PG8_SCHED; PG8_LDA(At, 1, 0); PG8_STAGE(PG8_SA(0, 1), a2 + hstep, voffA);
            PG8_WAIT_L(8); PG8_BAR; PG8_WAIT_L(0); PG8_MMA(0, 0, At, B0); PG8_BAR; PG8_SCHED;
            PG8_LDB(B1, 1, 1); PG8_STAGE(PG8_SB(1, 0), b3, voffB);
            PG8_BAR; PG8_WAIT_L(0); PG8_MMA(0, 1, At, B1); PG8_BAR;
            PG8_LDA(At, 1, 1); PG8_STAGE(PG8_SA(1, 0), a3, voffA);
            PG8_BAR; PG8_WAIT_L(0); PG8_MMA(1, 0, At, B0); PG8_BAR; PG8_SCHED;
            PG8_STAGE(PG8_SB(1, 1), b3 + hstep, voffB);
            PG8_WAIT_V(6); PG8_BAR; PG8_MMA(1, 1, At, B1); PG8_BAR;
        }
        { const int ln2 = lane_id_v(); E(acc, cur, wr, wc, ln2 & 15, ln2 >> 4); }
        if (!has_next) break;
#pragma unroll
        for (int a = 0; a < 2; ++a)
#pragma unroll
            for (int b = 0; b < 2; ++b)
#pragma unroll
                for (int m = 0; m < 4; ++m)
#pragma unroll
                    for (int n = 0; n < 2; ++n) acc[a][b][m][n] = (f32x4){0.f, 0.f, 0.f, 0.f};
        cur = nxt; cA = nA; cB = nB; ++ui;
    }
    PG8_WAIT_V(0);
    if (wr == 0) PG8_BAR;
    PG8_BAR;
#undef PG8_SA
#undef PG8_SB
#undef PG8_STAGE
#undef PG8_LDA
#undef PG8_LDB
#undef PG8_MMA
#undef PG8_WAIT_V
#undef PG8_WAIT_L
#undef PG8_BAR
#undef PG8_SCHED
}

typedef f32x4 Acc[2][2][4][2];

struct EpiProj {
    static constexpr bool PERM = true;
    bf16_t *uhy, *umla, *uret, *uconf;
    __device__ __forceinline__ void operator()(const Acc& acc, const Unit& u, int wr, int wc, int fr, int fq) const {
        const int row0 = u.pm * BM + wr * 64 + fr;
#pragma unroll
        for (int bj = 0; bj < 2; ++bj) {
            const int c0 = u.pn * BM + bj * HALF + wc * 32 + 8 * fq;
            bf16_t* p; int pitch;
            if (c0 < 768) { p = uhy + c0; pitch = 768; }
            else if (c0 < 1184) { p = umla + (c0 - 768); pitch = 416; }
            else if (c0 < 2208) { p = uret + (c0 - 1184); pitch = 1024; }
            else if (c0 < 2720) { p = uconf + (c0 - 2208); pitch = 512; }
            else continue;
#pragma unroll
            for (int ai = 0; ai < 2; ++ai)
#pragma unroll
                for (int m = 0; m < 4; ++m) {
                    const f32x4 v0 = acc[ai][bj][m][0], v1 = acc[ai][bj][m][1];
                    u32x4 w; w.x = cvt_pk_bf16(v0[0], v0[1]); w.y = cvt_pk_bf16(v0[2], v0[3]); w.z = cvt_pk_bf16(v1[0], v1[1]); w.w = cvt_pk_bf16(v1[2], v1[3]);
                    *(u32x4*)(p + (size_t)(row0 + ai * HALF + m * 16) * pitch) = w;
                }
        }
    }
};
struct EpiGate {
    static constexpr bool PERM = true;
    unsigned char* O; int ldc;
    __device__ __forceinline__ void operator()(const Acc& acc, const Unit& u, int wr, int wc, int fr, int fq) const {
        const int row0 = u.pm * BM + wr * 64 + fr;
#pragma unroll
        for (int bj = 0; bj < 2; ++bj) {
            const int c0 = u.pn * BM + bj * HALF + wc * 32 + 8 * fq;
#pragma unroll
            for (int ai = 0; ai < 2; ++ai)
#pragma unroll
                for (int m = 0; m < 4; ++m) {
                    f32x4 v0 = acc[ai][bj][m][0], v1 = acc[ai][bj][m][1];
#pragma unroll
                    for (int j = 0; j < 4; ++j) { v0[j] = fminf(fmaxf(v0[j], -240.f), 240.f); v1[j] = fminf(fmaxf(v1[j], -240.f), 240.f); }
                    int w0 = 0, w1 = 0;
                    w0 = __builtin_amdgcn_cvt_pk_fp8_f32(v0[0], v0[1], w0, false); w0 = __builtin_amdgcn_cvt_pk_fp8_f32(v0[2], v0[3], w0, true);
                    w1 = __builtin_amdgcn_cvt_pk_fp8_f32(v1[0], v1[1], w1, false); w1 = __builtin_amdgcn_cvt_pk_fp8_f32(v1[2], v1[3], w1, true);
                    *(u32x2*)(O + (size_t)(row0 + ai * HALF + m * 16) * ldc + c0) = (u32x2){(unsigned)w0, (unsigned)w1};
                }
        }
    }
};
struct EpiPlain {
    static constexpr bool PERM = false;
    bf16_t* O; int ldc; int ncols;
    __device__ __forceinline__ void operator()(const Acc& acc, const Unit& u, int wr, int wc, int fr, int fq) const {
        const int row0 = u.pm * BM + wr * 64 + fr;
#pragma unroll
        for (int bj = 0; bj < 2; ++bj) {
            const int c0 = u.pn * BM + bj * HALF + wc * 32 + 4 * fq;
            if (c0 >= ncols) continue;
#pragma unroll
            for (int ai = 0; ai < 2; ++ai)
#pragma unroll
                for (int m = 0; m < 4; ++m) {
                    bf16_t* p = O + (size_t)(row0 + ai * HALF + m * 16) * ldc + c0;
#pragma unroll
                    for (int n = 0; n < 2; ++n) { const f32x4 v = acc[ai][bj][m][n]; u32x2 w; w.x = cvt_pk_bf16(v[0], v[1]); w.y = cvt_pk_bf16(v[2], v[3]); *(u32x2*)(p + 16 * n) = w; }
                }
        }
    }
};
struct EpiFfn1 {
    static constexpr bool PERM = true;
    bf16_t* O;
    __device__ __forceinline__ void operator()(const Acc& acc, const Unit& u, int wr, int wc, int fr, int fq) const {
        const int row0 = u.pm * BM + wr * 64 + fr;
#pragma unroll
        for (int bj = 0; bj < 2; ++bj) {
            const int c0 = (u.pn * BM + bj * HALF + wc * 32 + 8 * fq) >> 1;
#pragma unroll
            for (int ai = 0; ai < 2; ++ai)
#pragma unroll
                for (int m = 0; m < 4; ++m) {
                    const f32x4 a = acc[ai][bj][m][0], b = acc[ai][bj][m][1];
                    float o[4];
#pragma unroll
                    for (int j = 0; j < 4; ++j) o[j] = a[j] * sigmoidf_(a[j]) * b[j];
                    u32x2 w; w.x = cvt_pk_bf16(o[0], o[1]); w.y = cvt_pk_bf16(o[2], o[3]);
                    *(u32x2*)(O + (size_t)(row0 + ai * HALF + m * 16) * DFF + c0) = w;
                }
        }
    }
};
struct EpiResid {
    static constexpr bool PERM = false;
    bf16_t* X; const float* gmod;
    __device__ __forceinline__ void operator()(const Acc& acc, const Unit& u, int wr, int wc, int fr, int fq) const {
        const int row0 = u.pm * BM + wr * 64 + fr, col0 = u.pn * BM + wc * 32 + 4 * fq;
        const float* gp = gmod + (size_t)midx_of_row(u.pm * BM) * 6144;
        f32x4 gv[2][2];
#pragma unroll
        for (int bj = 0; bj < 2; ++bj)
#pragma unroll
            for (int n = 0; n < 2; ++n) gv[bj][n] = *(const f32x4*)(gp + col0 + bj * HALF + n * 16);
#pragma unroll
        for (int ai = 0; ai < 2; ++ai) {
            u32x2 xw[4][2][2];
#pragma unroll
            for (int m = 0; m < 4; ++m)
#pragma unroll
                for (int bj = 0; bj < 2; ++bj)
#pragma unroll
                    for (int n = 0; n < 2; ++n) xw[m][bj][n] = *(const u32x2*)(X + (size_t)(row0 + ai * HALF + m * 16) * D + col0 + bj * HALF + n * 16);
#pragma unroll
            for (int m = 0; m < 4; ++m)
#pragma unroll
                for (int bj = 0; bj < 2; ++bj)
#pragma unroll
                    for (int n = 0; n < 2; ++n) { const u32x2 w = xw[m][bj][n];
                        const f32x4 xv = (f32x4){bflo(w.x), bfhi(w.x), bflo(w.y), bfhi(w.y)} + gv[bj][n] * acc[ai][bj][m][n];
                        u32x2 o; o.x = cvt_pk_bf16(xv[0], xv[1]); o.y = cvt_pk_bf16(xv[2], xv[3]);
                        *(u32x2*)(X + (size_t)(row0 + ai * HALF + m * 16) * D + col0 + bj * HALF + n * 16) = o; }
        }
    }
};
}

struct Ctx {
    const LAS unsigned* tab; float* out; unsigned char* ws; LAS unsigned char* ldsL; unsigned char* lds; int tid, lane, wid, bid, G;
};
__device__ __forceinline__ const float* tab_ptr(const LAS unsigned* tab, int i) { unsigned lo = tab[2 * i], hi = tab[2 * i + 1]; lo = __builtin_amdgcn_readfirstlane(lo); hi = __builtin_amdgcn_readfirstlane(hi); return (const float*)(((unsigned long long)hi << 32) | lo); }
#define INF(i) tab_ptr(C.tab, (i))
__device__ __forceinline__ int launder_s(int v0) { int v = __builtin_amdgcn_readfirstlane(v0); asm volatile("" : "+s"(v)); return v; }
__device__ __forceinline__ int uni(int v) { return __builtin_amdgcn_readfirstlane(v); }
__device__ __forceinline__ Ctx launder(const Ctx& C0) { Ctx C = C0; int ln = lane_id_v(); int w = uni(C0.wid); asm volatile("" : "+s"(w)); C.lane = ln; C.wid = w; C.tid = w * 64 + ln;
    unsigned long long pw = (unsigned long long)C0.ws; unsigned plo = (unsigned)uni((int)(unsigned)pw), phi = (unsigned)uni((int)(unsigned)(pw >> 32)); asm volatile("" : "+s"(plo), "+s"(phi)); C.ws = (unsigned char*)(((unsigned long long)phi << 32) | plo);
    int b = uni(C0.bid), g = uni(C0.G); asm volatile("" : "+s"(b), "+s"(g)); C.bid = b; C.G = g;
    unsigned tb = (unsigned)uni((int)(unsigned)(unsigned long long)C0.tab); asm volatile("" : "+s"(tb)); C.tab = (const LAS unsigned*)(unsigned long long)tb; return C; }

__device__ __forceinline__ void p0_mod(const Ctx& C0) { const Ctx C = launder(C0); const float* in5 = INF(5); const float* in6 = INF(6); const float* in7 = INF(7); const float* in8 = INF(8);
    float* scond = (float*)C.lds;
    float* part = scond + 5 * 1024;
    float* MOD = (float*)(C.ws + WS_MOD);
    bool have = false;
    for (int task = C.bid; task < 192; task += C.G) {
        if (!have) {
            for (int i = C.tid; i < 5 * 1024; i += NT) { const int m = i >> 10, k = i & 1023; const float x = (m == 0) ? in6[k] : in5[(m - 1) * 1024 + k]; scond[i] = x * sigmoidf_(x); }
            have = true; __syncthreads();
        }
        const int l = task / 96, j0 = (task % 96) * 64;
        const float* aw = in7 + (size_t)l * 1024 * 6144 + j0 + C.lane;
        float a[5] = {0.f, 0.f, 0.f, 0.f, 0.f};
        const int k0 = C.wid * 128;
#pragma unroll 8
        for (int k = 0; k < 128; ++k) { const float w = aw[(size_t)(k0 + k) * 6144];
#pragma unroll
            for (int m = 0; m < 5; ++m) a[m] += scond[m * 1024 + k0 + k] * w; }
#pragma unroll
        for (int m = 0; m < 5; ++m) part[(C.wid * 5 + m) * 64 + C.lane] = a[m];
        __syncthreads();
        if (C.tid < 320) { const int m = C.tid >> 6, j = C.tid & 63; float s = in8[l * 6144 + j0 + j];
#pragma unroll
            for (int w = 0; w < 8; ++w) s += part[(w * 5 + m) * 64 + j];
            MOD[((size_t)l * 5 + m) * 6144 + j0 + j] = s; }
        __syncthreads();
    }
    __syncthreads();
}

__device__ __forceinline__ void p0_filters(const Ctx& C0) { const Ctx C = launder(C0); const float* in13 = INF(13); const float* in14 = INF(14); const float* in15 = INF(15); const float* in16 = INF(16); const float* in17 = INF(17);
    float* zs = (float*)C.lds;
    float* h1s = zs + 8 * 4 * 64;
    float* h2s = h1s + 8 * 4 * 64;
    float* red = h2s + 8 * 4 * 64;
    float* HR = (float*)(C.ws + WS_AR + A_HRAW);
    float* HP = (float*)(C.ws + WS_HP);
    for (int task = (C.bid + 64) % C.G; task < 144; task += C.G) {
        const int l = task / 72, ch = task % 72, Lsel = ch < 8 ? 0 : 1, chunk = Lsel ? ch - 8 : ch, L = Lsel ? 2048 : 256;
        const int tb = chunk * 32 + C.wid * 4;
        float* zw = zs + C.wid * 256; float* h1w = h1s + C.wid * 256; float* h2w = h2s + C.wid * 256;
        if (C.lane < 33) {
#pragma unroll
            for (int tt = 0; tt < 4; ++tt) {
                const int t = tb + tt; const float w = (6.2831855f * (float)t) / (float)L;
                float z;
                if (C.lane == 0) z = (float)t / (float)(L - 1);
                else { const int bi = (C.lane - 1) & 15; const float f = 1e-4f + (float)bi * ((15.0f - 1e-4f) / 15.0f); const float a = f * w; z = (C.lane <= 16) ? cosf(a) : -sinf(a); }
                zw[tt * 64 + C.lane] = z;
            }
        }
        __builtin_amdgcn_wave_barrier();
        { float a[4]; const float b = in14[l * 64 + C.lane];
#pragma unroll
          for (int tt = 0; tt < 4; ++tt) a[tt] = b;
#pragma unroll 3
          for (int k = 0; k < 33; ++k) { const float w = in13[(l * 33 + k) * 64 + C.lane];
#pragma unroll
              for (int tt = 0; tt < 4; ++tt) a[tt] += zw[tt * 64 + k] * w; }
#pragma unroll
          for (int tt = 0; tt < 4; ++tt) h1w[tt * 64 + C.lane] = sinf(a[tt]); }
        __builtin_amdgcn_wave_barrier();
        { float a[4]; const float b = in16[l * 64 + C.lane];
#pragma unroll
          for (int tt = 0; tt < 4; ++tt) a[tt] = b;
#pragma unroll 4
          for (int k = 0; k < 64; ++k) { const float w = in15[(l * 64 + k) * 64 + C.lane];
#pragma unroll
              for (int tt = 0; tt < 4; ++tt) a[tt] += h1w[tt * 64 + k] * w; }
#pragma unroll
          for (int tt = 0; tt < 4; ++tt) h2w[tt * 64 + C.lane] = sinf(a[tt]); }
        __builtin_amdgcn_wave_barrier();
        const float* w3 = in17 + (size_t)l * 64 * 1024;
        float* hr = HR + ((size_t)l * 2304 + (Lsel ? 256 : 0)) * 1024;
#pragma unroll 1
        for (int q = 0; q < 8; ++q) {
            float psum = 0.f;
#pragma unroll 1
            for (int dir = 0; dir < 2; ++dir) {
                float a[4] = {0.f, 0.f, 0.f, 0.f};
                const int col = C.lane + 64 * ((q >> 2) * 8 + dir * 4 + (q & 3));
#pragma unroll 8
                for (int k = 0; k < 64; ++k) { const float w = w3[k * 1024 + col];
#pragma unroll
                    for (int tt = 0; tt < 4; ++tt) a[tt] += h2w[tt * 64 + k] * w; }
                const int c = col & 255;
                const float delta = fabsf(-3.0701134573f + (float)c * ((-15.3505672866f + 3.0701134573f) / 255.0f));
#pragma unroll
                for (int tt = 0; tt < 4; ++tt) {
                    const int t = tb + tt; const float tl = (float)t / (float)(L - 1);
                    const float v = a[tt] * __expf(-tl * delta);
                    hr[(size_t)t * 1024 + col] = v;
                    psum += fabsf(v);
                }
            }
            red[(C.wid * 8 + q) * 64 + C.lane] = psum;
        }
        __syncthreads();
        { const int o = C.tid >> 8, c = C.tid & 255, r4 = c >> 6, ln = c & 63; float s = 0.f;
#pragma unroll
          for (int w = 0; w < 8; ++w) s += red[(w * 8 + o * 4 + r4) * 64 + ln];
          HP[((size_t)l * 72 + ch) * 512 + C.tid] = s; }
        __syncthreads();
    }
    __syncthreads();
}

__device__ __forceinline__ void p0_misc(const Ctx& C0) { const Ctx C = launder(C0); const float* in4 = INF(4);
    float* rope = (float*)(C.ws + WS_ROPE);
    const int gt = C.bid * NT + C.tid, gs = C.G * NT;
    for (int i = gt; i < 32768; i += gs) {
        const int t = i >> 4, k = i & 15; const int pos = (k < 8) ? (t >> 6) : (t & 63);
        const float inv = powf(10000.0f, -(float)(k & 7) / 8.0f);
        const float a = (float)pos * inv;
        rope[i] = cosf(a); rope[32768 + i] = sinf(a);
    }
    bf16_t* s0t = (bf16_t*)(C.ws + WS_S0T);
    for (int i = gt; i < 64 * 4096; i += gs) { const int mat = i >> 12, dv = (i >> 6) & 63, dk = i & 63; s0t[i] = f2bf(in4[mat * 4096 + dk * 64 + dv]); }
}

__device__ __forceinline__ void conv_tile(const float* src, int ld, int kvalid, int k0, int colsrc  , bf16_t* dstrow  , float scale) {
    float vv[64];
    const int cs = colsrc < 0 ? 0 : colsrc;
#pragma unroll
    for (int j = 0; j < 64; ++j) { const int k = k0 + j, kc = k < kvalid ? k : kvalid - 1; vv[j] = src[(size_t)kc * ld + cs]; }
    unsigned w[32];
#pragma unroll
    for (int j = 0; j < 32; ++j) {
        const float a = (colsrc >= 0 && k0 + 2 * j < kvalid) ? vv[2 * j] : 0.f, b = (colsrc >= 0 && k0 + 2 * j + 1 < kvalid) ? vv[2 * j + 1] : 0.f;
        w[j] = cvt_pk_bf16(a * scale, b * scale);
    }
#pragma unroll
    for (int j = 0; j < 8; ++j) { u32x4 v; v.x = w[4 * j]; v.y = w[4 * j + 1]; v.z = w[4 * j + 2]; v.w = w[4 * j + 3]; *(u32x4*)(dstrow + 8 * j) = v; }
}
__device__ __forceinline__ void convert_weights(const Ctx& C0, int l0) { const int l = launder_s(l0); const Ctx C = launder(C0);
    unsigned char* W = C.ws + WS_W;
    constexpr int T0 = 704, T1 = T0 + 1024, T2 = T1 + 256, T3 = T2 + 1408, T4 = T3 + 704, T5 = T4 + 256, T6 = T5 + 32, T7 = T6 + 16, T8 = T7 + 16;
    for (int t = C.bid * 8 + C.wid; t < T8; t += C.G * 8) {
        const float* src; int ld, kvalid, k0, col; bf16_t* dst; float scale = 1.0f;
        if (t < T0) { const int nt = t % 44, kt = t / 44, n = nt * 64 + C.lane; src = INF(10) + (size_t)l * 1024 * 2720; ld = 2720; kvalid = 1024; k0 = kt * 64; col = n < 2720 ? n : -1; dst = (bf16_t*)(W + W_PROJ) + (size_t)n * 1024 + k0; }
        else if (t < T1) { const int u = t - T0, nt = u % 64, kt = u / 64, n = nt * 64 + C.lane; src = INF(32) + (size_t)l * 1024 * 4096; ld = 4096; kvalid = 1024; k0 = kt * 64; col = n; dst = (bf16_t*)(W + W_GATE) + (size_t)n * 1024 + k0; }
        else if (t < T2) { const int u = t - T1, nt = u % 16, kt = u / 16, n = nt * 64 + C.lane; src = INF(34) + (size_t)l * 1024 * 1024; ld = 1024; kvalid = 1024; k0 = kt * 64; col = n; dst = (bf16_t*)(W + W_O) + (size_t)n * 1024 + k0; }
        else if (t < T3) { const int u = t - T2, nt = u % 88, kt = u / 88, n = nt * 64 + C.lane; src = INF(36) + (size_t)l * 1024 * 5632; ld = 5632; kvalid = 1024; k0 = kt * 64;
            const int g = n >> 3, e = n & 7; col = (e < 4) ? 4 * g + e : 2816 + 4 * g + (e - 4); dst = (bf16_t*)(W + W_1) + (size_t)n * 1024 + k0; }
        else if (t < T4) { const int u = t - T3, nt = u % 16, kt = u / 16, n = nt * 64 + C.lane; src = INF(37) + (size_t)l * 2816 * 1024; ld = 1024; kvalid = 2816; k0 = kt * 64; col = n; dst = (bf16_t*)(W + W_2) + (size_t)n * 2816 + k0; }
        else if (t < T5) { const int u = t - T4, br = u / 64, v = u % 64, nt = v / 4, kt = v % 4, n = nt * 64 + C.lane; const int ii = (br == 0) ? 19 : (br == 1) ? 24 : (br == 2) ? 26 : 31;
            src = INF(ii) + (size_t)l * 256 * 1024; ld = 1024; kvalid = 256; k0 = kt * 64; col = n; dst = (bf16_t*)(W + W_BOUT) + ((size_t)br * 1024 + n) * 256 + k0; }
        else if (t < T6) { const int u = t - T5, nt = u / 4, kt = u % 4, n = nt * 64 + C.lane; src = INF(21) + (size_t)l * 256 * 384; ld = 384; kvalid = 256; k0 = kt * 64; col = n < 384 ? n : -1; dst = (bf16_t*)(W + W_UQ) + (size_t)n * 256 + k0; scale = 0.10206207261596577f * 1.4426950408889634f; }
        else if (t < T7) { const int u = t - T6, nt = u / 4, kt = u % 4, n = nt * 64 + C.lane; src = INF(23) + (size_t)l * 128 * 512; ld = 512; kvalid = 128; k0 = kt * 64; col = (n >> 6) * 128 + (n & 63); dst = (bf16_t*)(W + W_UK) + (size_t)n * 256 + k0; }
        else { const int u = t - T7, nt = u / 4, kt = u % 4, n = nt * 64 + C.lane; src = INF(23) + (size_t)l * 128 * 512; ld = 512; kvalid = 128; k0 = kt * 64; col = (n >> 6) * 128 + 64 + (n & 63); dst = (bf16_t*)(W + W_UV) + (size_t)n * 256 + k0; }
        conv_tile(src, ld, kvalid, k0, col, dst, scale);
    }
}

__device__ __forceinline__ bf16_t* rg_ptr(unsigned char* ws, int l, int p, int o, int c) {
    return (bf16_t*)(ws + WS_RG + (size_t)l * RG_LAYER) + (p ? (size_t)2 * 256 * 512 : 0) + (size_t)(o * 256 + c) * (p ? 4096 : 512);
}
__device__ __forceinline__ void build_rg(const Ctx& C0) { const Ctx C = launder(C0);
    float* tile = (float*)C.lds;
    float* invn = tile + 64 * 65;
    const float* HR = (const float*)(C.ws + WS_AR + A_HRAW);
    const float* HP = (const float*)(C.ws + WS_HP);
    for (int task = C.bid; task < 1152; task += C.G) {
        const int l = task / 576, u = task % 576;
        int p, o, cg, mc;
        if (u < 64) { p = 0; o = u / 32; cg = (u / 8) % 4; mc = u % 8; } else { const int v = u - 64; p = 1; o = v / 256; cg = (v / 64) % 4; mc = v % 64; }
        const int L = p ? 2048 : 256, nch = p ? 64 : 8, chb = p ? 8 : 0, c0 = cg * 64, m0 = mc * 64;
        {
          const int cch_ = C.tid & 63, part = C.tid >> 6; float hv[8];
#pragma unroll
          for (int q = 0; q < 8; ++q) { const int k = part + 8 * q; hv[q] = (k < nch) ? HP[((size_t)l * 72 + chb + k) * 512 + o * 256 + c0 + cch_] : 0.f; }
          invn[part * 64 + cch_] = ((hv[0] + hv[1]) + (hv[2] + hv[3])) + ((hv[4] + hv[5]) + (hv[6] + hv[7])); }
        const float* hr = HR + ((size_t)l * 2304 + (p ? 256 : 0)) * 1024;
#pragma unroll
        for (int jj = 0; jj < 8; ++jj) {
            const int j = C.wid * 8 + jj, m = m0 + j, n = L - m;
            float v = 0.f;
            if (m != 0) { const int t = n >= 0 ? n : -n, dir = n >= 0 ? 0 : 1; v = hr[(size_t)t * 1024 + o * 512 + dir * 256 + c0 + C.lane]; }
            tile[j * 65 + C.lane] = v;
        }
        __syncthreads();
        { const int cc = C.tid >> 3, jg = C.tid & 7;
          float sn = 0.f;
#pragma unroll
          for (int q = 0; q < 8; ++q) sn += invn[q * 64 + cc];
          const float s = 1.0f / sn;
          u32x4 w; float f[8];
#pragma unroll
          for (int e = 0; e < 8; ++e) f[e] = tile[(jg * 8 + e) * 65 + cc] * s;
          w.x = cvt_pk_bf16(f[0], f[1]); w.y = cvt_pk_bf16(f[2], f[3]); w.z = cvt_pk_bf16(f[4], f[5]); w.w = cvt_pk_bf16(f[6], f[7]);
          *(u32x4*)(rg_ptr(C.ws, l, p, o, c0 + cc) + m0 + jg * 8) = w; }
        __syncthreads();
    }
}

__device__ __forceinline__ void norm_phase(const Ctx& C0, int l0, int which) { const int l = launder_s(l0); const Ctx C = launder(C0); const float* in0 = INF(0); const float* in1 = INF(1); const float* in9 = INF(9); const float* in35 = INF(35);
    bf16_t* X = (bf16_t*)(C.ws + WS_HB);
    bf16_t* Hb = (bf16_t*)C.out;
    const float* MOD = (const float*)(C.ws + WS_MOD) + (size_t)l * 5 * 6144;
    const float* g = (which == 0 ? in9 : in35) + l * 1024;
    const int shoff = which == 0 ? 0 : 3072, scoff = shoff + 1024;
    const bool first = (which == 0 && l == 0);
    f32x4 gg[4];
#pragma unroll
    for (int i = 0; i < 4; ++i) gg[i] = *(const f32x4*)(g + i * 256 + C.lane * 4);
    for (int rp = C.bid * 8 + C.wid; rp < M / 2; rp += C.G * 8) {
        f32x4 v[2][4]; float ss[2] = {0.f, 0.f};
#pragma unroll
        for (int q = 0; q < 2; ++q) { const int row = rp + q * (M / 2);
            if (first) { const float* src = row < MC ? in0 + (size_t)row * D : in1 + (size_t)(row - MC) * D;
#pragma unroll
                for (int i = 0; i < 4; ++i) v[q][i] = *(const f32x4*)(src + i * 256 + C.lane * 4);
            } else { const bf16_t* src = X + (size_t)row * D;
#pragma unroll
                for (int i = 0; i < 4; ++i) { const u32x2 w = *(const u32x2*)(src + i * 256 + C.lane * 4); v[q][i] = (f32x4){bflo(w.x), bfhi(w.x), bflo(w.y), bfhi(w.y)}; } } }
#pragma unroll
        for (int q = 0; q < 2; ++q)
#pragma unroll
            for (int i = 0; i < 4; ++i) ss[q] += v[q][i][0] * v[q][i][0] + v[q][i][1] * v[q][i][1] + v[q][i][2] * v[q][i][2] + v[q][i][3] * v[q][i][3];
#pragma unroll
        for (int o = 32; o >= 1; o >>= 1) { const float t0 = shx(ss[0], o, C.lane), t1 = shx(ss[1], o, C.lane); ss[0] += t0; ss[1] += t1; }
#pragma unroll
        for (int q = 0; q < 2; ++q) { const int row = rp + q * (M / 2);
            const float rstd = rsqrtf(ss[q] * (1.0f / 1024.0f) + 1e-6f);
            const float* mp = MOD + (size_t)midx_of_row(row) * 6144;
#pragma unroll
            for (int i = 0; i < 4; ++i) {
                const int c = i * 256 + C.lane * 4;
                if (first) { u32x2 xw; xw.x = cvt_pk_bf16(v[q][i][0], v[q][i][1]); xw.y = cvt_pk_bf16(v[q][i][2], v[q][i][3]); *(u32x2*)(X + (size_t)row * D + c) = xw; }
                const f32x4 sh = *(const f32x4*)(mp + shoff + c), sc = *(const f32x4*)(mp + scoff + c);
                const f32x4 y = (v[q][i] * rstd * gg[i]) * (sc + 1.0f) + sh;
                u32x2 w; w.x = cvt_pk_bf16(y[0], y[1]); w.y = cvt_pk_bf16(y[2], y[3]);
                *(u32x2*)(Hb + (size_t)row * D + c) = w;
            } }
    }
}
__device__ __forceinline__ void final_norm(const Ctx& C0) { const Ctx C = launder(C0); const float* in38 = INF(38);
    const bf16_t* X = (const bf16_t*)(C.ws + WS_HB); float* Y = C.out; const float* g = in38;
    for (int row = C.bid * 8 + C.wid; row < M; row += C.G * 8) {
        const bf16_t* src = X + (size_t)row * D;
        f32x4 v[4]; float ss = 0.f;
#pragma unroll
        for (int i = 0; i < 4; ++i) { const u32x2 w = *(const u32x2*)(src + i * 256 + C.lane * 4); v[i] = (f32x4){bflo(w.x), bfhi(w.x), bflo(w.y), bfhi(w.y)}; ss += v[i][0] * v[i][0] + v[i][1] * v[i][1] + v[i][2] * v[i][2] + v[i][3] * v[i][3]; }
        ss = wave_sum_l(ss, C.lane);
        const float rstd = rsqrtf(ss * (1.0f / 1024.0f) + 1e-6f);
#pragma unroll
        for (int i = 0; i < 4; ++i) { const int c = i * 256 + C.lane * 4; *(f32x4*)(Y + (size_t)row * D + c) = v[i] * rstd * *(const f32x4*)(g + c); }
    }
}

__device__ __forceinline__ void prep_phase(const Ctx& C0, int l0) { const int l = launder_s(l0); const Ctx C = launder(C0); const float* in2 = INF(2); const float* in3 = INF(3); const float* in11 = INF(11); const float* in12 = INF(12); const float* in20 = INF(20); const float* in22 = INF(22); const float* in27 = INF(27); const float* in28 = INF(28); const float* in29 = INF(29); const float* in30 = INF(30);
    unsigned char* AR = C.ws + WS_AR;
    const bf16_t* UHY = (const bf16_t*)(AR + A_UHY); const bf16_t* UMLA = (const bf16_t*)(AR + A_UMLA);
    const bf16_t* UCONF = (const bf16_t*)(AR + A_UCONF); const bf16_t* URET = (const bf16_t*)(AR + A_URET);
    bf16_t* ZT = (bf16_t*)(AR + A_ZT); bf16_t* CQN = (bf16_t*)(AR + A_CQN); bf16_t* CKN = (bf16_t*)(AR + A_CKN);
    bf16_t* KR = (bf16_t*)(AR + A_KR); bf16_t* RVT = (bf16_t*)(AR + A_RVT);
    bf16_t* YCONF = (bf16_t*)((unsigned char*)C.out + 33554432) + (size_t)3 * M * 256;
    const float* rope = (const float*)(C.ws + WS_ROPE);
    float* out = C.out;
    for (int ti = C.bid; ti < M / 64; ti += C.G) {
        const int r0 = ti * 64; const bool lat = r0 >= MC;
        const int L = lat ? 2048 : 256, sb = lat ? MC + ((r0 - MC) >> 11) * 2048 : (r0 >> 8) * 256, t0 = r0 - sb, b = lat ? (r0 - MC) >> 11 : r0 >> 8;
        {
            LAS bf16_t* us = (LAS bf16_t*)C.ldsL;
#pragma unroll 4
            for (int q = C.tid; q < 66 * 96; q += NT) { const int rr = q / 96, cc = q % 96; const int t = t0 + rr - 1;
                u32x4 v = (u32x4){0u, 0u, 0u, 0u}; if (t >= 0 && t < L) v = *(const u32x4*)(UHY + (size_t)(sb + t) * 768 + cc * 8);
                *(LAS u32x4*)(us + rr * 768 + cc * 8) = v; }
            __syncthreads();
            const float* cw = in11 + l * 3 * 768; const float* cb = in12 + l * 768;
            for (int it = C.tid; it < 768 * 8; it += NT) { const int ch = it % 768, tg = it / 768;
                const float w0 = cw[ch], w1 = cw[768 + ch], w2 = cw[1536 + ch], bb = cb[ch];
                float u[10];
#pragma unroll
                for (int e = 0; e < 10; ++e) u[e] = bf2f(us[(tg * 8 + e) * 768 + ch]);
                float z[8];
#pragma unroll
                for (int e = 0; e < 8; ++e) z[e] = w0 * u[e] + w1 * u[e + 1] + w2 * u[e + 2] + bb;
                u32x4 w; w.x = cvt_pk_bf16(z[0], z[1]); w.y = cvt_pk_bf16(z[2], z[3]); w.z = cvt_pk_bf16(z[4], z[5]); w.w = cvt_pk_bf16(z[6], z[7]);
                *(u32x4*)(ZT + ((size_t)(lat ? 768 : 0) + ch) * 8192 + (r0 - (lat ? MC : 0)) + tg * 8) = w; }
            __syncthreads();
        }
        {
            const int rw0 = r0 + C.wid * 8;
            u32x2 cqv[8]; unsigned ckw[8]; float krx[8], rcs[8], rsn[8];
#pragma unroll
            for (int tt = 0; tt < 8; ++tt) { const bf16_t* um = UMLA + (size_t)(rw0 + tt) * 416;
                cqv[tt] = *(const u32x2*)(um + C.lane * 4); ckw[tt] = *(const unsigned*)(um + 256 + C.lane * 2); krx[tt] = bf2f(um[384 + (C.lane & 31)]);
                rcs[tt] = 1.f; rsn[tt] = 0.f;
                if (lat) { const int t = rw0 + tt - sb; rcs[tt] = rope[t * 16 + (C.lane & 15)]; rsn[tt] = rope[32768 + t * 16 + (C.lane & 15)]; } }
            const f32x4 gq = *(const f32x4*)(in20 + l * 256 + C.lane * 4); const f32x2 gk = *(const f32x2*)(in22 + l * 128 + C.lane * 2);
            float s1[8], s2[8], oth[8];
#pragma unroll
            for (int tt = 0; tt < 8; ++tt) { const float x0 = bflo(cqv[tt].x), x1 = bfhi(cqv[tt].x), x2 = bflo(cqv[tt].y), x3 = bfhi(cqv[tt].y), k0 = bflo(ckw[tt]), k1 = bfhi(ckw[tt]);
                s1[tt] = x0 * x0 + x1 * x1 + x2 * x2 + x3 * x3; s2[tt] = k0 * k0 + k1 * k1; oth[tt] = shx(krx[tt], 16, C.lane); }
#pragma unroll
            for (int o = 32; o >= 1; o >>= 1) {
                float t1[8], t2[8];
#pragma unroll
                for (int tt = 0; tt < 8; ++tt) { t1[tt] = shx(s1[tt], o, C.lane); t2[tt] = shx(s2[tt], o, C.lane); }
#pragma unroll
                for (int tt = 0; tt < 8; ++tt) { s1[tt] += t1[tt]; s2[tt] += t2[tt]; }
            }
#pragma unroll
            for (int tt = 0; tt < 8; ++tt) {
                const int row = rw0 + tt, t = row - sb; const size_t keyrow = lat ? (size_t)MC + b * 2304 + t : (size_t)row;
                { const float x0 = bflo(cqv[tt].x), x1 = bfhi(cqv[tt].x), x2 = bflo(cqv[tt].y), x3 = bfhi(cqv[tt].y); const float rs = rsqrtf(s1[tt] * (1.0f / 256.0f) + 1e-6f);
                  u32x2 o; o.x = cvt_pk_bf16(x0 * rs * gq[0], x1 * rs * gq[1]); o.y = cvt_pk_bf16(x2 * rs * gq[2], x3 * rs * gq[3]);
                  *(u32x2*)(CQN + (size_t)row * 256 + C.lane * 4) = o; }
                { const float x0 = bflo(ckw[tt]), x1 = bfhi(ckw[tt]); const float rs = rsqrtf(s2[tt] * (1.0f / 128.0f) + 1e-6f);
                  const float y0 = x0 * rs * gk[0], y1 = x1 * rs * gk[1];
                  *(unsigned*)(CKN + keyrow * 256 + C.lane * 2) = cvt_pk_bf16(y0, y1);
                  *(unsigned*)(CKN + keyrow * 256 + 128 + C.lane * 2) = 0u;
                  if (!lat) *(f32x2*)(out + 16777216 + (((size_t)b * 2 + l) * 256 + t) * 128 + C.lane * 2) = (f32x2){y0, y1}; }
                { const float x = krx[tt]; float y = x;
                  if (lat) y = (C.lane & 16) ? (oth[tt] * rsn[tt] + x * rcs[tt]) : (x * rcs[tt] - oth[tt] * rsn[tt]);
                  if (C.lane < 32) { KR[keyrow * 32 + C.lane] = f2bf(y); if (!lat) out[18874368 + (((size_t)b * 2 + l) * 256 + t) * 32 + C.lane] = x; } }
            }
        }
        {
            LAS bf16_t* vs = (LAS bf16_t*)C.ldsL;
#pragma unroll 4
            for (int q = C.tid; q < 64 * 32; q += NT) { const int rr = q >> 5, cc = q & 31; *(LAS u32x4*)(vs + rr * 264 + cc * 8) = *(const u32x4*)(URET + (size_t)(r0 + rr) * 1024 + 512 + cc * 8); }
            __syncthreads();
            for (int it = C.tid; it < 256 * 8; it += NT) { const int col = it & 255, tg = it >> 8; unsigned short e[8];
#pragma unroll
                for (int k = 0; k < 8; ++k) e[k] = vs[(tg * 8 + k) * 264 + col];
                u32x4 w; w.x = e[0] | ((unsigned)e[1] << 16); w.y = e[2] | ((unsigned)e[3] << 16); w.z = e[4] | ((unsigned)e[5] << 16); w.w = e[6] | ((unsigned)e[7] << 16);
                *(u32x4*)(RVT + (size_t)col * M + r0 + tg * 8) = w; }
            __syncthreads();
        }
        {
            LAS bf16_t* zb = (LAS bf16_t*)C.ldsL;
            LAS float* cbuf = (LAS float*)(C.ldsL + 94 * 256 * 2);
#pragma unroll 4
            for (int q = C.tid; q < 94 * 64; q += NT) { const int rr = q >> 6, cc = q & 63; const int t = t0 + rr - 15;
                u32x2 o = (u32x2){0u, 0u};
                if (t >= 0 && t < L) { const bf16_t* up = UCONF + (size_t)(sb + t) * 512 + cc * 4; const u32x2 a = *(const u32x2*)up, g = *(const u32x2*)(up + 256);
                    o.x = cvt_pk_bf16(bflo(a.x) * sigmoidf_(bflo(g.x)), bfhi(a.x) * sigmoidf_(bfhi(g.x))); o.y = cvt_pk_bf16(bflo(a.y) * sigmoidf_(bflo(g.y)), bfhi(a.y) * sigmoidf_(bfhi(g.y))); }
                *(LAS u32x2*)(zb + rr * 256 + cc * 4) = o; }
            __syncthreads();
            { const int c = C.tid & 255, th = C.tid >> 8; const float* dw = in27 + (size_t)l * 31 * 256 + c; const float bb = in28[l * 256 + c];
              float a[32];
#pragma unroll
              for (int i = 0; i < 32; ++i) a[i] = bb;
              for (int j = 0; j < 31; ++j) { const float w = dw[j * 256];
#pragma unroll
                  for (int i = 0; i < 32; ++i) a[i] += w * bf2f(zb[(th * 32 + i + j) * 256 + c]); }
#pragma unroll
              for (int i = 0; i < 32; ++i) cbuf[(th * 32 + i) * 256 + c] = a[i]; }
            __syncthreads();
            for (int tt = 0; tt < 8; ++tt) { const int tr = C.wid * 8 + tt; const f32x4 v = *(const LAS f32x4*)(cbuf + tr * 256 + C.lane * 4);
                const float mu = wave_sum_l(v[0] + v[1] + v[2] + v[3], C.lane) * (1.0f / 256.0f);
                const f32x4 d = v - mu; const float var = wave_sum_l(d[0] * d[0] + d[1] * d[1] + d[2] * d[2] + d[3] * d[3], C.lane) * (1.0f / 256.0f);
                const float rs = rsqrtf(var + 1e-6f);
                const f32x4 g = *(const f32x4*)(in29 + l * 256 + C.lane * 4), be = *(const f32x4*)(in30 + l * 256 + C.lane * 4);
                f32x4 y = d * rs * g + be;
#pragma unroll
                for (int j = 0; j < 4; ++j) y[j] = y[j] * sigmoidf_(y[j]);
                u32x2 w; w.x = cvt_pk_bf16(y[0], y[1]); w.y = cvt_pk_bf16(y[2], y[3]);
                *(u32x2*)(YCONF + (size_t)(r0 + tr) * 256 + C.lane * 4) = w; }
            __syncthreads();
        }
    }
    for (int r = C.bid * 8 + C.wid; r < 1024; r += C.G * 8) { const int b = r >> 8, j = r & 255; const size_t keyrow = (size_t)MC + b * 2304 + 2048 + j;
        const f32x2 v = *(const f32x2*)(in2 + (((size_t)b * 2 + l) * 256 + j) * 128 + C.lane * 2);
        *(unsigned*)(CKN + keyrow * 256 + C.lane * 2) = cvt_pk_bf16(v[0], v[1]); *(unsigned*)(CKN + keyrow * 256 + 128 + C.lane * 2) = 0u;
        if (C.lane < 32) KR[keyrow * 32 + C.lane] = f2bf(in3[(((size_t)b * 2 + l) * 256 + j) * 32 + C.lane]); }
}

__device__ __forceinline__ void hyena_phase(const Ctx& C0, int l0) { const int l = launder_s(l0); const Ctx C = launder(C0); const float* in18 = INF(18);
    const bf16_t* ZT = (const bf16_t*)(C.ws + WS_AR + A_ZT);
    bf16_t* YHY = (bf16_t*)((unsigned char*)C.out + 33554432);
    LAS unsigned char* vS = C.ldsL;
    LAS unsigned char* R0 = C.ldsL + 20480;
    LAS unsigned char* R1 = R0 + 8256;
    const int n = C.lane & 31, hf = C.lane >> 5;
    const int Bk = 32 * C.wid + n;
    for (int item = C.bid; item < 256; item += C.G) {
      u32x4 pd; unsigned pe;
#define HY_RLOAD(P_, O_) do { const bf16_t* rg_ = rg_ptr(C.ws, l, (P_), (O_), item); const int nch_ = ((P_) ? 4096 : 512) >> 3; pd = (u32x4){0u, 0u, 0u, 0u}; pe = 0u; \
          if (C.tid < nch_) { pd = *(const u32x4*)(rg_ + C.tid * 8); if (C.tid + 1 < nch_) pe = *(const unsigned*)(rg_ + C.tid * 8 + 8); } } while (0)
      HY_RLOAD(1, 0);
      for (int s = 0; s < 4; ++s) {
        const int p = 1 - (s >> 1), o = s & 1, c = item;
        const int L = p ? 2048 : 256, Lb = L >> 5, L2 = 2 * L;
        const bf16_t* zv = ZT + ((size_t)p * 768 + c) * 8192;
        const bf16_t* zx1 = zv + (size_t)256 * 8192; const bf16_t* zx2 = zv + (size_t)512 * 8192;
        if (o == 0) {
            __syncthreads();
            for (int q = C.tid; q < 1024; q += NT) *(LAS u32x4*)(vS + (q >> 2) * 80 + (q & 3) * 16) = *(const u32x4*)(zv + q * 8);
        }
        {
            if (C.tid <= (L2 >> 3)) {
                *(LAS u32x4*)(R0 + C.tid * 16) = pd;
                u32x4 sft; sft.x = (pd.x >> 16) | (pd.y << 16); sft.y = (pd.y >> 16) | (pd.z << 16); sft.z = (pd.z >> 16) | (pd.w << 16); sft.w = (pd.w >> 16) | (pe << 16);
                *(LAS u32x4*)(R1 + C.tid * 16) = sft;
            }
            __syncthreads();
            if (s < 3) HY_RLOAD(1 - ((s + 1) >> 1), (s + 1) & 1);
            f32x16 acc;
#pragma unroll
            for (int r = 0; r < 16; ++r) acc[r] = 0.f;
            const LAS unsigned* Rc = (const LAS unsigned*)((n & 1) ? R1 : R0);
            const int T = Bk & (Lb - 1);
            const int Tlo = (32 * C.wid) & (Lb - 1), Thi = Lb >= 32 ? Tlo + 31 : Lb - 1, Tl0 = Lb >= 32 ? Tlo : 0;
            const int dlo = Tl0 - (Lb - 1), dhi = Thi;
            for (int d = dlo; d <= dhi; ++d) {
                const int s0 = L - 32 * d - n + 8 * hf, dw = s0 >> 1;
                u32x4 a0, a1;
                a0.x = Rc[dw]; a0.y = Rc[dw + 1]; a0.z = Rc[dw + 2]; a0.w = Rc[dw + 3];
                a1.x = Rc[dw + 8]; a1.y = Rc[dw + 9]; a1.z = Rc[dw + 10]; a1.w = Rc[dw + 11];
                const int Ts = T - d;
                const bool valid = (Ts >= 0) && (Ts < Lb);
                const int sblk = valid ? (Bk - d) : 0;
                u32x4 b0 = *(const LAS u32x4*)(vS + sblk * 80 + hf * 16), b1 = *(const LAS u32x4*)(vS + sblk * 80 + 32 + hf * 16);
                if (!valid) { b0 = (u32x4){0u, 0u, 0u, 0u}; b1 = b0; }
                acc = __builtin_amdgcn_mfma_f32_32x32x16_bf16(__builtin_bit_cast(bf16x8, a0), __builtin_bit_cast(bf16x8, b0), acc, 0, 0, 0);
                acc = __builtin_amdgcn_mfma_f32_32x32x16_bf16(__builtin_bit_cast(bf16x8, a1), __builtin_bit_cast(bf16x8, b1), acc, 0, 0, 0);
            }
            __syncthreads();
            const float bias = in18[((size_t)l * 2 + o) * 256 + c];
            const bf16_t* zg = o == 0 ? zx1 : zx2;
#pragma unroll
            for (int g4 = 0; g4 < 4; ++g4) {
                const int i0 = 8 * g4 + 4 * hf; const int tf = 32 * Bk + i0;
                LAS u32x2* vp = (LAS u32x2*)(vS + Bk * 80 + i0 * 2);
                const u32x2 vv = *vp; const u32x2 gg = *(const u32x2*)(zg + tf);
                const float y0 = (acc[4 * g4 + 0] + bias * bflo(vv.x)) * bflo(gg.x), y1 = (acc[4 * g4 + 1] + bias * bfhi(vv.x)) * bfhi(gg.x);
                const float y2 = (acc[4 * g4 + 2] + bias * bflo(vv.y)) * bflo(gg.y), y3 = (acc[4 * g4 + 3] + bias * bfhi(vv.y)) * bfhi(gg.y);
                if (o == 0) { u32x2 w; w.x = cvt_pk_bf16(y0, y1); w.y = cvt_pk_bf16(y2, y3); *vp = w; }
                else { bf16_t* yp = YHY + (size_t)((p ? MC : 0) + tf) * 256 + c; yp[0] = f2bf(y0); yp[256] = f2bf(y1); yp[512] = f2bf(y2); yp[768] = f2bf(y3); }
            }
            __syncthreads();
        }
      }
    }
#undef HY_RLOAD
    __syncthreads();
}

__device__ void mla_item(const Ctx& C0, int item, bool lat) { const Ctx C = launder(C0);
    const unsigned char* AR = C.ws + WS_AR;
    const bf16_t* Q = (const bf16_t*)(AR + A_Q); const bf16_t* KN = (const bf16_t*)(AR + A_KN); const bf16_t* KR = (const bf16_t*)(AR + A_KR); const bf16_t* VT = (const bf16_t*)(AR + A_VT);
    bf16_t* Y = (bf16_t*)((unsigned char*)C.out + 33554432) + (size_t)1 * M * 256;
    int b, h, qt; if (lat) { b = item >> 8; h = (item >> 6) & 3; qt = item & 63; } else { b = item >> 5; h = (item >> 3) & 3; qt = item & 7; }
    const int row0 = (lat ? MC + b * 2048 : b * 256) + qt * 32, key0 = lat ? MC + b * 2304 : b * 256, nk = lat ? 2304 : 256;
    const int n = C.lane & 31, hf = C.lane >> 5;
    bf16x8 qf[6];
#pragma unroll
    for (int ks = 0; ks < 6; ++ks) qf[ks] = *(const bf16x8*)(Q + (size_t)(row0 + n) * 384 + h * 96 + ks * 16 + hf * 8);
    if (lat) {
        const float* rope = (const float*)(C.ws + WS_ROPE); const int t = qt * 32 + n;
        const f32x4 c0 = *(const f32x4*)(rope + t * 16 + hf * 8), c1 = *(const f32x4*)(rope + t * 16 + hf * 8 + 4);
        const f32x4 s0 = *(const f32x4*)(rope + 32768 + t * 16 + hf * 8), s1 = *(const f32x4*)(rope + 32768 + t * 16 + hf * 8 + 4);
        bf16x8 a = qf[4], bq = qf[5]; float o1v[8], o2v[8];
#pragma unroll
        for (int j = 0; j < 8; ++j) { const float x1 = bf2f((bf16_t)a[j]), x2 = bf2f((bf16_t)bq[j]); const float cs = j < 4 ? c0[j & 3] : c1[j & 3], sn = j < 4 ? s0[j & 3] : s1[j & 3];
            o1v[j] = x1 * cs - x2 * sn; o2v[j] = x1 * sn + x2 * cs; }
        u32x4 wa, wb; wa.x = cvt_pk_bf16(o1v[0], o1v[1]); wa.y = cvt_pk_bf16(o1v[2], o1v[3]); wa.z = cvt_pk_bf16(o1v[4], o1v[5]); wa.w = cvt_pk_bf16(o1v[6], o1v[7]);
        wb.x = cvt_pk_bf16(o2v[0], o2v[1]); wb.y = cvt_pk_bf16(o2v[2], o2v[3]); wb.z = cvt_pk_bf16(o2v[4], o2v[5]); wb.w = cvt_pk_bf16(o2v[6], o2v[7]);
        qf[4] = __builtin_bit_cast(bf16x8, wa); qf[5] = __builtin_bit_cast(bf16x8, wb);
    }
    float mrun = -1e30f, lrun = 0.f; f32x16 o0, o1;
#pragma unroll
    for (int r = 0; r < 16; ++r) { o0[r] = 0.f; o1[r] = 0.f; }
    const bf16_t* vt0 = VT + (size_t)(h * 64 + n) * NKEY + key0 + 4 * hf; const bf16_t* vt1 = vt0 + (size_t)32 * NKEY;
    for (int kt = 0; kt < nk; kt += 32) {
        const size_t key = (size_t)key0 + kt + n;
        bf16x8 kf[6];
#pragma unroll
        for (int ks = 0; ks < 4; ++ks) kf[ks] = *(const bf16x8*)(KN + key * 256 + h * 64 + ks * 16 + hf * 8);
        kf[4] = *(const bf16x8*)(KR + key * 32 + hf * 8); kf[5] = *(const bf16x8*)(KR + key * 32 + 16 + hf * 8);
        bf16x4 va[2][2][2];
#pragma unroll
        for (int s2 = 0; s2 < 2; ++s2) { va[0][s2][0] = *(const bf16x4*)(vt0 + kt + 16 * s2); va[0][s2][1] = *(const bf16x4*)(vt0 + kt + 16 * s2 + 8);
                                         va[1][s2][0] = *(const bf16x4*)(vt1 + kt + 16 * s2); va[1][s2][1] = *(const bf16x4*)(vt1 + kt + 16 * s2 + 8); }
        f32x16 s;
#pragma unroll
        for (int r = 0; r < 16; ++r) s[r] = 0.f;
#pragma unroll
        for (int ks = 0; ks < 6; ++ks) s = __builtin_amdgcn_mfma_f32_32x32x16_bf16(kf[ks], qf[ks], s, 0, 0, 0);
        float mx = s[0];
#pragma unroll
        for (int r = 1; r < 16; ++r) mx = fmaxf(mx, s[r]);
        mx = fmaxf(mx, shx(mx, 32, C.lane));
        const float mnew = fmaxf(mrun, mx), alpha = exp2f(mrun - mnew); mrun = mnew;
        float ls = 0.f;
#pragma unroll
        for (int r = 0; r < 16; ++r) { s[r] = exp2f(s[r] - mnew); ls += s[r]; }
        lrun = lrun * alpha + ls;
#pragma unroll
        for (int r = 0; r < 16; ++r) { o0[r] *= alpha; o1[r] *= alpha; }
#pragma unroll
        for (int s2 = 0; s2 < 2; ++s2) {
            u32x4 pw; pw.x = cvt_pk_bf16(s[8 * s2], s[8 * s2 + 1]); pw.y = cvt_pk_bf16(s[8 * s2 + 2], s[8 * s2 + 3]); pw.z = cvt_pk_bf16(s[8 * s2 + 4], s[8 * s2 + 5]); pw.w = cvt_pk_bf16(s[8 * s2 + 6], s[8 * s2 + 7]);
            const bf16x8 pf = __builtin_bit_cast(bf16x8, pw);
            const bf16x8 v0 = __builtin_shufflevector(va[0][s2][0], va[0][s2][1], 0, 1, 2, 3, 4, 5, 6, 7), v1 = __builtin_shufflevector(va[1][s2][0], va[1][s2][1], 0, 1, 2, 3, 4, 5, 6, 7);
            o0 = __builtin_amdgcn_mfma_f32_32x32x16_bf16(v0, pf, o0, 0, 0, 0);
            o1 = __builtin_amdgcn_mfma_f32_32x32x16_bf16(v1, pf, o1, 0, 0, 0);
        }
    }
    lrun += shx(lrun, 32, C.lane);
    const float inv = 1.0f / lrun;
    bf16_t* yp = Y + (size_t)(row0 + n) * 256 + h * 64 + 4 * hf;
#pragma unroll
    for (int g4 = 0; g4 < 4; ++g4) {
        u32x2 w0, w1; w0.x = cvt_pk_bf16(o0[4 * g4] * inv, o0[4 * g4 + 1] * inv); w0.y = cvt_pk_bf16(o0[4 * g4 + 2] * inv, o0[4 * g4 + 3] * inv);
        w1.x = cvt_pk_bf16(o1[4 * g4] * inv, o1[4 * g4 + 1] * inv); w1.y = cvt_pk_bf16(o1[4 * g4 + 2] * inv, o1[4 * g4 + 3] * inv);
        *(u32x2*)(yp + 8 * g4) = w0; *(u32x2*)(yp + 32 + 8 * g4) = w1;
    }
}

__device__ __forceinline__ float log2_sigmoid(float x) { return -log1pf(__expf(-x)) * 1.4426950408889634f; }
__device__ void ret_item(const Ctx& C0, int l0, int item, bool lat) { const int l = launder_s(l0); const Ctx C = launder(C0); const float* in25 = INF(25);
    const unsigned char* AR = C.ws + WS_AR;
    const bf16_t* URET = (const bf16_t*)(AR + A_URET); const bf16_t* RVT = (const bf16_t*)(AR + A_RVT);
    const bf16_t* S0T = (const bf16_t*)(C.ws + WS_S0T);
    bf16_t* Y = (bf16_t*)((unsigned char*)C.out + 33554432) + (size_t)2 * M * 256;
    int b, h, qt; if (lat) { b = item >> 8; h = (item >> 6) & 3; qt = item & 63; } else { b = item >> 5; h = (item >> 3) & 3; qt = item & 7; }
    const int L = lat ? 2048 : 256, sb = lat ? MC + b * 2048 : b * 256, row0 = sb + qt * 32;
    const int n = C.lane & 31, hf = C.lane >> 5;
    const float lgf = log2_sigmoid(in25[(l * 2 + 0) * 4 + h]), lgb = log2_sigmoid(in25[(l * 2 + 1) * 4 + h]);
    bf16x8 qf[4];
#pragma unroll
    for (int ks = 0; ks < 4; ++ks) qf[ks] = *(const bf16x8*)(URET + (size_t)(row0 + n) * 1024 + h * 64 + ks * 16 + hf * 8);
    f32x16 o0, o1;
#pragma unroll
    for (int r = 0; r < 16; ++r) { o0[r] = 0.f; o1[r] = 0.f; }
    const int tq = qt * 32 + n;
    const bf16_t* vt0 = RVT + (size_t)(h * 64 + n) * M + sb + 4 * hf; const bf16_t* vt1 = vt0 + (size_t)32 * M;
    for (int kt = 0; kt < L; kt += 32) {
        bf16x8 kf[4];
#pragma unroll
        for (int ks = 0; ks < 4; ++ks) kf[ks] = *(const bf16x8*)(URET + (size_t)(sb + kt + n) * 1024 + 256 + h * 64 + ks * 16 + hf * 8);
        bf16x4 va[2][2][2];
#pragma unroll
        for (int s2 = 0; s2 < 2; ++s2) { va[0][s2][0] = *(const bf16x4*)(vt0 + kt + 16 * s2); va[0][s2][1] = *(const bf16x4*)(vt0 + kt + 16 * s2 + 8);
                                         va[1][s2][0] = *(const bf16x4*)(vt1 + kt + 16 * s2); va[1][s2][1] = *(const bf16x4*)(vt1 + kt + 16 * s2 + 8); }
        f32x16 s;
#pragma unroll
        for (int r = 0; r < 16; ++r) s[r] = 0.f;
#pragma unroll
        for (int ks = 0; ks < 4; ++ks) s = __builtin_amdgcn_mfma_f32_32x32x16_bf16(kf[ks], qf[ks], s, 0, 0, 0);
#pragma unroll
        for (int r = 0; r < 16; ++r) { const int sp = kt + 8 * (r >> 2) + 4 * hf + (r & 3); const int dd = tq - sp;
            const float w = dd > 0 ? exp2f(lgf * (float)dd) : (dd < 0 ? exp2f(lgb * (float)(-dd)) : 2.0f);
            s[r] = s[r] * w * 0.125f; }
#pragma unroll
        for (int s2 = 0; s2 < 2; ++s2) {
            u32x4 pw; pw.x = cvt_pk_bf16(s[8 * s2], s[8 * s2 + 1]); pw.y = cvt_pk_bf16(s[8 * s2 + 2], s[8 * s2 + 3]); pw.z = cvt_pk_bf16(s[8 * s2 + 4], s[8 * s2 + 5]); pw.w = cvt_pk_bf16(s[8 * s2 + 6], s[8 * s2 + 7]);
            const bf16x8 pf = __builtin_bit_cast(bf16x8, pw);
            const bf16x8 v0 = __builtin_shufflevector(va[0][s2][0], va[0][s2][1], 0, 1, 2, 3, 4, 5, 6, 7), v1 = __builtin_shufflevector(va[1][s2][0], va[1][s2][1], 0, 1, 2, 3, 4, 5, 6, 7);
            o0 = __builtin_amdgcn_mfma_f32_32x32x16_bf16(v0, pf, o0, 0, 0, 0);
            o1 = __builtin_amdgcn_mfma_f32_32x32x16_bf16(v1, pf, o1, 0, 0, 0);
        }
    }
    if (lat) {
#pragma unroll
        for (int dir = 0; dir < 2; ++dir) {
            const bf16_t* st = S0T + ((((size_t)b * 2 + l) * 2 + dir) * 4 + h) * 4096;
            f32x16 a0, a1;
#pragma unroll
            for (int r = 0; r < 16; ++r) { a0[r] = 0.f; a1[r] = 0.f; }
#pragma unroll
            for (int ks = 0; ks < 4; ++ks) {
                const bf16x8 s0 = *(const bf16x8*)(st + (size_t)n * 64 + ks * 16 + hf * 8), s1 = *(const bf16x8*)(st + (size_t)(32 + n) * 64 + ks * 16 + hf * 8);
                a0 = __builtin_amdgcn_mfma_f32_32x32x16_bf16(s0, qf[ks], a0, 0, 0, 0);
                a1 = __builtin_amdgcn_mfma_f32_32x32x16_bf16(s1, qf[ks], a1, 0, 0, 0);
            }
            const float w = dir == 0 ? exp2f(lgf * (float)(tq + 1)) : exp2f(lgb * (float)(L - tq));
#pragma unroll
            for (int r = 0; r < 16; ++r) { o0[r] += w * a0[r]; o1[r] += w * a1[r]; }
        }
    }
    float sm = 0.f;
#pragma unroll
    for (int r = 0; r < 16; ++r) sm += o0[r] + o1[r];
    sm += shx(sm, 32, C.lane);
    const float mu = sm * (1.0f / 64.0f);
    float vr = 0.f;
#pragma unroll
    for (int r = 0; r < 16; ++r) { const float d0 = o0[r] - mu, d1 = o1[r] - mu; vr += d0 * d0 + d1 * d1; }
    vr += shx(vr, 32, C.lane);
    const float rs = rsqrtf(vr * (1.0f / 64.0f) + 1e-6f);
    const bf16_t* gp = URET + (size_t)(row0 + n) * 1024 + 768 + h * 64 + 4 * hf;
    bf16_t* yp = Y + (size_t)(row0 + n) * 256 + h * 64 + 4 * hf;
#pragma unroll
    for (int g4 = 0; g4 < 4; ++g4) {
        const u32x2 ga = *(const u32x2*)(gp + 8 * g4), gb = *(const u32x2*)(gp + 32 + 8 * g4);
        const float g0[4] = {bflo(ga.x), bfhi(ga.x), bflo(ga.y), bfhi(ga.y)}, g1[4] = {bflo(gb.x), bfhi(gb.x), bflo(gb.y), bfhi(gb.y)};
        float y0[4], y1[4];
#pragma unroll
        for (int j = 0; j < 4; ++j) { y0[j] = (o0[4 * g4 + j] - mu) * rs * (g0[j] * sigmoidf_(g0[j])); y1[j] = (o1[4 * g4 + j] - mu) * rs * (g1[j] * sigmoidf_(g1[j])); }
        u32x2 w0, w1; w0.x = cvt_pk_bf16(y0[0], y0[1]); w0.y = cvt_pk_bf16(y0[2], y0[3]); w1.x = cvt_pk_bf16(y1[0], y1[1]); w1.y = cvt_pk_bf16(y1[2], y1[3]);
        *(u32x2*)(yp + 8 * g4) = w0; *(u32x2*)(yp + 32 + 8 * g4) = w1;
    }
}


template <bool IS_RET>
__device__ __forceinline__ void att_block(const Ctx& C0, int l0, bool lat, int b, int h, int qblk) { const int l = launder_s(l0); const Ctx C = launder(C0);
    const unsigned char* AR = C.ws + WS_AR;
    const bf16_t* Q = (const bf16_t*)(AR + A_Q); const bf16_t* KN = (const bf16_t*)(AR + A_KN); const bf16_t* KR = (const bf16_t*)(AR + A_KR); const bf16_t* VT = (const bf16_t*)(AR + A_VT);
    const bf16_t* URET = (const bf16_t*)(AR + A_URET); const bf16_t* RVT = (const bf16_t*)(AR + A_RVT);
    constexpr int KP = 208, VP = 264, KBYTES = 128 * KP, SBYTES = KBYTES + 64 * VP;
    const int L = lat ? 2048 : 256, sb = lat ? MC + b * 2048 : b * 256;
    const int row0 = sb + qblk * 256 + C.wid * 32;
    const int key0 = IS_RET ? sb : (lat ? MC + b * 2304 : b * 256), nk = IS_RET ? L : (lat ? 2304 : 256);
    const int n = C.lane & 31, hf = C.lane >> 5;
    constexpr int NKS = IS_RET ? 4 : 6;
    bf16x8 qf[NKS];
    if (IS_RET) {
#pragma unroll
        for (int ks = 0; ks < 4; ++ks) qf[ks] = *(const bf16x8*)(URET + (size_t)(row0 + n) * 1024 + h * 64 + ks * 16 + hf * 8);
    } else {
#pragma unroll
        for (int ks = 0; ks < NKS; ++ks) qf[ks] = *(const bf16x8*)(Q + (size_t)(row0 + n) * 384 + h * 96 + ks * 16 + hf * 8);
        if (lat) {
            const float* rope = (const float*)(C.ws + WS_ROPE); const int t = row0 - sb + n;
            const f32x4 c0 = *(const f32x4*)(rope + t * 16 + hf * 8), c1 = *(const f32x4*)(rope + t * 16 + hf * 8 + 4);
            const f32x4 s0 = *(const f32x4*)(rope + 32768 + t * 16 + hf * 8), s1 = *(const f32x4*)(rope + 32768 + t * 16 + hf * 8 + 4);
            bf16x8 a = qf[NKS - 2], bq = qf[NKS - 1]; float o1v[8], o2v[8];
#pragma unroll
            for (int j = 0; j < 8; ++j) { const float x1 = bf2f((bf16_t)a[j]), x2 = bf2f((bf16_t)bq[j]); const float cs = j < 4 ? c0[j & 3] : c1[j & 3], sn = j < 4 ? s0[j & 3] : s1[j & 3];
                o1v[j] = x1 * cs - x2 * sn; o2v[j] = x1 * sn + x2 * cs; }
            u32x4 wa, wb; wa.x = cvt_pk_bf16(o1v[0], o1v[1]); wa.y = cvt_pk_bf16(o1v[2], o1v[3]); wa.z = cvt_pk_bf16(o1v[4], o1v[5]); wa.w = cvt_pk_bf16(o1v[6], o1v[7]);
            wb.x = cvt_pk_bf16(o2v[0], o2v[1]); wb.y = cvt_pk_bf16(o2v[2], o2v[3]); wb.z = cvt_pk_bf16(o2v[4], o2v[5]); wb.w = cvt_pk_bf16(o2v[6], o2v[7]);
            qf[NKS - 2] = __builtin_bit_cast(bf16x8, wa); qf[NKS - 1] = __builtin_bit_cast(bf16x8, wb);
        }
    }
    float lgf = 0.f, lgb = 0.f;
    if (IS_RET) { const float* in25 = INF(25); lgf = log2_sigmoid(in25[(l * 2 + 0) * 4 + h]); lgb = log2_sigmoid(in25[(l * 2 + 1) * 4 + h]); }
    const int tq = row0 - sb + n;
    const int q0w = qblk * 256 + C.wid * 32;
    float mrun = -1e30f, lrun = 0.f; f32x16 o0, o1;
#pragma unroll
    for (int r = 0; r < 16; ++r) { o0[r] = 0.f; o1[r] = 0.f; }
    const int skey = C.tid >> 3, sch = C.tid & 7, rkey = C.tid >> 2, rch = C.tid & 3;
    u32x4 gk0, gk1, gr, gv0, gv1;
#define ATT_GLOAD(kt) do { \
        if (IS_RET) { \
            gk0 = *(const u32x4*)(URET + (size_t)(sb + (kt) + skey) * 1024 + 256 + h * 64 + sch * 8); gk1 = *(const u32x4*)(URET + (size_t)(sb + (kt) + skey + 64) * 1024 + 256 + h * 64 + sch * 8); \
            gv0 = *(const u32x4*)(RVT + (size_t)(h * 64 + skey) * M + sb + (kt) + sch * 8); gv1 = *(const u32x4*)(RVT + (size_t)(h * 64 + skey) * M + sb + (kt) + (sch + 8) * 8); \
        } else { \
            gk0 = *(const u32x4*)(KN + (size_t)(key0 + (kt) + skey) * 256 + h * 64 + sch * 8); gk1 = *(const u32x4*)(KN + (size_t)(key0 + (kt) + skey + 64) * 256 + h * 64 + sch * 8); \
            gv0 = *(const u32x4*)(VT + (size_t)(h * 64 + skey) * NKEY + key0 + (kt) + sch * 8); gv1 = *(const u32x4*)(VT + (size_t)(h * 64 + skey) * NKEY + key0 + (kt) + (sch + 8) * 8); \
            gr = *(const u32x4*)(KR + (size_t)(key0 + (kt) + rkey) * 32 + rch * 8); \
        } } while (0)
#define ATT_LSTORE(buf) do { \
        LAS unsigned char* kb_ = C.ldsL + (buf) * SBYTES; LAS unsigned char* vb_ = kb_ + KBYTES; \
        *(LAS u32x4*)(kb_ + skey * KP + sch * 16) = gk0; *(LAS u32x4*)(kb_ + (skey + 64) * KP + sch * 16) = gk1; \
        *(LAS u32x2*)(vb_ + skey * VP + sch * 16) = (u32x2){gv0.x, gv0.y}; *(LAS u32x2*)(vb_ + skey * VP + sch * 16 + 8) = (u32x2){gv0.z, gv0.w}; \
        *(LAS u32x2*)(vb_ + skey * VP + (sch + 8) * 16) = (u32x2){gv1.x, gv1.y}; *(LAS u32x2*)(vb_ + skey * VP + (sch + 8) * 16 + 8) = (u32x2){gv1.z, gv1.w}; \
        if (!IS_RET) *(LAS u32x4*)(kb_ + rkey * KP + 128 + rch * 16) = gr; } while (0)
    __syncthreads();
    ATT_GLOAD(0); ATT_LSTORE(0);
    __syncthreads();
    const int nst = nk >> 7;
    for (int st = 0; st < nst; ++st) {
        if (st + 1 < nst) ATT_GLOAD((st + 1) * 128);
        const LAS unsigned char* kb = C.ldsL + (st & 1) * SBYTES; const LAS unsigned char* vb = kb + KBYTES;
#pragma unroll
        for (int sub = 0; sub < 4; ++sub) {
            f32x16 s;
#pragma unroll
            for (int r = 0; r < 16; ++r) s[r] = 0.f;
#pragma unroll
            for (int ks = 0; ks < NKS; ++ks) { const bf16x8 kf = *(const LAS bf16x8*)(kb + (sub * 32 + n) * KP + ks * 32 + hf * 16); s = __builtin_amdgcn_mfma_f32_32x32x16_bf16(kf, qf[ks], s, 0, 0, 0); }
            if (IS_RET) {
                const int kt = st * 128 + sub * 32;
                if (kt < q0w) {
                    const float base = lgf * (float)(tq - kt - 4 * hf) - 3.0f;
#pragma unroll
                    for (int r = 0; r < 16; ++r) s[r] = s[r] * __builtin_amdgcn_exp2f(fmaxf(base - lgf * (float)(8 * (r >> 2) + (r & 3)), -126.0f));
                } else if (kt > q0w) {
                    const float base = lgb * (float)(kt + 4 * hf - tq) - 3.0f;
#pragma unroll
                    for (int r = 0; r < 16; ++r) s[r] = s[r] * __builtin_amdgcn_exp2f(fmaxf(base + lgb * (float)(8 * (r >> 2) + (r & 3)), -126.0f));
                } else {
#pragma unroll
                    for (int r = 0; r < 16; ++r) { const int sp = kt + 8 * (r >> 2) + 4 * hf + (r & 3); const int dd = tq - sp;
                        const float w = dd > 0 ? exp2f(lgf * (float)dd) : (dd < 0 ? exp2f(lgb * (float)(-dd)) : 2.0f);
                        s[r] = s[r] * w * 0.125f; }
                }
            } else {
                float mx = s[0];
#pragma unroll
                for (int r = 1; r < 16; ++r) mx = fmaxf(mx, s[r]);
                mx = fmaxf(mx, shx(mx, 32, C.lane));
                const float mnew = fmaxf(mrun, mx);
                if (__ballot(mnew > mrun) != 0ull) {
                    const float alpha = __builtin_amdgcn_exp2f(fmaxf(mrun - mnew, -126.0f)); mrun = mnew; lrun *= alpha;
#pragma unroll
                    for (int r = 0; r < 16; ++r) { o0[r] *= alpha; o1[r] *= alpha; }
                }
                float ls = 0.f;
#pragma unroll
                for (int r = 0; r < 16; ++r) { s[r] = __builtin_amdgcn_exp2f(fmaxf(s[r] - mrun, -126.0f)); ls += s[r]; }
                lrun += ls;
            }
#pragma unroll
            for (int s2 = 0; s2 < 2; ++s2) {
                u32x4 pw; pw.x = cvt_pk_bf16(s[8 * s2], s[8 * s2 + 1]); pw.y = cvt_pk_bf16(s[8 * s2 + 2], s[8 * s2 + 3]); pw.z = cvt_pk_bf16(s[8 * s2 + 4], s[8 * s2 + 5]); pw.w = cvt_pk_bf16(s[8 * s2 + 6], s[8 * s2 + 7]);
                const bf16x8 pf = __builtin_bit_cast(bf16x8, pw);
                const LAS unsigned char* v0p = vb + n * VP + (sub * 32 + 16 * s2 + 4 * hf) * 2; const LAS unsigned char* v1p = v0p + 32 * VP;
                const u32x2 a0 = *(const LAS u32x2*)v0p, a1 = *(const LAS u32x2*)(v0p + 16), b0 = *(const LAS u32x2*)v1p, b1 = *(const LAS u32x2*)(v1p + 16);
                const u32x4 va = (u32x4){a0.x, a0.y, a1.x, a1.y}, vbv = (u32x4){b0.x, b0.y, b1.x, b1.y};
                o0 = __builtin_amdgcn_mfma_f32_32x32x16_bf16(__builtin_bit_cast(bf16x8, va), pf, o0, 0, 0, 0);
                o1 = __builtin_amdgcn_mfma_f32_32x32x16_bf16(__builtin_bit_cast(bf16x8, vbv), pf, o1, 0, 0, 0);
            }
        }
        if (st + 1 < nst) ATT_LSTORE((st + 1) & 1);
        __syncthreads();
    }
    if (!IS_RET) {
        bf16_t* Y = (bf16_t*)((unsigned char*)C.out + 33554432) + (size_t)1 * M * 256;
        lrun += shx(lrun, 32, C.lane);
        const float inv = 1.0f / lrun;
        bf16_t* yp = Y + (size_t)(row0 + n) * 256 + h * 64 + 4 * hf;
#pragma unroll
        for (int g4 = 0; g4 < 4; ++g4) {
            u32x2 w0, w1; w0.x = cvt_pk_bf16(o0[4 * g4] * inv, o0[4 * g4 + 1] * inv); w0.y = cvt_pk_bf16(o0[4 * g4 + 2] * inv, o0[4 * g4 + 3] * inv);
            w1.x = cvt_pk_bf16(o1[4 * g4] * inv, o1[4 * g4 + 1] * inv); w1.y = cvt_pk_bf16(o1[4 * g4 + 2] * inv, o1[4 * g4 + 3] * inv);
            *(u32x2*)(yp + 8 * g4) = w0; *(u32x2*)(yp + 32 + 8 * g4) = w1;
        }
    } else {
        bf16_t* Y = (bf16_t*)((unsigned char*)C.out + 33554432) + (size_t)2 * M * 256;
        if (lat) {
            const bf16_t* S0T = (const bf16_t*)(C.ws + WS_S0T);
#pragma unroll
            for (int dir = 0; dir < 2; ++dir) {
                const bf16_t* stp = S0T + ((((size_t)b * 2 + l) * 2 + dir) * 4 + h) * 4096;
                f32x16 a0, a1;
#pragma unroll
                for (int r = 0; r < 16; ++r) { a0[r] = 0.f; a1[r] = 0.f; }
#pragma unroll
                for (int ks = 0; ks < 4; ++ks) {
                    const bf16x8 s0 = *(const bf16x8*)(stp + (size_t)n * 64 + ks * 16 + hf * 8), s1 = *(const bf16x8*)(stp + (size_t)(32 + n) * 64 + ks * 16 + hf * 8);
                    a0 = __builtin_amdgcn_mfma_f32_32x32x16_bf16(s0, qf[ks], a0, 0, 0, 0);
                    a1 = __builtin_amdgcn_mfma_f32_32x32x16_bf16(s1, qf[ks], a1, 0, 0, 0);
                }
                const float w = dir == 0 ? exp2f(lgf * (float)(tq + 1)) : exp2f(lgb * (float)(L - tq));
#pragma unroll
                for (int r = 0; r < 16; ++r) { o0[r] += w * a0[r]; o1[r] += w * a1[r]; }
            }
        }
        float sm = 0.f;
#pragma unroll
        for (int r = 0; r < 16; ++r) sm += o0[r] + o1[r];
        sm += shx(sm, 32, C.lane);
        const float mu = sm * (1.0f / 64.0f);
        float vr = 0.f;
#pragma unroll
        for (int r = 0; r < 16; ++r) { const float d0 = o0[r] - mu, d1 = o1[r] - mu; vr += d0 * d0 + d1 * d1; }
        vr += shx(vr, 32, C.lane);
        const float rs = rsqrtf(vr * (1.0f / 64.0f) + 1e-6f);
        const bf16_t* gp = URET + (size_t)(row0 + n) * 1024 + 768 + h * 64 + 4 * hf;
        bf16_t* yp = Y + (size_t)(row0 + n) * 256 + h * 64 + 4 * hf;
#pragma unroll
        for (int g4 = 0; g4 < 4; ++g4) {
            const u32x2 ga = *(const u32x2*)(gp + 8 * g4), gb = *(const u32x2*)(gp + 32 + 8 * g4);
            const float g0[4] = {bflo(ga.x), bfhi(ga.x), bflo(ga.y), bfhi(ga.y)}, g1[4] = {bflo(gb.x), bfhi(gb.x), bflo(gb.y), bfhi(gb.y)};
            float y0[4], y1[4];
#pragma unroll
            for (int j = 0; j < 4; ++j) { y0[j] = (o0[4 * g4 + j] - mu) * rs * (g0[j] * sigmoidf_(g0[j])); y1[j] = (o1[4 * g4 + j] - mu) * rs * (g1[j] * sigmoidf_(g1[j])); }
            u32x2 w0, w1; w0.x = cvt_pk_bf16(y0[0], y0[1]); w0.y = cvt_pk_bf16(y0[2], y0[3]); w1.x = cvt_pk_bf16(y1[0], y1[1]); w1.y = cvt_pk_bf16(y1[2], y1[3]);
            *(u32x2*)(yp + 8 * g4) = w0; *(u32x2*)(yp + 32 + 8 * g4) = w1;
        }
    }
    __syncthreads();
}

__device__ __forceinline__ void ret_state(const Ctx& C0, int l0) { const int l = launder_s(l0); const Ctx C = launder(C0); const float* in25 = INF(25);
    const bf16_t* URET = (const bf16_t*)(C.ws + WS_AR + A_URET);
    float* out = C.out + 19398656;
    LAS unsigned char* ksm = C.ldsL; LAS unsigned char* vsm = C.ldsL + 256 * 144;
    for (int item = C.bid; item < 256; item += C.G) {
        const int b = item >> 3, h = (item >> 1) & 3, dir = item & 1;
        const float lg = log2_sigmoid(in25[(l * 2 + dir) * 4 + h]);
        __syncthreads();
#pragma unroll
        for (int j = 0; j < 4; ++j) { const int row = (C.tid >> 3) + 64 * j, ch = C.tid & 7; const bf16_t* rp = URET + (size_t)(b * 256 + row) * 1024 + h * 64 + ch * 8;
            *(LAS u32x4*)(ksm + row * 144 + ch * 16) = *(const u32x4*)(rp + 256); *(LAS u32x4*)(vsm + row * 144 + ch * 16) = *(const u32x4*)(rp + 512); }
        __syncthreads();
        const int dk = C.tid >> 3, dv8 = C.tid & 7;
        float a[8];
#pragma unroll
        for (int j = 0; j < 8; ++j) a[j] = 0.f;
#pragma unroll 4
        for (int s = 0; s < 256; ++s) {
            const float w = exp2f(lg * (float)(dir == 0 ? 255 - s : s)) * 0.125f;
            const float kk = bf2f(*(const LAS bf16_t*)(ksm + s * 144 + dk * 2)) * w;
            const u32x4 v = *(const LAS u32x4*)(vsm + s * 144 + dv8 * 16);
            a[0] += kk * bflo(v.x); a[1] += kk * bfhi(v.x); a[2] += kk * bflo(v.y); a[3] += kk * bfhi(v.y);
            a[4] += kk * bflo(v.z); a[5] += kk * bfhi(v.z); a[6] += kk * bflo(v.w); a[7] += kk * bfhi(v.w);
        }
        float* op = out + ((((size_t)b * 2 + l) * 2 + dir) * 4 + h) * 4096 + dk * 64 + dv8 * 8;
        *(f32x4*)op = (f32x4){a[0], a[1], a[2], a[3]}; *(f32x4*)(op + 4) = (f32x4){a[4], a[5], a[6], a[7]};
    }
    __syncthreads();
}

__device__ __forceinline__ void merge_phase(const Ctx& C0, int l0) { const int l = launder_s(l0); const Ctx C = launder(C0); const float* gbias = INF(33) + l * 4096;
    const bf16_t* YB = (const bf16_t*)((unsigned char*)C.out + 33554432); const bf16_t* BO = (const bf16_t*)(C.ws + WS_W + W_BOUT);
    const unsigned char* GT = (const unsigned char*)(C.ws + WS_AR + A_GT); bf16_t* MG = (bf16_t*)C.out;
    constexpr int AP = 72;
    constexpr int ABYTES = 256 * AP * 2, BBYTES = 128 * AP * 2, SBYTES = ABYTES + BBYTES;
    const int wm = C.wid >> 1, wn = C.wid & 1, n = C.lane & 31, hf = C.lane >> 5;
    for (int tile = C.bid; tile < 512; tile += C.G) {
        int pm = tile >> 3, pn = tile & 7;
        if (C.G == 256) { const int x = C.bid & 7, j = C.bid >> 3; pm = x * 4 + (j >> 3) + 32 * (tile >> 8); pn = j & 7; }
        f32x16 acc[2][2], tot[2][2];
#pragma unroll
        for (int a = 0; a < 2; ++a)
#pragma unroll
            for (int b = 0; b < 2; ++b)
#pragma unroll
                for (int r = 0; r < 16; ++r) { acc[a][b][r] = 0.f; tot[a][b][r] = 0.f; }
        u32x4 ra[4], rb[2];
        auto gload = [&](int it) {
            const int br = it >> 2, kc = it & 3;
#pragma unroll
            for (int j = 0; j < 4; ++j) { const int q = C.tid + NT * j, row = q >> 3, kp = q & 7; ra[j] = *(const u32x4*)(YB + ((size_t)br * M + pm * 256 + row) * 256 + kc * 64 + kp * 8); }
#pragma unroll
            for (int j = 0; j < 2; ++j) { const int q = C.tid + NT * j, col = q >> 3, kp = q & 7; rb[j] = *(const u32x4*)(BO + ((size_t)br * 1024 + pn * 128 + col) * 256 + kc * 64 + kp * 8); }
        };
        auto lstore = [&](int buf) {
            LAS unsigned char* sa = C.ldsL + buf * SBYTES; LAS unsigned char* sbp = sa + ABYTES;
#pragma unroll
            for (int j = 0; j < 4; ++j) { const int q = C.tid + NT * j, row = q >> 3, kp = q & 7; *(LAS u32x4*)(sa + (row * AP + kp * 8) * 2) = ra[j]; }
#pragma unroll
            for (int j = 0; j < 2; ++j) { const int q = C.tid + NT * j, col = q >> 3, kp = q & 7; *(LAS u32x4*)(sbp + (col * AP + kp * 8) * 2) = rb[j]; }
        };
        __syncthreads();
        ((LAS float*)(C.ldsL + 2 * SBYTES))[C.tid] = gbias[(C.tid >> 7) * 1024 + pn * 128 + (C.tid & 127)];
        gload(0); lstore(0);
        __syncthreads();
        for (int it = 0; it < 16; ++it) {
            if (it < 15) gload(it + 1);
            unsigned gwq[2][4];
            if ((it & 3) == 3) {
#pragma unroll
                for (int nt = 0; nt < 2; ++nt)
#pragma unroll
                    for (int g4 = 0; g4 < 4; ++g4)
                        gwq[nt][g4] = *(const unsigned*)(GT + ((size_t)pm * 256 + wm * 64 + n) * 4096 + (it >> 2) * 1024 + pn * 128 + wn * 64 + nt * 32 + 4 * hf + 8 * g4);
            }
            const LAS unsigned char* sa = C.ldsL + (it & 1) * SBYTES; const LAS unsigned char* sbp = sa + ABYTES;
#pragma unroll
            for (int kk = 0; kk < 4; ++kk) {
                bf16x8 af[2], bfr[2];
#pragma unroll
                for (int mt = 0; mt < 2; ++mt) af[mt] = *(const LAS bf16x8*)(sa + ((wm * 64 + mt * 32 + n) * AP + kk * 16 + hf * 8) * 2);
#pragma unroll
                for (int nt = 0; nt < 2; ++nt) bfr[nt] = *(const LAS bf16x8*)(sbp + ((wn * 64 + nt * 32 + n) * AP + kk * 16 + hf * 8) * 2);
#pragma unroll
                for (int mt = 0; mt < 2; ++mt)
#pragma unroll
                    for (int nt = 0; nt < 2; ++nt) acc[mt][nt] = __builtin_amdgcn_mfma_f32_32x32x16_bf16(bfr[nt], af[mt], acc[mt][nt], 0, 0, 0);
            }
            if ((it & 3) == 3) {
                const int br = it >> 2;
#pragma unroll
                for (int mt = 0; mt < 2; ++mt) {
                    const size_t R = (size_t)pm * 256 + wm * 64 + mt * 32 + n;
#pragma unroll
                    for (int nt = 0; nt < 2; ++nt) {
#pragma unroll
                        for (int g4 = 0; g4 < 4; ++g4) { const int gw = mt == 0 ? (int)gwq[nt][g4] : (int)*(const unsigned*)(GT + R * 4096 + br * 1024 + pn * 128 + wn * 64 + nt * 32 + 4 * hf + 8 * g4); const f32x4 gb4 = *(const LAS f32x4*)(C.ldsL + 2 * SBYTES + (br * 128 + wn * 64 + nt * 32 + 4 * hf + 8 * g4) * 4);
                            const float q0 = sigmoidf_(__builtin_amdgcn_cvt_f32_fp8(gw, 0) + gb4[0]), q1 = sigmoidf_(__builtin_amdgcn_cvt_f32_fp8(gw, 1) + gb4[1]), q2 = sigmoidf_(__builtin_amdgcn_cvt_f32_fp8(gw, 2) + gb4[2]), q3 = sigmoidf_(__builtin_amdgcn_cvt_f32_fp8(gw, 3) + gb4[3]);
                            tot[mt][nt][4 * g4] += q0 * acc[mt][nt][4 * g4]; tot[mt][nt][4 * g4 + 1] += q1 * acc[mt][nt][4 * g4 + 1];
                            tot[mt][nt][4 * g4 + 2] += q2 * acc[mt][nt][4 * g4 + 2]; tot[mt][nt][4 * g4 + 3] += q3 * acc[mt][nt][4 * g4 + 3]; }
#pragma unroll
                        for (int r = 0; r < 16; ++r) acc[mt][nt][r] = 0.f;
                    }
                }
            }
            if (it < 15) lstore((it + 1) & 1);
            __syncthreads();
        }
#pragma unroll
        for (int mt = 0; mt < 2; ++mt) {
            const size_t R = (size_t)pm * 256 + wm * 64 + mt * 32 + n;
#pragma unroll
            for (int nt = 0; nt < 2; ++nt) {
                bf16_t* op = MG + R * 1024 + pn * 128 + wn * 64 + nt * 32 + 4 * hf;
#pragma unroll
                for (int g4 = 0; g4 < 4; ++g4) { u32x2 w; w.x = cvt_pk_bf16(tot[mt][nt][4 * g4], tot[mt][nt][4 * g4 + 1]); w.y = cvt_pk_bf16(tot[mt][nt][4 * g4 + 2], tot[mt][nt][4 * g4 + 3]); *(u32x2*)(op + 8 * g4) = w; }
            }
        }
    }
    __syncthreads();
}

#define XB_TMO      128
#define XB_XCNT(j)  (256  + 64 * (j))
#define XB_XSUB(j)  (1280 + 64 * (j))
#define XB_XGEN(j)  (2304 + 64 * (j))
#define XB_TOP      3328
#define XB_TOPGEN   3392
#define XCD_BAR_WORDS 3456
#define XB_SPIN_CAP (1u << 20)
__device__ __forceinline__ unsigned xb_ld(unsigned* p)              { return __hip_atomic_load(p, __ATOMIC_RELAXED, __HIP_MEMORY_SCOPE_AGENT); }
__device__ __forceinline__ unsigned xb_add(unsigned* p, unsigned v) { return __hip_atomic_fetch_add(p, v, __ATOMIC_RELAXED, __HIP_MEMORY_SCOPE_AGENT); }
__device__ __forceinline__ unsigned xb_xcc_id() { return (unsigned)__builtin_amdgcn_s_getreg((3 << 11) | 20) & 0xFu; }
#define XB_SPIN(cond, bar) do { unsigned _sp = 0; while (cond) { __builtin_amdgcn_s_sleep(1); \
    if ((++_sp & 255u) == 0u) { if (xb_ld(&(bar)[XB_TMO])) break; if (_sp > XB_SPIN_CAP) { atomicAdd(&(bar)[XB_TMO], 1u); break; } } } } while (0)
__device__ __forceinline__ void xcd_barrier_complete(unsigned* bar, unsigned x, unsigned G, unsigned& nloc, unsigned& nx) {
    unsigned sum, cnt, mine, sp = 0u;
    for (;;) {
        sum = 0u; cnt = 0u; mine = 0u;
#pragma unroll
        for (unsigned j = 0; j < 16; ++j) { const unsigned c = xb_ld(&bar[XB_XCNT(j)]); sum += c; cnt += (c > 0u) ? 1u : 0u; mine = (j == x) ? c : mine; }
        if (sum == G) break;
        __builtin_amdgcn_s_sleep(1);
        if ((++sp & 255u) == 0u) { if (xb_ld(&bar[XB_TMO])) break; if (sp > XB_SPIN_CAP) { atomicAdd(&bar[XB_TMO], 1u); break; } }
    }
    nloc = mine > 0u ? mine : 1u; nx = cnt > 0u ? cnt : 1u;
}
__device__ __forceinline__ void grid_bar(unsigned* bar, volatile LAS unsigned* st, unsigned G, int wid, int lane) {
    asm volatile("s_waitcnt vmcnt(0)" ::: "memory");
    __syncthreads();
    if (wid == 0 && lane == 0) {
        __builtin_amdgcn_s_waitcnt(0);
        const unsigned x = xb_xcc_id();
        unsigned nloc = st[0], nx = st[1];
        if (nloc == 0u) { xcd_barrier_complete(bar, x, G, nloc, nx); st[0] = nloc; st[1] = nx; }
        const unsigned old = xb_add(&bar[XB_XSUB(x)], 1u);
        const unsigned gen = old / nloc;
        if (old + 1u == (gen + 1u) * nloc) {
            __builtin_amdgcn_fence(__ATOMIC_RELEASE, "agent");
            asm volatile("s_waitcnt vmcnt(0)" ::: "memory");
            const unsigned og = xb_add(&bar[XB_TOP], 1u);
            const unsigned tg = og / nx;
            if (og + 1u == (tg + 1u) * nx) xb_add(&bar[XB_TOPGEN], 1u);
            else XB_SPIN(xb_ld(&bar[XB_TOPGEN]) == tg, bar);
            __builtin_amdgcn_fence(__ATOMIC_ACQUIRE, "agent");
            xb_add(&bar[XB_XGEN(x)], 1u);
            asm volatile("s_waitcnt vmcnt(0)" ::: "memory");
        } else {
            XB_SPIN(xb_ld(&bar[XB_XGEN(x)]) == gen, bar);
            __builtin_amdgcn_fence(__ATOMIC_ACQUIRE, "agent");
            asm volatile("s_waitcnt vmcnt(0)" ::: "memory");
        }
    }
    __syncthreads();
}
__global__ void __launch_bounds__(NT, 2) fwd_megakernel(Params prm) {
    extern __shared__ __attribute__((aligned(16))) unsigned char lds[];
    cg::grid_group grid = cg::this_grid();
    LAS unsigned long long* tabw = (LAS unsigned long long*)((LAS unsigned char*)lds + 131072);
    if (threadIdx.x < 39) tabw[threadIdx.x] = (unsigned long long)prm.in[threadIdx.x];
    __syncthreads();
    Ctx Cm; { Ctx& C = Cm; C.tab = (const LAS unsigned*)tabw; C.out = prm.out; C.ws = prm.ws; C.lds = lds; C.ldsL = (LAS unsigned char*)lds; C.tid = threadIdx.x; C.lane = C.tid & 63; C.wid = __builtin_amdgcn_readfirstlane(C.tid >> 6); C.bid = blockIdx.x; C.G = gridDim.x; }
    const Ctx& C = Cm;
    bf16_t* X = (bf16_t*)(prm.ws + WS_HB);
#define PH_PTRS const Ctx C = launder(Cm); const int lq = launder_s(l); (void)lq; unsigned char* ws = C.ws; asm volatile("" : "+s"(ws)); unsigned char* AR = ws + WS_AR; unsigned char* W = ws + WS_W; (void)AR; (void)W;

    const int lo = prm.ph_lo, hi = prm.ph_hi;
    int ph = 0;
    unsigned* barw = (unsigned*)(prm.ws + WS_BAR);
#define GSYNC() do { const Ctx Cb = launder(C); grid_bar(barw, (volatile LAS unsigned*)((LAS unsigned char*)lds + 131072 + 384), (unsigned)Cb.G, Cb.wid, Cb.lane); } while (0)
#define PH_BEGIN if (ph >= lo && ph < hi) { for (int rep_ = 0; rep_ < 1 + (int)((DUP_MASK >> ph) & 1u); ++rep_) { if (rep_) __syncthreads();
#define PH_END } } if (ph >= lo && ph + 1 < hi) { GSYNC(); if (ph == 0) for (int xb_ = 0; xb_ < EXTRA_BAR; ++xb_) GSYNC(); } ++ph;
    if (hi - lo > 1) {
        if (threadIdx.x < 2) ((LAS unsigned*)((LAS unsigned char*)lds + 131072 + 384))[threadIdx.x] = 0u;
        if (blockIdx.x == 0) for (int i = threadIdx.x; i < XCD_BAR_WORDS; i += NT) __hip_atomic_store(barw + i, 0u, __ATOMIC_RELAXED, __HIP_MEMORY_SCOPE_AGENT);
        asm volatile("s_waitcnt vmcnt(0)" ::: "memory"); __builtin_amdgcn_fence(__ATOMIC_RELEASE, "agent"); asm volatile("s_waitcnt vmcnt(0)" ::: "memory");
        grid.sync();
        __builtin_amdgcn_fence(__ATOMIC_ACQUIRE, "agent"); asm volatile("s_waitcnt vmcnt(0)" ::: "memory");
        if (threadIdx.x == 0) (void)xb_add(&barw[XB_XCNT(xb_xcc_id())], 1u);
        __syncthreads();
    }
    PH_BEGIN p0_mod(C); p0_filters(C); p0_misc(C); PH_END
    for (int l = 0; l < 2; ++l) {
        PH_BEGIN
        norm_phase(C, l, 0);
        convert_weights(C, l);
        if (l == 0) build_rg(C);
        PH_END
        PH_BEGIN
        { PH_PTRS pg8::Gemm g{(const bf16_t*)C.out, (const bf16_t*)(W + W_PROJ), M, 2816, 1024}; pg8::StaticOrder S; S.init(M, 2816, C.G, C.bid);
          pg8::EpiProj E{(bf16_t*)(AR + A_UHY), (bf16_t*)(AR + A_UMLA), (bf16_t*)(AR + A_URET), (bf16_t*)(AR + A_UCONF)};
          pg8::gemm_phase<pg8::EpiProj>(C.ldsL, g, S, E, C.wid); }
        PH_END
        PH_BEGIN prep_phase(C, l); PH_END
        PH_BEGIN
        { PH_PTRS pg8::Gemm g{(const bf16_t*)(AR + A_CQN), (const bf16_t*)(W + W_UQ), M, 512, 256}; pg8::StaticOrder S; S.init(M, 512, C.G, C.bid);
          pg8::EpiPlain E{(bf16_t*)(AR + A_Q), 384, 384};
          pg8::gemm_phase<pg8::EpiPlain>(C.ldsL, g, S, E, C.wid); }
        { PH_PTRS pg8::Gemm g{(const bf16_t*)(AR + A_CKN), (const bf16_t*)(W + W_UK), NKEY, 256, 256}; pg8::StaticOrder S; S.init(NKEY, 256, C.G, (C.bid + C.G - 128) % C.G);
          pg8::EpiPlain E{(bf16_t*)(AR + A_KN), 256, 256};
          pg8::gemm_phase<pg8::EpiPlain>(C.ldsL, g, S, E, C.wid); }
        { PH_PTRS pg8::Gemm g{(const bf16_t*)(W + W_UV), (const bf16_t*)(AR + A_CKN), 256, NKEY, 256}; pg8::StaticOrder S; S.init(256, NKEY, C.G, (C.bid + C.G - 196) % C.G);
          pg8::EpiPlain E{(bf16_t*)(AR + A_VT), NKEY, NKEY};
          pg8::gemm_phase<pg8::EpiPlain>(C.ldsL, g, S, E, C.wid); }
        hyena_phase(C, l);
        PH_END
        PH_BEGIN
        { const Ctx Ca = launder(C);
          for (int p0_ = Ca.bid; p0_ < 256; p0_ += Ca.G) {
              const int p = (Ca.G == 256) ? ((p0_ & 7) * 32 + (p0_ >> 3)) : p0_;
              const int q = p & 127; const bool first = p < 128;
              att_block<false>(C, l, first, first ? (q >> 5) : (q >> 2), first ? ((q >> 3) & 3) : (q & 3), first ? (q & 7) : 0);
              att_block<true>(C, l, !first, first ? (q >> 2) : (q >> 5), first ? (q & 3) : ((q >> 3) & 3), first ? 0 : (q & 7));
          }
          ret_state(C, l); }
        PH_END
        PH_BEGIN
        { PH_PTRS pg8::Gemm g{(const bf16_t*)C.out, (const bf16_t*)(W + W_GATE), M, 4096, 1024}; pg8::StaticOrder S; S.init(M, 4096, C.G, C.bid);
          pg8::EpiGate E{(unsigned char*)(AR + A_GT), 4096};
          pg8::gemm_phase<pg8::EpiGate>(C.ldsL, g, S, E, C.wid); }
        PH_END
        PH_BEGIN merge_phase(C, l); PH_END
        PH_BEGIN
        { PH_PTRS pg8::Gemm g{(const bf16_t*)C.out, (const bf16_t*)(W + W_O), M, 1024, 1024}; pg8::StaticOrder S; S.init(M, 1024, C.G, C.bid);
          pg8::EpiResid E{X, (const float*)(ws + WS_MOD) + (size_t)lq * 5 * 6144 + 2048};
          pg8::gemm_phase<pg8::EpiResid>(C.ldsL, g, S, E, C.wid); }
        PH_END
        PH_BEGIN norm_phase(C, l, 1); PH_END
        PH_BEGIN
        { PH_PTRS pg8::Gemm g{(const bf16_t*)C.out, (const bf16_t*)(W + W_1), M, 5632, 1024}; pg8::StaticOrder S; S.init(M, 5632, C.G, C.bid);
          pg8::EpiFfn1 E{(bf16_t*)(AR + A_ACT)};
          pg8::gemm_phase<pg8::EpiFfn1>(C.ldsL, g, S, E, C.wid); }
        PH_END
        PH_BEGIN
        { PH_PTRS pg8::Gemm g{(const bf16_t*)(AR + A_ACT), (const bf16_t*)(W + W_2), M, 1024, 2816}; pg8::StaticOrder S; S.init(M, 1024, C.G, C.bid);
          pg8::EpiResid E{X, (const float*)(ws + WS_MOD) + (size_t)lq * 5 * 6144 + 5120};
          pg8::gemm_phase<pg8::EpiResid>(C.ldsL, g, S, E, C.wid); }
        PH_END
    }
    PH_BEGIN final_norm(C); PH_END
}

extern "C" void kernel_launch(void* const* d_in, const int* in_sizes, int n_in, void* d_out, int out_size, void* d_ws, size_t ws_size, hipStream_t stream) {
    static int grid = 0;
    if (grid == 0) {
        if (n_in != 39 || ws_size < WS_NEED) { fprintf(stderr, "kernel_launch: unexpected n_in %d / ws_size %zu (need %zu)\n", n_in, ws_size, (size_t)WS_NEED); grid = -1; return; }
        int dev = 0, cus = 0, per_cu = 0;
        hipGetDevice(&dev);
        hipDeviceGetAttribute(&cus, hipDeviceAttributeMultiprocessorCount, dev);
        if (hipFuncSetAttribute((const void*)fwd_megakernel, hipFuncAttributeMaxDynamicSharedMemorySize, LDS_BYTES) != hipSuccess) { fprintf(stderr, "kernel_launch: hipFuncSetAttribute failed\n"); grid = -1; return; }
        if (hipOccupancyMaxActiveBlocksPerMultiprocessor(&per_cu, (const void*)fwd_megakernel, NT, LDS_BYTES) != hipSuccess || per_cu < 1) { fprintf(stderr, "kernel_launch: occupancy query gives %d\n", per_cu); per_cu = 1; }
        (void)hipGetLastError();
        grid = cus;
    }
    if (grid < 0) return;
    Params p{};
    for (int i = 0; i < 39; ++i) p.in[i] = (const float*)d_in[i];
    p.out = (float*)d_out; p.ws = (unsigned char*)d_ws;
    if (hipMemsetAsync((unsigned char*)d_ws + WS_BAR, 0, 16384, stream) != hipSuccess) { fprintf(stderr, "memset failed\n"); return; }
#if MK_PER_PHASE
    for (int k = 0; k < 24; ++k) { p.ph_lo = k; p.ph_hi = k + 1; hipLaunchKernelGGL(fwd_megakernel, dim3(grid), dim3(NT), LDS_BYTES, stream, p); }
#else
    p.ph_lo = 0; p.ph_hi = 24;
    void* args[] = {&p};
    hipError_t e = hipLaunchCooperativeKernel((const void*)fwd_megakernel, dim3(grid), dim3(NT), args, LDS_BYTES, stream);
    if (e != hipSuccess) fprintf(stderr, "cooperative launch failed: %s (grid %d)\n", hipGetErrorString(e), grid);
#endif
}
```

```cpp
#include <hip/hip_runtime.h>
#include <hip/hip_cooperative_groups.h>
#include <cstdio>
namespace cg = cooperative_groups;

#define LAS __attribute__((address_space(3)))
typedef unsigned short bf16_t;
typedef short bf16x8 __attribute__((ext_vector_type(8)));
typedef short bf16x4 __attribute__((ext_vector_type(4)));
typedef float f32x4 __attribute__((ext_vector_type(4)));
typedef float f32x2 __attribute__((ext_vector_type(2)));
typedef float f32x16 __attribute__((ext_vector_type(16)));
typedef unsigned u32x4 __attribute__((ext_vector_type(4)));
typedef unsigned u32x2 __attribute__((ext_vector_type(2)));

constexpr int M = 16384, D = 1024, MC = 8192, NKEY = 17408, DFF = 2816;
constexpr int LDS_BYTES = 131072 + 512;
constexpr int NT = 512;
#ifndef DBG_FFN
#define DBG_FFN 1
#define DBG_WO 1
#define DBG_HYCONV 1
#endif
#ifndef MK_PER_PHASE
#define MK_PER_PHASE 0
#endif
#ifndef DUP_MASK
#define DUP_MASK 0u
#endif
#ifndef EXTRA_BAR
#define EXTRA_BAR 0
#endif
#ifndef DBG_MASK
#define DBG_MASK 0
#define DBG_GATEHALF 0
#endif

constexpr size_t WS_BAR = 0;
constexpr size_t WS_MOD = 16384;
constexpr size_t WS_ROPE = WS_MOD + 245760;
constexpr size_t WS_S0T = WS_ROPE + 262144;
constexpr size_t WS_HP = WS_S0T + 524288;
constexpr size_t WS_RG = WS_HP + 294912;
constexpr size_t RG_LAYER = 4718592;
constexpr size_t WS_W = WS_RG + 2 * RG_LAYER;
constexpr size_t W_PROJ = 0, W_GATE = W_PROJ + 5767168, W_O = W_GATE + 8388608, W_1 = W_O + 2097152, W_2 = W_1 + 11534336,
                 W_BOUT = W_2 + 5767168, W_UQ = W_BOUT + 2097152, W_UK = W_UQ + 262144, W_UV = W_UK + 131072, W_TOTAL = W_UV + 131072;
constexpr size_t WS_HB = WS_W + W_TOTAL;
constexpr size_t WS_YB = WS_HB + 33554432;
constexpr size_t WS_AR = WS_YB + 33554432;
constexpr size_t A_UHY = 0, A_UMLA = A_UHY + 25165824, A_UCONF = A_UMLA + 13631488, A_URET = A_UCONF + 16777216,
                 A_ZT = A_URET + 33554432, A_CQN = A_ZT + 25165824, A_CKN = A_CQN + 8388608, A_KR = A_CKN + 8912896,
                 A_RVT = A_KR + 1114112, A_END = A_RVT + 8388608;
constexpr size_t A_Q = 0, A_KN = A_Q + 12582912, A_VT = A_KN + 8912896;
constexpr size_t A_GT = 0, A_ACT = 0, A_HRAW = 0;
constexpr size_t WS_NEED = WS_AR + A_END;
static_assert(A_VT + 8912896 <= A_UCONF, "alias");
static_assert(WS_NEED <= 268435456ull, "ws");

struct Params { const float* in[39]; float* out; unsigned char* ws; int ph_lo, ph_hi; };

__device__ __forceinline__ unsigned cvt_pk_bf16(float lo, float hi) { unsigned r; asm("v_cvt_pk_bf16_f32 %0, %1, %2" : "=v"(r) : "v"(lo), "v"(hi)); return r; }
__device__ __forceinline__ bf16_t f2bf(float f) { return (bf16_t)(cvt_pk_bf16(f, 0.f) & 0xffffu); }
__device__ __forceinline__ float bf2f(bf16_t b) { return __uint_as_float(((unsigned)b) << 16); }
__device__ __forceinline__ float bflo(unsigned w) { return __uint_as_float(w << 16); }
__device__ __forceinline__ float bfhi(unsigned w) { return __uint_as_float(w & 0xffff0000u); }
__device__ __forceinline__ float sigmoidf_(float x) { return __builtin_amdgcn_rcpf(1.0f + __expf(-x)); }
__device__ __forceinline__ int lane_id_v() { int l; asm volatile("v_mbcnt_lo_u32_b32 %0, -1, 0\n\tv_mbcnt_hi_u32_b32 %0, -1, %0" : "=v"(l)); return l; }
__device__ __forceinline__ float shx(float v, int mask, int lane) { return __int_as_float(__builtin_amdgcn_ds_bpermute((lane ^ mask) << 2, __float_as_int(v))); }
__device__ __forceinline__ float wave_sum_l(float v, int lane) {
#pragma unroll
    for (int o = 32; o >= 1; o >>= 1) v += shx(v, o, lane);
    return v;
}
__device__ __forceinline__ int midx_of_row(int row) { return row < MC ? 0 : 1 + ((row - MC) >> 11); }

namespace pg8 {
constexpr int BM = 256, BK = 64, HALF = 128, HTB = HALF * BK * 2, STAGE_BYTES = 8 * HTB, NXCD = 8, WGM = 8;
__host__ __device__ __forceinline__ int lds_byte(int r, int c) { const int st = (r >> 4) * 2 + (c >> 5), rr = r & 15, cc = c & 31, ob = rr * 64 + cc * 2; return st * 1024 + (ob ^ (((ob >> 9) & 1) << 5)); }
__host__ __device__ __forceinline__ void stage_rc(int b, int& R, int& C) { const int st = b / 1024, sb = b % 1024, swz = sb ^ (((sb >> 9) & 1) << 5); R = (st >> 1) * 16 + swz / 64; C = (st & 1) * 32 + (swz % 64) / 2; }
__host__ __device__ __forceinline__ int perm32(int rho) { const int n = rho >> 4, i = rho & 15; return 8 * (i >> 2) + 4 * n + (i & 3); }
struct Unit { int pm, pn; };
struct Gemm { const bf16_t* A; const bf16_t* Bt; int M, N, K; };
struct StaticOrder {
    int nM, nN, nwg, G, c;
    __device__ void init(int M_, int N_, int G_, int c_) { nM = M_ / BM; nN = N_ / BM; nwg = nM * nN; G = G_; c = c_; }
    __device__ bool next(int i, Unit& u) const {
        const long L = (long)i * G + c; if (L >= nwg) return false;
        int wgid = (int)L; { const int q = nwg / NXCD, r = nwg % NXCD, xcd = wgid % NXCD, off = wgid / NXCD; wgid = (xcd < r ? xcd * (q + 1) : r * (q + 1) + (xcd - r) * q) + off; }
        const int nig = WGM * nN, gid = wgid / nig, fm = gid * WGM, gsz = (nM - fm) < WGM ? (nM - fm) : WGM;
        u.pm = fm + ((wgid % nig) % gsz); u.pn = (wgid % nig) / gsz; return true;
    }
};

template <class Epi>
__device__ __forceinline__ void gemm_phase(LAS unsigned char* lds, const Gemm g, const StaticOrder& S, const Epi& E, int wid_in) {
    int ln_ = lane_id_v(); int w_ = wid_in; asm volatile("" : "+s"(w_));
    const int wid = w_, lane = ln_, tid = wid * 64 + lane, wr = wid >> 2, wc = wid & 3, fr = lane & 15, fq = lane >> 4;
    const int K = g.K, nt = K / BK;
    unsigned voffA[2], voffB[2];
#pragma unroll
    for (int i = 0; i < 2; ++i) { int R, C; stage_rc(tid * 16 + i * 8192, R, C); const int Rb = Epi::PERM ? ((R & ~31) + perm32(R & 31)) : R;
        voffA[i] = (unsigned)(R * K + C) * 2u; voffB[i] = (unsigned)(Rb * K + C) * 2u; }
    const size_t kstep = (size_t)(BK * 2);
    const size_t hstep = (size_t)HALF * K * 2;
    const size_t tstep = 2 * hstep;
    const unsigned ldsw = (unsigned)wid * 1024u;
    const int aoff = lds_byte(wr * 64 + fr, fq * 8), boff = lds_byte(wc * 32 + fr, fq * 8);
#define PG8_SA(b, h) (((b) * 2 + (h)) * HTB)
#define PG8_SB(b, h) ((4 + (b) * 2 + (h)) * HTB)
#define PG8_STAGE(bufoff, gbase, voff) do { _Pragma("unroll") for (int _i = 0; _i < 2; ++_i) \
        __builtin_amdgcn_global_load_lds((const unsigned*)((const char*)(gbase) + (voff)[_i]), (LAS unsigned*)(lds + (bufoff) + ldsw + _i * 8192), 16, 0, 0); } while (0)
#define PG8_LDA(dst, b, h) do { _Pragma("unroll") for (int m = 0; m < 4; ++m) _Pragma("unroll") for (int k = 0; k < 2; ++k) dst[m][k] = *(const LAS bf16x8*)(lds + PG8_SA(b, h) + aoff + m * 2048 + k * 1024); } while (0)
#define PG8_LDB(dst, b, h) do { _Pragma("unroll") for (int n = 0; n < 2; ++n) _Pragma("unroll") for (int k = 0; k < 2; ++k) dst[n][k] = *(const LAS bf16x8*)(lds + PG8_SB(b, h) + boff + n * 2048 + k * 1024); } while (0)
#define PG8_MMA(ai, bj, At, Bt) do { __builtin_amdgcn_s_setprio(1); _Pragma("unroll") for (int m = 0; m < 4; ++m) _Pragma("unroll") for (int n = 0; n < 2; ++n) _Pragma("unroll") for (int k = 0; k < 2; ++k) \
        acc[ai][bj][m][n] = __builtin_amdgcn_mfma_f32_16x16x32_bf16(Bt[n][k], At[m][k], acc[ai][bj][m][n], 0, 0, 0); __builtin_amdgcn_s_setprio(0); } while (0)
#define PG8_WAIT_V(n) asm volatile("s_waitcnt vmcnt(" #n ")" ::: "memory")
#define PG8_WAIT_L(n) asm volatile("s_waitcnt lgkmcnt(" #n ")" ::: "memory")
#define PG8_BAR __builtin_amdgcn_s_barrier()
#define PG8_SCHED __builtin_amdgcn_sched_barrier(0)
    Unit cur, nxt; int ui = 0;
    if (!S.next(0, cur)) return;
    f32x4 acc[2][2][4][2];
#pragma unroll
    for (int a = 0; a < 2; ++a)
#pragma unroll
        for (int b = 0; b < 2; ++b)
#pragma unroll
            for (int m = 0; m < 4; ++m)
#pragma unroll
                for (int n = 0; n < 2; ++n) acc[a][b][m][n] = (f32x4){0.f, 0.f, 0.f, 0.f};
    bf16x8 At[4][2], B0[2][2], B1[2][2];
    const char* cA = (const char*)g.A + (size_t)cur.pm * tstep; const char* cB = (const char*)g.Bt + (size_t)cur.pn * tstep;
    PG8_STAGE(PG8_SB(0, 0), cB, voffB); PG8_STAGE(PG8_SA(0, 0), cA, voffA); PG8_STAGE(PG8_SB(0, 1), cB + hstep, voffB); PG8_STAGE(PG8_SA(0, 1), cA + hstep, voffA);
    if (wr == 1) PG8_BAR;
    PG8_WAIT_V(4); PG8_BAR;
    PG8_STAGE(PG8_SB(1, 0), cB + kstep, voffB); PG8_STAGE(PG8_SA(1, 0), cA + kstep, voffA); PG8_STAGE(PG8_SB(1, 1), cB + hstep + kstep, voffB);
    PG8_WAIT_V(6); PG8_BAR;
    for (;;) {
        const bool has_next = S.next(ui + 1, nxt);
        const char* nA = has_next ? (const char*)g.A + (size_t)nxt.pm * tstep : cA; const char* nB = has_next ? (const char*)g.Bt + (size_t)nxt.pn * tstep : cB;
        for (int t = 0; t < nt; t += 2) {
            const bool last = (t == nt - 2);
            const char* a1 = cA + (size_t)(t + 1) * kstep;
            const char* a2 = last ? nA : cA + (size_t)(t + 2) * kstep; const char* b2 = last ? nB : cB + (size_t)(t + 2) * kstep;
            const char* a3 = a2 + kstep; const char* b3 = b2 + kstep;
            PG8_LDB(B0, 0, 0); PG8_SCHED; PG8_LDA(At, 0, 0); PG8_STAGE(PG8_SA(1, 1), a1 + hstep, voffA);
            PG8_WAIT_L(8); PG8_BAR; PG8_WAIT_L(0); PG8_MMA(0, 0, At, B0); PG8_BAR; PG8_SCHED;
            PG8_LDB(B1, 0, 1); PG8_STAGE(PG8_SB(0, 0), b2, voffB);
            PG8_BAR; PG8_WAIT_L(0); PG8_MMA(0, 1, At, B1); PG8_BAR;
            PG8_LDA(At, 0, 1); PG8_STAGE(PG8_SA(0, 0), a2, voffA);
            PG8_BAR; PG8_WAIT_L(0); PG8_MMA(1, 0, At, B0); PG8_BAR; PG8_SCHED;
            PG8_STAGE(PG8_SB(0, 1), b2 + hstep, voffB);
            PG8_WAIT_V(6); PG8_BAR; PG8_MMA(1, 1, At, B1); PG8_BAR;
            PG8_LDB(B0, 1, 0); PG8_SCHED; PG8_LDA(At, 1, 0); PG8_STAGE(PG8_SA(0, 1), a2 + hstep, voffA);
            PG8_WAIT_L(8); PG8_BAR; PG8_WAIT_L(0); PG8_MMA(0, 0, At, B0); PG8_BAR; PG8_SCHED;
            PG8_LDB(B1, 1, 1); PG8_STAGE(PG8_SB(1, 0), b3, voffB);
            PG8_BAR; PG8_WAIT_L(0); PG8_MMA(0, 1, At, B1); PG8_BAR;
            PG8_LDA(At, 1, 1); PG8_STAGE(PG8_SA(1, 0), a3, voffA);
            PG8_BAR; PG8_WAIT_L(0); PG8_MMA(1, 0, At, B0); PG8_BAR; PG8_SCHED;
            PG8_STAGE(PG8_SB(1, 1), b3 + hstep, voffB);
            PG8_WAIT_V(6); PG8_BAR; PG8_MMA(1, 1, At, B1); PG8_BAR;
        }
        { const int ln2 = lane_id_v(); E(acc, cur, wr, wc, ln2 & 15, ln2 >> 4); }
        if (!has_next) break;
#pragma unroll
        for (int a = 0; a < 2; ++a)
#pragma unroll
            for (int b = 0; b < 2; ++b)
#pragma unroll
                for (int m = 0; m < 4; ++m)
#pragma unroll
                    for (int n = 0; n < 2; ++n) acc[a][b][m][n] = (f32x4){0.f, 0.f, 0.f, 0.f};
        cur = nxt; cA = nA; cB = nB; ++ui;
    }
    PG8_WAIT_V(0);
    if (wr == 0) PG8_BAR;
    PG8_BAR;
#undef PG8_SA
#undef PG8_SB
#undef PG8_STAGE
#undef PG8_LDA
#undef PG8_LDB
#undef PG8_MMA
#undef PG8_WAIT_V
#undef PG8_WAIT_L
#undef PG8_BAR
#undef PG8_SCHED
}

typedef f32x4 Acc[2][2][4][2];

struct EpiProj {
    static constexpr bool PERM = true;
    bf16_t *uhy, *umla, *uret, *uconf;
    __device__ __forceinline__ void operator()(const Acc& acc, const Unit& u, int wr, int wc, int fr, int fq) const {
        const int row0 = u.pm * BM + wr * 64 + fr;
#pragma unroll
        for (int bj = 0; bj < 2; ++bj) {
            const int c0 = u.pn * BM + bj * HALF + wc * 32 + 8 * fq;
            bf16_t* p; int pitch;
            if (c0 < 768) { p = uhy + c0; pitch = 768; }
            else if (c0 < 1184) { p = umla + (c0 - 768); pitch = 416; }
            else if (c0 < 2208) { p = uret + (c0 - 1184); pitch = 1024; }
            else if (c0 < 2720) { p = uconf + (c0 - 2208); pitch = 512; }
            else continue;
#pragma unroll
            for (int ai = 0; ai < 2; ++ai)
#pragma unroll
                for (int m = 0; m < 4; ++m) {
                    const f32x4 v0 = acc[ai][bj][m][0], v1 = acc[ai][bj][m][1];
                    u32x4 w; w.x = cvt_pk_bf16(v0[0], v0[1]); w.y = cvt_pk_bf16(v0[2], v0[3]); w.z = cvt_pk_bf16(v1[0], v1[1]); w.w = cvt_pk_bf16(v1[2], v1[3]);
                    *(u32x4*)(p + (size_t)(row0 + ai * HALF + m * 16) * pitch) = w;
                }
        }
    }
};
struct EpiGate {
    static constexpr bool PERM = true;
    unsigned char* O; int ldc;
    __device__ __forceinline__ void operator()(const Acc& acc, const Unit& u, int wr, int wc, int fr, int fq) const {
        const int row0 = u.pm * BM + wr * 64 + fr;
#pragma unroll
        for (int bj = 0; bj < 2; ++bj) {
            const int c0 = u.pn * BM + bj * HALF + wc * 32 + 8 * fq;
#pragma unroll
            for (int ai = 0; ai < 2; ++ai)
#pragma unroll
                for (int m = 0; m < 4; ++m) {
                    f32x4 v0 = acc[ai][bj][m][0], v1 = acc[ai][bj][m][1];
#pragma unroll
                    for (int j = 0; j < 4; ++j) { v0[j] = fminf(fmaxf(v0[j], -240.f), 240.f); v1[j] = fminf(fmaxf(v1[j], -240.f), 240.f); }
                    int w0 = 0, w1 = 0;
                    w0 = __builtin_amdgcn_cvt_pk_fp8_f32(v0[0], v0[1], w0, false); w0 = __builtin_amdgcn_cvt_pk_fp8_f32(v0[2], v0[3], w0, true);
                    w1 = __builtin_amdgcn_cvt_pk_fp8_f32(v1[0], v1[1], w1, false); w1 = __builtin_amdgcn_cvt_pk_fp8_f32(v1[2], v1[3], w1, true);
                    *(u32x2*)(O + (size_t)(row0 + ai * HALF + m * 16) * ldc + c0) = (u32x2){(unsigned)w0, (unsigned)w1};
                }
        }
    }
};
struct EpiPlain {
    static constexpr bool PERM = false;
    bf16_t* O; int ldc; int ncols;
    __device__ __forceinline__ void operator()(const Acc& acc, const Unit& u, int wr, int wc, int fr, int fq) const {
        const int row0 = u.pm * BM + wr * 64 + fr;
#pragma unroll
        for (int bj = 0; bj < 2; ++bj) {
            const int c0 = u.pn * BM + bj * HALF + wc * 32 + 4 * fq;
            if (c0 >= ncols) continue;
#pragma unroll
            for (int ai = 0; ai < 2; ++ai)
#pragma unroll
                for (int m = 0; m < 4; ++m) {
                    bf16_t* p = O + (size_t)(row0 + ai * HALF + m * 16) * ldc + c0;
#pragma unroll
                    for (int n = 0; n < 2; ++n) { const f32x4 v = acc[ai][bj][m][n]; u32x2 w; w.x = cvt_pk_bf16(v[0], v[1]); w.y = cvt_pk_bf16(v[2], v[3]); *(u32x2*)(p + 16 * n) = w; }
                }
        }
    }
};
struct EpiFfn1 {
    static constexpr bool PERM = true;
    bf16_t* O;
    __device__ __forceinline__ void operator()(const Acc& acc, const Unit& u, int wr, int wc, int fr, int fq) const {
        const int row0 = u.pm * BM + wr * 64 + fr;
#pragma unroll
        for (int bj = 0; bj < 2; ++bj) {
            const int c0 = (u.pn * BM + bj * HALF + wc * 32 + 8 * fq) >> 1;
#pragma unroll
            for (int ai = 0; ai < 2; ++ai)
#pragma unroll
                for (int m = 0; m < 4; ++m) {
                    const f32x4 a = acc[ai][bj][m][0], b = acc[ai][bj][m][1];
                    float o[4];
#pragma unroll
                    for (int j = 0; j < 4; ++j) o[j] = a[j] * sigmoidf_(a[j]) * b[j];
                    u32x2 w; w.x = cvt_pk_bf16(o[0], o[1]); w.y = cvt_pk_bf16(o[2], o[3]);
                    *(u32x2*)(O + (size_t)(row0 + ai * HALF + m * 16) * DFF + c0) = w;
                }
        }
    }
};
struct EpiResid {
    static constexpr bool PERM = false;
    bf16_t* X; const float* gmod;
    __device__ __forceinline__ void operator()(const Acc& acc, const Unit& u, int wr, int wc, int fr, int fq) const {
        const int row0 = u.pm * BM + wr * 64 + fr, col0 = u.pn * BM + wc * 32 + 4 * fq;
        const float* gp = gmod + (size_t)midx_of_row(u.pm * BM) * 6144;
        f32x4 gv[2][2];
#pragma unroll
        for (int bj = 0; bj < 2; ++bj)
#pragma unroll
            for (int n = 0; n < 2; ++n) gv[bj][n] = *(const f32x4*)(gp + col0 + bj * HALF + n * 16);
#pragma unroll
        for (int ai = 0; ai < 2; ++ai) {
            u32x2 xw[4][2][2];
#pragma unroll
            for (int m = 0; m < 4; ++m)
#pragma unroll
                for (int bj = 0; bj < 2; ++bj)
#pragma unroll
                    for (int n = 0; n < 2; ++n) xw[m][bj][n] = *(const u32x2*)(X + (size_t)(row0 + ai * HALF + m * 16) * D + col0 + bj * HALF + n * 16);
#pragma unroll
            for (int m = 0; m < 4; ++m)
#pragma unroll
                for (int bj = 0; bj < 2; ++bj)
#pragma unroll
                    for (int n = 0; n < 2; ++n) { const u32x2 w = xw[m][bj][n];
                        const f32x4 xv = (f32x4){bflo(w.x), bfhi(w.x), bflo(w.y), bfhi(w.y)} + gv[bj][n] * acc[ai][bj][m][n];
                        u32x2 o; o.x = cvt_pk_bf16(xv[0], xv[1]); o.y = cvt_pk_bf16(xv[2], xv[3]);
                        *(u32x2*)(X + (size_t)(row0 + ai * HALF + m * 16) * D + col0 + bj * HALF + n * 16) = o; }
        }
    }
};
}

struct Ctx {
    const LAS unsigned* tab; float* out; unsigned char* ws; LAS unsigned char* ldsL; unsigned char* lds; int tid, lane, wid, bid, G;
};
__device__ __forceinline__ const float* tab_ptr(const LAS unsigned* tab, int i) { unsigned lo = tab[2 * i], hi = tab[2 * i + 1]; lo = __builtin_amdgcn_readfirstlane(lo); hi = __builtin_amdgcn_readfirstlane(hi); return (const float*)(((unsigned long long)hi << 32) | lo); }
#define INF(i) tab_ptr(C.tab, (i))
__device__ __forceinline__ int launder_s(int v0) { int v = __builtin_amdgcn_readfirstlane(v0); asm volatile("" : "+s"(v)); return v; }
__device__ __forceinline__ int uni(int v) { return __builtin_amdgcn_readfirstlane(v); }
__device__ __forceinline__ Ctx launder(const Ctx& C0) { Ctx C = C0; int ln = lane_id_v(); int w = uni(C0.wid); asm volatile("" : "+s"(w)); C.lane = ln; C.wid = w; C.tid = w * 64 + ln;
    unsigned long long pw = (unsigned long long)C0.ws; unsigned plo = (unsigned)uni((int)(unsigned)pw), phi = (unsigned)uni((int)(unsigned)(pw >> 32)); asm volatile("" : "+s"(plo), "+s"(phi)); C.ws = (unsigned char*)(((unsigned long long)phi << 32) | plo);
    int b = uni(C0.bid), g = uni(C0.G); asm volatile("" : "+s"(b), "+s"(g)); C.bid = b; C.G = g;
    unsigned tb = (unsigned)uni((int)(unsigned)(unsigned long long)C0.tab); asm volatile("" : "+s"(tb)); C.tab = (const LAS unsigned*)(unsigned long long)tb; return C; }

__device__ __forceinline__ void p0_mod(const Ctx& C0) { const Ctx C = launder(C0); const float* in5 = INF(5); const float* in6 = INF(6); const float* in7 = INF(7); const float* in8 = INF(8);
    float* scond = (float*)C.lds;
    float* part = scond + 5 * 1024;
    float* MOD = (float*)(C.ws + WS_MOD);
    bool have = false;
    for (int task = C.bid; task < 192; task += C.G) {
        if (!have) {
            for (int i = C.tid; i < 5 * 1024; i += NT) { const int m = i >> 10, k = i & 1023; const float x = (m == 0) ? in6[k] : in5[(m - 1) * 1024 + k]; scond[i] = x * sigmoidf_(x); }
            have = true; __syncthreads();
        }
        const int l = task / 96, j0 = (task % 96) * 64;
        const float* aw = in7 + (size_t)l * 1024 * 6144 + j0 + C.lane;
        float a[5] = {0.f, 0.f, 0.f, 0.f, 0.f};
        const int k0 = C.wid * 128;
#pragma unroll 8
        for (int k = 0; k < 128; ++k) { const float w = aw[(size_t)(k0 + k) * 6144];
#pragma unroll
            for (int m = 0; m < 5; ++m) a[m] += scond[m * 1024 + k0 + k] * w; }
#pragma unroll
        for (int m = 0; m < 5; ++m) part[(C.wid * 5 + m) * 64 + C.lane] = a[m];
        __syncthreads();
        if (C.tid < 320) { const int m = C.tid >> 6, j = C.tid & 63; float s = in8[l * 6144 + j0 + j];
#pragma unroll
            for (int w = 0; w < 8; ++w) s += part[(w * 5 + m) * 64 + j];
            MOD[((size_t)l * 5 + m) * 6144 + j0 + j] = s; }
        __syncthreads();
    }
    __syncthreads();
}

__device__ __forceinline__ void p0_filters(const Ctx& C0) { const Ctx C = launder(C0); const float* in13 = INF(13); const float* in14 = INF(14); const float* in15 = INF(15); const float* in16 = INF(16); const float* in17 = INF(17);
    float* zs = (float*)C.lds;
    float* h1s = zs + 8 * 4 * 64;
    float* h2s = h1s + 8 * 4 * 64;
    float* red = h2s + 8 * 4 * 64;
    float* HR = (float*)(C.ws + WS_AR + A_HRAW);
    float* HP = (float*)(C.ws + WS_HP);
    for (int task = (C.bid + 64) % C.G; task < 144; task += C.G) {
        const int l = task / 72, ch = task % 72, Lsel = ch < 8 ? 0 : 1, chunk = Lsel ? ch - 8 : ch, L = Lsel ? 2048 : 256;
        const int tb = chunk * 32 + C.wid * 4;
        float* zw = zs + C.wid * 256; float* h1w = h1s + C.wid * 256; float* h2w = h2s + C.wid * 256;
        if (C.lane < 33) {
#pragma unroll
            for (int tt = 0; tt < 4; ++tt) {
                const int t = tb + tt; const float w = (6.2831855f * (float)t) / (float)L;
                float z;
                if (C.lane == 0) z = (float)t / (float)(L - 1);
                else { const int bi = (C.lane - 1) & 15; const float f = 1e-4f + (float)bi * ((15.0f - 1e-4f) / 15.0f); const float a = f * w; z = (C.lane <= 16) ? cosf(a) : -sinf(a); }
                zw[tt * 64 + C.lane] = z;
            }
        }
        __builtin_amdgcn_wave_barrier();
        { float a[4]; const float b = in14[l * 64 + C.lane];
#pragma unroll
          for (int tt = 0; tt < 4; ++tt) a[tt] = b;
#pragma unroll 3
          for (int k = 0; k < 33; ++k) { const float w = in13[(l * 33 + k) * 64 + C.lane];
#pragma unroll
              for (int tt = 0; tt < 4; ++tt) a[tt] += zw[tt * 64 + k] * w; }
#pragma unroll
          for (int tt = 0; tt < 4; ++tt) h1w[tt * 64 + C.lane] = sinf(a[tt]); }
        __builtin_amdgcn_wave_barrier();
        { float a[4]; const float b = in16[l * 64 + C.lane];
#pragma unroll
          for (int tt = 0; tt < 4; ++tt) a[tt] = b;
#pragma unroll 4
          for (int k = 0; k < 64; ++k) { const float w = in15[(l * 64 + k) * 64 + C.lane];
#pragma unroll
              for (int tt = 0; tt < 4; ++tt) a[tt] += h1w[tt * 64 + k] * w; }
#pragma unroll
          for (int tt = 0; tt < 4; ++tt) h2w[tt * 64 + C.lane] = sinf(a[tt]); }
        __builtin_amdgcn_wave_barrier();
        const float* w3 = in17 + (size_t)l * 64 * 1024;
        float* hr = HR + ((size_t)l * 2304 + (Lsel ? 256 : 0)) * 1024;
#pragma unroll 1
        for (int q = 0; q < 8; ++q) {
            float psum = 0.f;
#pragma unroll 1
            for (int dir = 0; dir < 2; ++dir) {
                float a[4] = {0.f, 0.f, 0.f, 0.f};
                const int col = C.lane + 64 * ((q >> 2) * 8 + dir * 4 + (q & 3));
#pragma unroll 8
                for (int k = 0; k < 64; ++k) { const float w = w3[k * 1024 + col];
#pragma unroll
                    for (int tt = 0; tt < 4; ++tt) a[tt] += h2w[tt * 64 + k] * w; }
                const int c = col & 255;
                const float delta = fabsf(-3.0701134573f + (float)c * ((-15.3505672866f + 3.0701134573f) / 255.0f));
#pragma unroll
                for (int tt = 0; tt < 4; ++tt) {
                    const int t = tb + tt; const float tl = (float)t / (float)(L - 1);
                    const float v = a[tt] * __expf(-tl * delta);
                    hr[(size_t)t * 1024 + col] = v;
                    psum += fabsf(v);
                }
            }
            red[(C.wid * 8 + q) * 64 + C.lane] = psum;
        }
        __syncthreads();
        { const int o = C.tid >> 8, c = C.tid & 255, r4 = c >> 6, ln = c & 63; float s = 0.f;
#pragma unroll
          for (int w = 0; w < 8; ++w) s += red[(w * 8 + o * 4 + r4) * 64 + ln];
          HP[((size_t)l * 72 + ch) * 512 + C.tid] = s; }
        __syncthreads();
    }
    __syncthreads();
}

__device__ __forceinline__ void p0_misc(const Ctx& C0) { const Ctx C = launder(C0); const float* in4 = INF(4);
    float* rope = (float*)(C.ws + WS_ROPE);
    const int gt = C.bid * NT + C.tid, gs = C.G * NT;
    for (int i = gt; i < 32768; i += gs) {
        const int t = i >> 4, k = i & 15; const int pos = (k < 8) ? (t >> 6) : (t & 63);
        const float inv = powf(10000.0f, -(float)(k & 7) / 8.0f);
        const float a = (float)pos * inv;
        rope[i] = cosf(a); rope[32768 + i] = sinf(a);
    }
    bf16_t* s0t = (bf16_t*)(C.ws + WS_S0T);
    for (int i = gt; i < 64 * 4096; i += gs) { const int mat = i >> 12, dv = (i >> 6) & 63, dk = i & 63; s0t[i] = f2bf(in4[mat * 4096 + dk * 64 + dv]); }
}

__device__ __forceinline__ void conv_tile(const float* src, int ld, int kvalid, int k0, int colsrc  , bf16_t* dstrow  , float scale) {
    float vv[64];
    const int cs = colsrc < 0 ? 0 : colsrc;
#pragma unroll
    for (int j = 0; j < 64; ++j) { const int k = k0 + j, kc = k < kvalid ? k : kvalid - 1; vv[j] = src[(size_t)kc * ld + cs]; }
    unsigned w[32];
#pragma unroll
    for (int j = 0; j < 32; ++j) {
        const float a = (colsrc >= 0 && k0 + 2 * j < kvalid) ? vv[2 * j] : 0.f, b = (colsrc >= 0 && k0 + 2 * j + 1 < kvalid) ? vv[2 * j + 1] : 0.f;
        w[j] = cvt_pk_bf16(a * scale, b * scale);
    }
#pragma unroll
    for (int j = 0; j < 8; ++j) { u32x4 v; v.x = w[4 * j]; v.y = w[4 * j + 1]; v.z = w[4 * j + 2]; v.w = w[4 * j + 3]; *(u32x4*)(dstrow + 8 * j) = v; }
}
__device__ __forceinline__ void convert_weights(const Ctx& C0, int l0) { const int l = launder_s(l0); const Ctx C = launder(C0);
    unsigned char* W = C.ws + WS_W;
    constexpr int T0 = 704, T1 = T0 + 1024, T2 = T1 + 256, T3 = T2 + 1408, T4 = T3 + 704, T5 = T4 + 256, T6 = T5 + 32, T7 = T6 + 16, T8 = T7 + 16;
    for (int t = C.bid * 8 + C.wid; t < T8; t += C.G * 8) {
        const float* src; int ld, kvalid, k0, col; bf16_t* dst; float scale = 1.0f;
        if (t < T0) { const int nt = t % 44, kt = t / 44, n = nt * 64 + C.lane; src = INF(10) + (size_t)l * 1024 * 2720; ld = 2720; kvalid = 1024; k0 = kt * 64; col = n < 2720 ? n : -1; dst = (bf16_t*)(W + W_PROJ) + (size_t)n * 1024 + k0; }
        else if (t < T1) { const int u = t - T0, nt = u % 64, kt = u / 64, n = nt * 64 + C.lane; src = INF(32) + (size_t)l * 1024 * 4096; ld = 4096; kvalid = 1024; k0 = kt * 64; col = n; dst = (bf16_t*)(W + W_GATE) + (size_t)n * 1024 + k0; }
        else if (t < T2) { const int u = t - T1, nt = u % 16, kt = u / 16, n = nt * 64 + C.lane; src = INF(34) + (size_t)l * 1024 * 1024; ld = 1024; kvalid = 1024; k0 = kt * 64; col = n; dst = (bf16_t*)(W + W_O) + (size_t)n * 1024 + k0; }
        else if (t < T3) { const int u = t - T2, nt = u % 88, kt = u / 88, n = nt * 64 + C.lane; src = INF(36) + (size_t)l * 1024 * 5632; ld = 5632; kvalid = 1024; k0 = kt * 64;
            const int g = n >> 3, e = n & 7; col = (e < 4) ? 4 * g + e : 2816 + 4 * g + (e - 4); dst = (bf16_t*)(W + W_1) + (size_t)n * 1024 + k0; }
        else if (t < T4) { const int u = t - T3, nt = u % 16, kt = u / 16, n = nt * 64 + C.lane; src = INF(37) + (size_t)l * 2816 * 1024; ld = 1024; kvalid = 2816; k0 = kt * 64; col = n; dst = (bf16_t*)(W + W_2) + (size_t)n * 2816 + k0; }
        else if (t < T5) { const int u = t - T4, br = u / 64, v = u % 64, nt = v / 4, kt = v % 4, n = nt * 64 + C.lane; const int ii = (br == 0) ? 19 : (br == 1) ? 24 : (br == 2) ? 26 : 31;
            src = INF(ii) + (size_t)l * 256 * 1024; ld = 1024; kvalid = 256; k0 = kt * 64; col = n; dst = (bf16_t*)(W + W_BOUT) + ((size_t)br * 1024 + n) * 256 + k0; }
        else if (t < T6) { const int u = t - T5, nt = u / 4, kt = u % 4, n = nt * 64 + C.lane; src = INF(21) + (size_t)l * 256 * 384; ld = 384; kvalid = 256; k0 = kt * 64; col = n < 384 ? n : -1; dst = (bf16_t*)(W + W_UQ) + (size_t)n * 256 + k0; scale = 0.10206207261596577f * 1.4426950408889634f; }
        else if (t < T7) { const int u = t - T6, nt = u / 4, kt = u % 4, n = nt * 64 + C.lane; src = INF(23) + (size_t)l * 128 * 512; ld = 512; kvalid = 128; k0 = kt * 64; col = (n >> 6) * 128 + (n & 63); dst = (bf16_t*)(W + W_UK) + (size_t)n * 256 + k0; }
        else { const int u = t - T7, nt = u / 4, kt = u % 4, n = nt * 64 + C.lane; src = INF(23) + (size_t)l * 128 * 512; ld = 512; kvalid = 128; k0 = kt * 64; col = (n >> 6) * 128 + 64 + (n & 63); dst = (bf16_t*)(W + W_UV) + (size_t)n * 256 + k0; }
        conv_tile(src, ld, kvalid, k0, col, dst, scale);
    }
}

__device__ __forceinline__ bf16_t* rg_ptr(unsigned char* ws, int l, int p, int o, int c) {
    return (bf16_t*)(ws + WS_RG + (size_t)l * RG_LAYER) + (p ? (size_t)2 * 256 * 512 : 0) + (size_t)(o * 256 + c) * (p ? 4096 : 512);
}
__device__ __forceinline__ void build_rg(const Ctx& C0) { const Ctx C = launder(C0);
    LAS float* tile = (LAS float*)C.ldsL;
    LAS float* invn = tile + 64 * 65;
    const float* HR = (const float*)(C.ws + WS_AR + A_HRAW);
    const float* HP = (const float*)(C.ws + WS_HP);
    for (int task = C.bid; task < 1152; task += C.G) {
        const int l = task / 576, u = task % 576;
        int p, o, cg, mc;
        if (u < 64) { p = 0; o = u / 32; cg = (u / 8) % 4; mc = u % 8; } else { const int v = u - 64; p = 1; o = v / 256; cg = (v / 64) % 4; mc = v % 64; }
        const int L = p ? 2048 : 256, nch = p ? 64 : 8, chb = p ? 8 : 0, c0 = cg * 64, m0 = mc * 64;
        {
          const int cch_ = C.tid & 63, part = C.tid >> 6; float hv[8];
#pragma unroll
          for (int q = 0; q < 8; ++q) { const int k = part + 8 * q; hv[q] = (k < nch) ? HP[((size_t)l * 72 + chb + k) * 512 + o * 256 + c0 + cch_] : 0.f; }
          invn[part * 64 + cch_] = ((hv[0] + hv[1]) + (hv[2] + hv[3])) + ((hv[4] + hv[5]) + (hv[6] + hv[7])); }
        const float* hr = HR + ((size_t)l * 2304 + (p ? 256 : 0)) * 1024;
#pragma unroll
        for (int jj = 0; jj < 8; ++jj) {
            const int j = C.wid * 8 + jj, m = m0 + j, n = L - m;
            float v = 0.f;
            if (m != 0) { const int t = n >= 0 ? n : -n, dir = n >= 0 ? 0 : 1; v = hr[(size_t)t * 1024 + o * 512 + dir * 256 + c0 + C.lane]; }
            tile[j * 65 + C.lane] = v;
        }
        __syncthreads();
        { const int cc = C.tid >> 3, jg = C.tid & 7;
          float sn = 0.f;
#pragma unroll
          for (int q = 0; q < 8; ++q) sn += invn[q * 64 + cc];
          const float s = 1.0f / sn;
          u32x4 w; float f[8];
#pragma unroll
          for (int e = 0; e < 8; ++e) f[e] = tile[(jg * 8 + e) * 65 + cc] * s;
          w.x = cvt_pk_bf16(f[0], f[1]); w.y = cvt_pk_bf16(f[2], f[3]); w.z = cvt_pk_bf16(f[4], f[5]); w.w = cvt_pk_bf16(f[6], f[7]);
          *(u32x4*)(rg_ptr(C.ws, l, p, o, c0 + cc) + m0 + jg * 8) = w; }
        __syncthreads();
    }
}

__device__ __forceinline__ void norm_phase(const Ctx& C0, int l0, int which) { const int l = launder_s(l0); const Ctx C = launder(C0); const float* in0 = INF(0); const float* in1 = INF(1); const float* in9 = INF(9); const float* in35 = INF(35);
    bf16_t* X = (bf16_t*)(C.ws + WS_HB);
    bf16_t* Hb = (bf16_t*)C.out;
    const float* MOD = (const float*)(C.ws + WS_MOD) + (size_t)l * 5 * 6144;
    const float* g = (which == 0 ? in9 : in35) + l * 1024;
    const int shoff = which == 0 ? 0 : 3072, scoff = shoff + 1024;
    const bool first = (which == 0 && l == 0);
    f32x4 gg[4];
#pragma unroll
    for (int i = 0; i < 4; ++i) gg[i] = *(const f32x4*)(g + i * 256 + C.lane * 4);
    for (int rp = C.bid * 8 + C.wid; rp < M / 2; rp += C.G * 8) {
        f32x4 v[2][4]; float ss[2] = {0.f, 0.f};
#pragma unroll
        for (int q = 0; q < 2; ++q) { const int row = rp + q * (M / 2);
            if (first) { const float* src = row < MC ? in0 + (size_t)row * D : in1 + (size_t)(row - MC) * D;
#pragma unroll
                for (int i = 0; i < 4; ++i) v[q][i] = *(const f32x4*)(src + i * 256 + C.lane * 4);
            } else { const bf16_t* src = X + (size_t)row * D;
#pragma unroll
                for (int i = 0; i < 4; ++i) { const u32x2 w = *(const u32x2*)(src + i * 256 + C.lane * 4); v[q][i] = (f32x4){bflo(w.x), bfhi(w.x), bflo(w.y), bfhi(w.y)}; } } }
#pragma unroll
        for (int q = 0; q < 2; ++q)
#pragma unroll
            for (int i = 0; i < 4; ++i) ss[q] += v[q][i][0] * v[q][i][0] + v[q][i][1] * v[q][i][1] + v[q][i][2] * v[q][i][2] + v[q][i][3] * v[q][i][3];
#pragma unroll
        for (int o = 32; o >= 1; o >>= 1) { const float t0 = shx(ss[0], o, C.lane), t1 = shx(ss[1], o, C.lane); ss[0] += t0; ss[1] += t1; }
#pragma unroll
        for (int q = 0; q < 2; ++q) { const int row = rp + q * (M / 2);
            const float rstd = rsqrtf(ss[q] * (1.0f / 1024.0f) + 1e-6f);
            const float* mp = MOD + (size_t)midx_of_row(row) * 6144;
#pragma unroll
            for (int i = 0; i < 4; ++i) {
                const int c = i * 256 + C.lane * 4;
                if (first) { u32x2 xw; xw.x = cvt_pk_bf16(v[q][i][0], v[q][i][1]); xw.y = cvt_pk_bf16(v[q][i][2], v[q][i][3]); *(u32x2*)(X + (size_t)row * D + c) = xw; }
                const f32x4 sh = *(const f32x4*)(mp + shoff + c), sc = *(const f32x4*)(mp + scoff + c);
                const f32x4 y = (v[q][i] * rstd * gg[i]) * (sc + 1.0f) + sh;
                u32x2 w; w.x = cvt_pk_bf16(y[0], y[1]); w.y = cvt_pk_bf16(y[2], y[3]);
                *(u32x2*)(Hb + (size_t)row * D + c) = w;
            } }
    }
}
__device__ __forceinline__ void final_norm(const Ctx& C0) { const Ctx C = launder(C0); const float* in38 = INF(38);
    const bf16_t* X = (const bf16_t*)(C.ws + WS_HB); float* Y = C.out; const float* g = in38;
    for (int row = C.bid * 8 + C.wid; row < M; row += C.G * 8) {
        const bf16_t* src = X + (size_t)row * D;
        f32x4 v[4]; float ss = 0.f;
#pragma unroll
        for (int i = 0; i < 4; ++i) { const u32x2 w = *(const u32x2*)(src + i * 256 + C.lane * 4); v[i] = (f32x4){bflo(w.x), bfhi(w.x), bflo(w.y), bfhi(w.y)}; ss += v[i][0] * v[i][0] + v[i][1] * v[i][1] + v[i][2] * v[i][2] + v[i][3] * v[i][3]; }
        ss = wave_sum_l(ss, C.lane);
        const float rstd = rsqrtf(ss * (1.0f / 1024.0f) + 1e-6f);
#pragma unroll
        for (int i = 0; i < 4; ++i) { const int c = i * 256 + C.lane * 4; *(f32x4*)(Y + (size_t)row * D + c) = v[i] * rstd * *(const f32x4*)(g + c); }
    }
}

__device__ __forceinline__ void prep_phase(const Ctx& C0, int l0) { const int l = launder_s(l0); const Ctx C = launder(C0); const float* in2 = INF(2); const float* in3 = INF(3); const float* in11 = INF(11); const float* in12 = INF(12); const float* in20 = INF(20); const float* in22 = INF(22); const float* in27 = INF(27); const float* in28 = INF(28); const float* in29 = INF(29); const float* in30 = INF(30);
    unsigned char* AR = C.ws + WS_AR;
    const bf16_t* UHY = (const bf16_t*)(AR + A_UHY); const bf16_t* UMLA = (const bf16_t*)(AR + A_UMLA);
    const bf16_t* UCONF = (const bf16_t*)(AR + A_UCONF); const bf16_t* URET = (const bf16_t*)(AR + A_URET);
    bf16_t* ZT = (bf16_t*)(AR + A_ZT); bf16_t* CQN = (bf16_t*)(AR + A_CQN); bf16_t* CKN = (bf16_t*)(AR + A_CKN);
    bf16_t* KR = (bf16_t*)(AR + A_KR); bf16_t* RVT = (bf16_t*)(AR + A_RVT);
    bf16_t* YCONF = (bf16_t*)((unsigned char*)C.out + 33554432) + (size_t)3 * M * 256;
    const float* rope = (const float*)(C.ws + WS_ROPE);
    float* out = C.out;
    for (int ti = C.bid; ti < M / 64; ti += C.G) {
        const int r0 = ti * 64; const bool lat = r0 >= MC;
        const int L = lat ? 2048 : 256, sb = lat ? MC + ((r0 - MC) >> 11) * 2048 : (r0 >> 8) * 256, t0 = r0 - sb, b = lat ? (r0 - MC) >> 11 : r0 >> 8;
        {
            bf16_t* us = (bf16_t*)C.lds;
#pragma unroll 4
            for (int q = C.tid; q < 66 * 96; q += NT) { const int rr = q / 96, cc = q % 96; const int t = t0 + rr - 1;
                u32x4 v = (u32x4){0u, 0u, 0u, 0u}; if (t >= 0 && t < L) v = *(const u32x4*)(UHY + (size_t)(sb + t) * 768 + cc * 8);
                *(u32x4*)(us + rr * 768 + cc * 8) = v; }
            __syncthreads();
            const float* cw = in11 + l * 3 * 768; const float* cb = in12 + l * 768;
            for (int it = C.tid; it < 768 * 8; it += NT) { const int ch = it % 768, tg = it / 768;
                const float w0 = cw[ch], w1 = cw[768 + ch], w2 = cw[1536 + ch], bb = cb[ch];
                float u[10];
#pragma unroll
                for (int e = 0; e < 10; ++e) u[e] = bf2f(us[(tg * 8 + e) * 768 + ch]);
                float z[8];
#pragma unroll
                for (int e = 0; e < 8; ++e) z[e] = w0 * u[e] + w1 * u[e + 1] + w2 * u[e + 2] + bb;
                u32x4 w; w.x = cvt_pk_bf16(z[0], z[1]); w.y = cvt_pk_bf16(z[2], z[3]); w.z = cvt_pk_bf16(z[4], z[5]); w.w = cvt_pk_bf16(z[6], z[7]);
                *(u32x4*)(ZT + ((size_t)(lat ? 768 : 0) + ch) * 8192 + (r0 - (lat ? MC : 0)) + tg * 8) = w; }
            __syncthreads();
        }
        {
            const int rw0 = r0 + C.wid * 8;
            u32x2 cqv[8]; unsigned ckw[8]; float krx[8], rcs[8], rsn[8];
#pragma unroll
            for (int tt = 0; tt < 8; ++tt) { const bf16_t* um = UMLA + (size_t)(rw0 + tt) * 416;
                cqv[tt] = *(const u32x2*)(um + C.lane * 4); ckw[tt] = *(const unsigned*)(um + 256 + C.lane * 2); krx[tt] = bf2f(um[384 + (C.lane & 31)]);
                rcs[tt] = 1.f; rsn[tt] = 0.f;
                if (lat) { const int t = rw0 + tt - sb; rcs[tt] = rope[t * 16 + (C.lane & 15)]; rsn[tt] = rope[32768 + t * 16 + (C.lane & 15)]; } }
            const f32x4 gq = *(const f32x4*)(in20 + l * 256 + C.lane * 4); const f32x2 gk = *(const f32x2*)(in22 + l * 128 + C.lane * 2);
            float s1[8], s2[8], oth[8];
#pragma unroll
            for (int tt = 0; tt < 8; ++tt) { const float x0 = bflo(cqv[tt].x), x1 = bfhi(cqv[tt].x), x2 = bflo(cqv[tt].y), x3 = bfhi(cqv[tt].y), k0 = bflo(ckw[tt]), k1 = bfhi(ckw[tt]);
                s1[tt] = x0 * x0 + x1 * x1 + x2 * x2 + x3 * x3; s2[tt] = k0 * k0 + k1 * k1; oth[tt] = shx(krx[tt], 16, C.lane); }
#pragma unroll
            for (int o = 32; o >= 1; o >>= 1) {
                float t1[8], t2[8];
#pragma unroll
                for (int tt = 0; tt < 8; ++tt) { t1[tt] = shx(s1[tt], o, C.lane); t2[tt] = shx(s2[tt], o, C.lane); }
#pragma unroll
                for (int tt = 0; tt < 8; ++tt) { s1[tt] += t1[tt]; s2[tt] += t2[tt]; }
            }
#pragma unroll
            for (int tt = 0; tt < 8; ++tt) {
                const int row = rw0 + tt, t = row - sb; const size_t keyrow = lat ? (size_t)MC + b * 2304 + t : (size_t)row;
                { const float x0 = bflo(cqv[tt].x), x1 = bfhi(cqv[tt].x), x2 = bflo(cqv[tt].y), x3 = bfhi(cqv[tt].y); const float rs = rsqrtf(s1[tt] * (1.0f / 256.0f) + 1e-6f);
                  u32x2 o; o.x = cvt_pk_bf16(x0 * rs * gq[0], x1 * rs * gq[1]); o.y = cvt_pk_bf16(x2 * rs * gq[2], x3 * rs * gq[3]);
                  *(u32x2*)(CQN + (size_t)row * 256 + C.lane * 4) = o; }
                { const float x0 = bflo(ckw[tt]), x1 = bfhi(ckw[tt]); const float rs = rsqrtf(s2[tt] * (1.0f / 128.0f) + 1e-6f);
                  const float y0 = x0 * rs * gk[0], y1 = x1 * rs * gk[1];
                  *(unsigned*)(CKN + keyrow * 256 + C.lane * 2) = cvt_pk_bf16(y0, y1);
                  *(unsigned*)(CKN + keyrow * 256 + 128 + C.lane * 2) = 0u;
                  if (!lat) *(f32x2*)(out + 16777216 + (((size_t)b * 2 + l) * 256 + t) * 128 + C.lane * 2) = (f32x2){y0, y1}; }
                { const float x = krx[tt]; float y = x;
                  if (lat) y = (C.lane & 16) ? (oth[tt] * rsn[tt] + x * rcs[tt]) : (x * rcs[tt] - oth[tt] * rsn[tt]);
                  if (C.lane < 32) { KR[keyrow * 32 + C.lane] = f2bf(y); if (!lat) out[18874368 + (((size_t)b * 2 + l) * 256 + t) * 32 + C.lane] = x; } }
            }
        }
        {
            bf16_t* vs = (bf16_t*)C.lds;
#pragma unroll 4
            for (int q = C.tid; q < 64 * 32; q += NT) { const int rr = q >> 5, cc = q & 31; *(u32x4*)(vs + rr * 264 + cc * 8) = *(const u32x4*)(URET + (size_t)(r0 + rr) * 1024 + 512 + cc * 8); }
            __syncthreads();
            for (int it = C.tid; it < 256 * 8; it += NT) { const int col = it & 255, tg = it >> 8; unsigned short e[8];
#pragma unroll
                for (int k = 0; k < 8; ++k) e[k] = vs[(tg * 8 + k) * 264 + col];
                u32x4 w; w.x = e[0] | ((unsigned)e[1] << 16); w.y = e[2] | ((unsigned)e[3] << 16); w.z = e[4] | ((unsigned)e[5] << 16); w.w = e[6] | ((unsigned)e[7] << 16);
                *(u32x4*)(RVT + (size_t)col * M + r0 + tg * 8) = w; }
            __syncthreads();
        }
        {
            bf16_t* zb = (bf16_t*)C.lds;
            float* cbuf = (float*)(C.lds + 94 * 256 * 2);
#pragma unroll 4
            for (int q = C.tid; q < 94 * 64; q += NT) { const int rr = q >> 6, cc = q & 63; const int t = t0 + rr - 15;
                u32x2 o = (u32x2){0u, 0u};
                if (t >= 0 && t < L) { const bf16_t* up = UCONF + (size_t)(sb + t) * 512 + cc * 4; const u32x2 a = *(const u32x2*)up, g = *(const u32x2*)(up + 256);
                    o.x = cvt_pk_bf16(bflo(a.x) * sigmoidf_(bflo(g.x)), bfhi(a.x) * sigmoidf_(bfhi(g.x))); o.y = cvt_pk_bf16(bflo(a.y) * sigmoidf_(bflo(g.y)), bfhi(a.y) * sigmoidf_(bfhi(g.y))); }
                *(u32x2*)(zb + rr * 256 + cc * 4) = o; }
            __syncthreads();
            { const int c = C.tid & 255, th = C.tid >> 8; const float* dw = in27 + (size_t)l * 31 * 256 + c; const float bb = in28[l * 256 + c];
              float a[32];
#pragma unroll
              for (int i = 0; i < 32; ++i) a[i] = bb;
              for (int j = 0; j < 31; ++j) { const float w = dw[j * 256];
#pragma unroll
                  for (int i = 0; i < 32; ++i) a[i] += w * bf2f(zb[(th * 32 + i + j) * 256 + c]); }
#pragma unroll
              for (int i = 0; i < 32; ++i) cbuf[(th * 32 + i) * 256 + c] = a[i]; }
            __syncthreads();
            for (int tt = 0; tt < 8; ++tt) { const int tr = C.wid * 8 + tt; const f32x4 v = *(const f32x4*)(cbuf + tr * 256 + C.lane * 4);
                const float mu = wave_sum_l(v[0] + v[1] + v[2] + v[3], C.lane) * (1.0f / 256.0f);
                const f32x4 d = v - mu; const float var = wave_sum_l(d[0] * d[0] + d[1] * d[1] + d[2] * d[2] + d[3] * d[3], C.lane) * (1.0f / 256.0f);
                const float rs = rsqrtf(var + 1e-6f);
                const f32x4 g = *(const f32x4*)(in29 + l * 256 + C.lane * 4), be = *(const f32x4*)(in30 + l * 256 + C.lane * 4);
                f32x4 y = d * rs * g + be;
#pragma unroll
                for (int j = 0; j < 4; ++j) y[j] = y[j] * sigmoidf_(y[j]);
                u32x2 w; w.x = cvt_pk_bf16(y[0], y[1]); w.y = cvt_pk_bf16(y[2], y[3]);
                *(u32x2*)(YCONF + (size_t)(r0 + tr) * 256 + C.lane * 4) = w; }
            __syncthreads();
        }
    }
    for (int r = C.bid * 8 + C.wid; r < 1024; r += C.G * 8) { const int b = r >> 8, j = r & 255; const size_t keyrow = (size_t)MC + b * 2304 + 2048 + j;
        const f32x2 v = *(const f32x2*)(in2 + (((size_t)b * 2 + l) * 256 + j) * 128 + C.lane * 2);
        *(unsigned*)(CKN + keyrow * 256 + C.lane * 2) = cvt_pk_bf16(v[0], v[1]); *(unsigned*)(CKN + keyrow * 256 + 128 + C.lane * 2) = 0u;
        if (C.lane < 32) KR[keyrow * 32 + C.lane] = f2bf(in3[(((size_t)b * 2 + l) * 256 + j) * 32 + C.lane]); }
}

__device__ __forceinline__ void hyena_phase(const Ctx& C0, int l0) { const int l = launder_s(l0); const Ctx C = launder(C0); const float* in18 = INF(18);
    const bf16_t* ZT = (const bf16_t*)(C.ws + WS_AR + A_ZT);
    bf16_t* YHY = (bf16_t*)((unsigned char*)C.out + 33554432);
    LAS unsigned char* vS = C.ldsL;
    LAS unsigned char* R0 = C.ldsL + 20480;
    LAS unsigned char* R1 = R0 + 8256;
    const int n = C.lane & 31, hf = C.lane >> 5;
    const int Bk = 32 * C.wid + n;
    for (int item = C.bid; item < 256; item += C.G) {
      u32x4 pd; unsigned pe;
#define HY_RLOAD(P_, O_) do { const bf16_t* rg_ = rg_ptr(C.ws, l, (P_), (O_), item); const int nch_ = ((P_) ? 4096 : 512) >> 3; pd = (u32x4){0u, 0u, 0u, 0u}; pe = 0u; \
          if (C.tid < nch_) { pd = *(const u32x4*)(rg_ + C.tid * 8); if (C.tid + 1 < nch_) pe = *(const unsigned*)(rg_ + C.tid * 8 + 8); } } while (0)
      HY_RLOAD(1, 0);
      for (int s = 0; s < 4; ++s) {
        const int p = 1 - (s >> 1), o = s & 1, c = item;
        const int L = p ? 2048 : 256, Lb = L >> 5, L2 = 2 * L;
        const bf16_t* zv = ZT + ((size_t)p * 768 + c) * 8192;
        const bf16_t* zx1 = zv + (size_t)256 * 8192; const bf16_t* zx2 = zv + (size_t)512 * 8192;
        if (o == 0) {
            __syncthreads();
            for (int q = C.tid; q < 1024; q += NT) *(LAS u32x4*)(vS + (q >> 2) * 80 + (q & 3) * 16) = *(const u32x4*)(zv + q * 8);
        }
        {
            if (C.tid <= (L2 >> 3)) {
                *(LAS u32x4*)(R0 + C.tid * 16) = pd;
                u32x4 sft; sft.x = (pd.x >> 16) | (pd.y << 16); sft.y = (pd.y >> 16) | (pd.z << 16); sft.z = (pd.z >> 16) | (pd.w << 16); sft.w = (pd.w >> 16) | (pe << 16);
                *(LAS u32x4*)(R1 + C.tid * 16) = sft;
            }
            __syncthreads();
            if (s < 3) HY_RLOAD(1 - ((s + 1) >> 1), (s + 1) & 1);
            f32x16 acc;
#pragma unroll
            for (int r = 0; r < 16; ++r) acc[r] = 0.f;
            const LAS unsigned* Rc = (const LAS unsigned*)((n & 1) ? R1 : R0);
            const int T = Bk & (Lb - 1);
            const int Tlo = (32 * C.wid) & (Lb - 1), Thi = Lb >= 32 ? Tlo + 31 : Lb - 1, Tl0 = Lb >= 32 ? Tlo : 0;
            const int dlo = Tl0 - (Lb - 1), dhi = Thi;
            for (int d = dlo; d <= dhi; ++d) {
                const int s0 = L - 32 * d - n + 8 * hf, dw = s0 >> 1;
                u32x4 a0, a1;
                a0.x = Rc[dw]; a0.y = Rc[dw + 1]; a0.z = Rc[dw + 2]; a0.w = Rc[dw + 3];
                a1.x = Rc[dw + 8]; a1.y = Rc[dw + 9]; a1.z = Rc[dw + 10]; a1.w = Rc[dw + 11];
                const int Ts = T - d;
                const bool valid = (Ts >= 0) && (Ts < Lb);
                const int sblk = valid ? (Bk - d) : 0;
                u32x4 b0 = *(const LAS u32x4*)(vS + sblk * 80 + hf * 16), b1 = *(const LAS u32x4*)(vS + sblk * 80 + 32 + hf * 16);
                if (!valid) { b0 = (u32x4){0u, 0u, 0u, 0u}; b1 = b0; }
                acc = __builtin_amdgcn_mfma_f32_32x32x16_bf16(__builtin_bit_cast(bf16x8, a0), __builtin_bit_cast(bf16x8, b0), acc, 0, 0, 0);
                acc = __builtin_amdgcn_mfma_f32_32x32x16_bf16(__builtin_bit_cast(bf16x8, a1), __builtin_bit_cast(bf16x8, b1), acc, 0, 0, 0);
            }
            __syncthreads();
            const float bias = in18[((size_t)l * 2 + o) * 256 + c];
            const bf16_t* zg = o == 0 ? zx1 : zx2;
#pragma unroll
            for (int g4 = 0; g4 < 4; ++g4) {
                const int i0 = 8 * g4 + 4 * hf; const int tf = 32 * Bk + i0;
                LAS u32x2* vp = (LAS u32x2*)(vS + Bk * 80 + i0 * 2);
                const u32x2 vv = *vp; const u32x2 gg = *(const u32x2*)(zg + tf);
                const float y0 = (acc[4 * g4 + 0] + bias * bflo(vv.x)) * bflo(gg.x), y1 = (acc[4 * g4 + 1] + bias * bfhi(vv.x)) * bfhi(gg.x);
                const float y2 = (acc[4 * g4 + 2] + bias * bflo(vv.y)) * bflo(gg.y), y3 = (acc[4 * g4 + 3] + bias * bfhi(vv.y)) * bfhi(gg.y);
                if (o == 0) { u32x2 w; w.x = cvt_pk_bf16(y0, y1); w.y = cvt_pk_bf16(y2, y3); *vp = w; }
                else { bf16_t* yp = YHY + (size_t)((p ? MC : 0) + tf) * 256 + c; yp[0] = f2bf(y0); yp[256] = f2bf(y1); yp[512] = f2bf(y2); yp[768] = f2bf(y3); }
            }
            __syncthreads();
        }
      }
    }
#undef HY_RLOAD
    __syncthreads();
}

__device__ void mla_item(const Ctx& C0, int item, bool lat) { const Ctx C = launder(C0);
    const unsigned char* AR = C.ws + WS_AR;
    const bf16_t* Q = (const bf16_t*)(AR + A_Q); const bf16_t* KN = (const bf16_t*)(AR + A_KN); const bf16_t* KR = (const bf16_t*)(AR + A_KR); const bf16_t* VT = (const bf16_t*)(AR + A_VT);
    bf16_t* Y = (bf16_t*)((unsigned char*)C.out + 33554432) + (size_t)1 * M * 256;
    int b, h, qt; if (lat) { b = item >> 8; h = (item >> 6) & 3; qt = item & 63; } else { b = item >> 5; h = (item >> 3) & 3; qt = item & 7; }
    const int row0 = (lat ? MC + b * 2048 : b * 256) + qt * 32, key0 = lat ? MC + b * 2304 : b * 256, nk = lat ? 2304 : 256;
    const int n = C.lane & 31, hf = C.lane >> 5;
    bf16x8 qf[6];
#pragma unroll
    for (int ks = 0; ks < 6; ++ks) qf[ks] = *(const bf16x8*)(Q + (size_t)(row0 + n) * 384 + h * 96 + ks * 16 + hf * 8);
    if (lat) {
        const float* rope = (const float*)(C.ws + WS_ROPE); const int t = qt * 32 + n;
        const f32x4 c0 = *(const f32x4*)(rope + t * 16 + hf * 8), c1 = *(const f32x4*)(rope + t * 16 + hf * 8 + 4);
        const f32x4 s0 = *(const f32x4*)(rope + 32768 + t * 16 + hf * 8), s1 = *(const f32x4*)(rope + 32768 + t * 16 + hf * 8 + 4);
        bf16x8 a = qf[4], bq = qf[5]; float o1v[8], o2v[8];
#pragma unroll
        for (int j = 0; j < 8; ++j) { const float x1 = bf2f((bf16_t)a[j]), x2 = bf2f((bf16_t)bq[j]); const float cs = j < 4 ? c0[j & 3] : c1[j & 3], sn = j < 4 ? s0[j & 3] : s1[j & 3];
            o1v[j] = x1 * cs - x2 * sn; o2v[j] = x1 * sn + x2 * cs; }
        u32x4 wa, wb; wa.x = cvt_pk_bf16(o1v[0], o1v[1]); wa.y = cvt_pk_bf16(o1v[2], o1v[3]); wa.z = cvt_pk_bf16(o1v[4], o1v[5]); wa.w = cvt_pk_bf16(o1v[6], o1v[7]);
        wb.x = cvt_pk_bf16(o2v[0], o2v[1]); wb.y = cvt_pk_bf16(o2v[2], o2v[3]); wb.z = cvt_pk_bf16(o2v[4], o2v[5]); wb.w = cvt_pk_bf16(o2v[6], o2v[7]);
        qf[4] = __builtin_bit_cast(bf16x8, wa); qf[5] = __builtin_bit_cast(bf16x8, wb);
    }
    float mrun = -1e30f, lrun = 0.f; f32x16 o0, o1;
#pragma unroll
    for (int r = 0; r < 16; ++r) { o0[r] = 0.f; o1[r] = 0.f; }
    const bf16_t* vt0 = VT + (size_t)(h * 64 + n) * NKEY + key0 + 4 * hf; const bf16_t* vt1 = vt0 + (size_t)32 * NKEY;
    for (int kt = 0; kt < nk; kt += 32) {
        const size_t key = (size_t)key0 + kt + n;
        bf16x8 kf[6];
#pragma unroll
        for (int ks = 0; ks < 4; ++ks) kf[ks] = *(const bf16x8*)(KN + key * 256 + h * 64 + ks * 16 + hf * 8);
        kf[4] = *(const bf16x8*)(KR + key * 32 + hf * 8); kf[5] = *(const bf16x8*)(KR + key * 32 + 16 + hf * 8);
        bf16x4 va[2][2][2];
#pragma unroll
        for (int s2 = 0; s2 < 2; ++s2) { va[0][s2][0] = *(const bf16x4*)(vt0 + kt + 16 * s2); va[0][s2][1] = *(const bf16x4*)(vt0 + kt + 16 * s2 + 8);
                                         va[1][s2][0] = *(const bf16x4*)(vt1 + kt + 16 * s2); va[1][s2][1] = *(const bf16x4*)(vt1 + kt + 16 * s2 + 8); }
        f32x16 s;
#pragma unroll
        for (int r = 0; r < 16; ++r) s[r] = 0.f;
#pragma unroll
        for (int ks = 0; ks < 6; ++ks) s = __builtin_amdgcn_mfma_f32_32x32x16_bf16(kf[ks], qf[ks], s, 0, 0, 0);
        float mx = s[0];
#pragma unroll
        for (int r = 1; r < 16; ++r) mx = fmaxf(mx, s[r]);
        mx = fmaxf(mx, shx(mx, 32, C.lane));
        const float mnew = fmaxf(mrun, mx), alpha = exp2f(mrun - mnew); mrun = mnew;
        float ls = 0.f;
#pragma unroll
        for (int r = 0; r < 16; ++r) { s[r] = exp2f(s[r] - mnew); ls += s[r]; }
        lrun = lrun * alpha + ls;
#pragma unroll
        for (int r = 0; r < 16; ++r) { o0[r] *= alpha; o1[r] *= alpha; }
#pragma unroll
        for (int s2 = 0; s2 < 2; ++s2) {
            u32x4 pw; pw.x = cvt_pk_bf16(s[8 * s2], s[8 * s2 + 1]); pw.y = cvt_pk_bf16(s[8 * s2 + 2], s[8 * s2 + 3]); pw.z = cvt_pk_bf16(s[8 * s2 + 4], s[8 * s2 + 5]); pw.w = cvt_pk_bf16(s[8 * s2 + 6], s[8 * s2 + 7]);
            const bf16x8 pf = __builtin_bit_cast(bf16x8, pw);
            const bf16x8 v0 = __builtin_shufflevector(va[0][s2][0], va[0][s2][1], 0, 1, 2, 3, 4, 5, 6, 7), v1 = __builtin_shufflevector(va[1][s2][0], va[1][s2][1], 0, 1, 2, 3, 4, 5, 6, 7);
            o0 = __builtin_amdgcn_mfma_f32_32x32x16_bf16(v0, pf, o0, 0, 0, 0);
            o1 = __builtin_amdgcn_mfma_f32_32x32x16_bf16(v1, pf, o1, 0, 0, 0);
        }
    }
    lrun += shx(lrun, 32, C.lane);
    const float inv = 1.0f / lrun;
    bf16_t* yp = Y + (size_t)(row0 + n) * 256 + h * 64 + 4 * hf;
#pragma unroll
    for (int g4 = 0; g4 < 4; ++g4) {
        u32x2 w0, w1; w0.x = cvt_pk_bf16(o0[4 * g4] * inv, o0[4 * g4 + 1] * inv); w0.y = cvt_pk_bf16(o0[4 * g4 + 2] * inv, o0[4 * g4 + 3] * inv);
        w1.x = cvt_pk_bf16(o1[4 * g4] * inv, o1[4 * g4 + 1] * inv); w1.y = cvt_pk_bf16(o1[4 * g4 + 2] * inv, o1[4 * g4 + 3] * inv);
        *(u32x2*)(yp + 8 * g4) = w0; *(u32x2*)(yp + 32 + 8 * g4) = w1;
    }
}

__device__ __forceinline__ float log2_sigmoid(float x) { return -log1pf(__expf(-x)) * 1.4426950408889634f; }
__device__ void ret_item(const Ctx& C0, int l0, int item, bool lat) { const int l = launder_s(l0); const Ctx C = launder(C0); const float* in25 = INF(25);
    const unsigned char* AR = C.ws + WS_AR;
    const bf16_t* URET = (const bf16_t*)(AR + A_URET); const bf16_t* RVT = (const bf16_t*)(AR + A_RVT);
    const bf16_t* S0T = (const bf16_t*)(C.ws + WS_S0T);
    bf16_t* Y = (bf16_t*)((unsigned char*)C.out + 33554432) + (size_t)2 * M * 256;
    int b, h, qt; if (lat) { b = item >> 8; h = (item >> 6) & 3; qt = item & 63; } else { b = item >> 5; h = (item >> 3) & 3; qt = item & 7; }
    const int L = lat ? 2048 : 256, sb = lat ? MC + b * 2048 : b * 256, row0 = sb + qt * 32;
    const int n = C.lane & 31, hf = C.lane >> 5;
    const float lgf = log2_sigmoid(in25[(l * 2 + 0) * 4 + h]), lgb = log2_sigmoid(in25[(l * 2 + 1) * 4 + h]);
    bf16x8 qf[4];
#pragma unroll
    for (int ks = 0; ks < 4; ++ks) qf[ks] = *(const bf16x8*)(URET + (size_t)(row0 + n) * 1024 + h * 64 + ks * 16 + hf * 8);
    f32x16 o0, o1;
#pragma unroll
    for (int r = 0; r < 16; ++r) { o0[r] = 0.f; o1[r] = 0.f; }
    const int tq = qt * 32 + n;
    const bf16_t* vt0 = RVT + (size_t)(h * 64 + n) * M + sb + 4 * hf; const bf16_t* vt1 = vt0 + (size_t)32 * M;
    for (int kt = 0; kt < L; kt += 32) {
        bf16x8 kf[4];
#pragma unroll
        for (int ks = 0; ks < 4; ++ks) kf[ks] = *(const bf16x8*)(URET + (size_t)(sb + kt + n) * 1024 + 256 + h * 64 + ks * 16 + hf * 8);
        bf16x4 va[2][2][2];
#pragma unroll
        for (int s2 = 0; s2 < 2; ++s2) { va[0][s2][0] = *(const bf16x4*)(vt0 + kt + 16 * s2); va[0][s2][1] = *(const bf16x4*)(vt0 + kt + 16 * s2 + 8);
                                         va[1][s2][0] = *(const bf16x4*)(vt1 + kt + 16 * s2); va[1][s2][1] = *(const bf16x4*)(vt1 + kt + 16 * s2 + 8); }
        f32x16 s;
#pragma unroll
        for (int r = 0; r < 16; ++r) s[r] = 0.f;
#pragma unroll
        for (int ks = 0; ks < 4; ++ks) s = __builtin_amdgcn_mfma_f32_32x32x16_bf16(kf[ks], qf[ks], s, 0, 0, 0);
#pragma unroll
        for (int r = 0; r < 16; ++r) { const int sp = kt + 8 * (r >> 2) + 4 * hf + (r & 3); const int dd = tq - sp;
            const float w = dd > 0 ? exp2f(lgf * (float)dd) : (dd < 0 ? exp2f(lgb * (float)(-dd)) : 2.0f);
            s[r] = s[r] * w * 0.125f; }
#pragma unroll
        for (int s2 = 0; s2 < 2; ++s2) {
            u32x4 pw; pw.x = cvt_pk_bf16(s[8 * s2], s[8 * s2 + 1]); pw.y = cvt_pk_bf16(s[8 * s2 + 2], s[8 * s2 + 3]); pw.z = cvt_pk_bf16(s[8 * s2 + 4], s[8 * s2 + 5]); pw.w = cvt_pk_bf16(s[8 * s2 + 6], s[8 * s2 + 7]);
            const bf16x8 pf = __builtin_bit_cast(bf16x8, pw);
            const bf16x8 v0 = __builtin_shufflevector(va[0][s2][0], va[0][s2][1], 0, 1, 2, 3, 4, 5, 6, 7), v1 = __builtin_shufflevector(va[1][s2][0], va[1][s2][1], 0, 1, 2, 3, 4, 5, 6, 7);
            o0 = __builtin_amdgcn_mfma_f32_32x32x16_bf16(v0, pf, o0, 0, 0, 0);
            o1 = __builtin_amdgcn_mfma_f32_32x32x16_bf16(v1, pf, o1, 0, 0, 0);
        }
    }
    if (lat) {
#pragma unroll
        for (int dir = 0; dir < 2; ++dir) {
            const bf16_t* st = S0T + ((((size_t)b * 2 + l) * 2 + dir) * 4 + h) * 4096;
            f32x16 a0, a1;
#pragma unroll
            for (int r = 0; r < 16; ++r) { a0[r] = 0.f; a1[r] = 0.f; }
#pragma unroll
            for (int ks = 0; ks < 4; ++ks) {
                const bf16x8 s0 = *(const bf16x8*)(st + (size_t)n * 64 + ks * 16 + hf * 8), s1 = *(const bf16x8*)(st + (size_t)(32 + n) * 64 + ks * 16 + hf * 8);
                a0 = __builtin_amdgcn_mfma_f32_32x32x16_bf16(s0, qf[ks], a0, 0, 0, 0);
                a1 = __builtin_amdgcn_mfma_f32_32x32x16_bf16(s1, qf[ks], a1, 0, 0, 0);
            }
            const float w = dir == 0 ? exp2f(lgf * (float)(tq + 1)) : exp2f(lgb * (float)(L - tq));
#pragma unroll
            for (int r = 0; r < 16; ++r) { o0[r] += w * a0[r]; o1[r] += w * a1[r]; }
        }
    }
    float sm = 0.f;
#pragma unroll
    for (int r = 0; r < 16; ++r) sm += o0[r] + o1[r];
    sm += shx(sm, 32, C.lane);
    const float mu = sm * (1.0f / 64.0f);
    float vr = 0.f;
#pragma unroll
    for (int r = 0; r < 16; ++r) { const float d0 = o0[r] - mu, d1 = o1[r] - mu; vr += d0 * d0 + d1 * d1; }
    vr += shx(vr, 32, C.lane);
    const float rs = rsqrtf(vr * (1.0f / 64.0f) + 1e-6f);
    const bf16_t* gp = URET + (size_t)(row0 + n) * 1024 + 768 + h * 64 + 4 * hf;
    bf16_t* yp = Y + (size_t)(row0 + n) * 256 + h * 64 + 4 * hf;
#pragma unroll
    for (int g4 = 0; g4 < 4; ++g4) {
        const u32x2 ga = *(const u32x2*)(gp + 8 * g4), gb = *(const u32x2*)(gp + 32 + 8 * g4);
        const float g0[4] = {bflo(ga.x), bfhi(ga.x), bflo(ga.y), bfhi(ga.y)}, g1[4] = {bflo(gb.x), bfhi(gb.x), bflo(gb.y), bfhi(gb.y)};
        float y0[4], y1[4];
#pragma unroll
        for (int j = 0; j < 4; ++j) { y0[j] = (o0[4 * g4 + j] - mu) * rs * (g0[j] * sigmoidf_(g0[j])); y1[j] = (o1[4 * g4 + j] - mu) * rs * (g1[j] * sigmoidf_(g1[j])); }
        u32x2 w0, w1; w0.x = cvt_pk_bf16(y0[0], y0[1]); w0.y = cvt_pk_bf16(y0[2], y0[3]); w1.x = cvt_pk_bf16(y1[0], y1[1]); w1.y = cvt_pk_bf16(y1[2], y1[3]);
        *(u32x2*)(yp + 8 * g4) = w0; *(u32x2*)(yp + 32 + 8 * g4) = w1;
    }
}


template <bool IS_RET>
__device__ __forceinline__ void att_block(const Ctx& C0, int l0, bool lat, int b, int h, int qblk) { const int l = launder_s(l0); const Ctx C = launder(C0);
    const unsigned char* AR = C.ws + WS_AR;
    const bf16_t* Q = (const bf16_t*)(AR + A_Q); const bf16_t* KN = (const bf16_t*)(AR + A_KN); const bf16_t* KR = (const bf16_t*)(AR + A_KR); const bf16_t* VT = (const bf16_t*)(AR + A_VT);
    const bf16_t* URET = (const bf16_t*)(AR + A_URET); const bf16_t* RVT = (const bf16_t*)(AR + A_RVT);
    constexpr int KP = 208, VP = 264, KBYTES = 128 * KP, SBYTES = KBYTES + 64 * VP;
    const int L = lat ? 2048 : 256, sb = lat ? MC + b * 2048 : b * 256;
    const int row0 = sb + qblk * 256 + C.wid * 32;
    const int key0 = IS_RET ? sb : (lat ? MC + b * 2304 : b * 256), nk = IS_RET ? L : (lat ? 2304 : 256);
    const int n = C.lane & 31, hf = C.lane >> 5;
    constexpr int NKS = IS_RET ? 4 : 6;
    bf16x8 qf[NKS];
    if (IS_RET) {
#pragma unroll
        for (int ks = 0; ks < 4; ++ks) qf[ks] = *(const bf16x8*)(URET + (size_t)(row0 + n) * 1024 + h * 64 + ks * 16 + hf * 8);
    } else {
#pragma unroll
        for (int ks = 0; ks < NKS; ++ks) qf[ks] = *(const bf16x8*)(Q + (size_t)(row0 + n) * 384 + h * 96 + ks * 16 + hf * 8);
        if (lat) {
            const float* rope = (const float*)(C.ws + WS_ROPE); const int t = row0 - sb + n;
            const f32x4 c0 = *(const f32x4*)(rope + t * 16 + hf * 8), c1 = *(const f32x4*)(rope + t * 16 + hf * 8 + 4);
            const f32x4 s0 = *(const f32x4*)(rope + 32768 + t * 16 + hf * 8), s1 = *(const f32x4*)(rope + 32768 + t * 16 + hf * 8 + 4);
            bf16x8 a = qf[NKS - 2], bq = qf[NKS - 1]; float o1v[8], o2v[8];
#pragma unroll
            for (int j = 0; j < 8; ++j) { const float x1 = bf2f((bf16_t)a[j]), x2 = bf2f((bf16_t)bq[j]); const float cs = j < 4 ? c0[j & 3] : c1[j & 3], sn = j < 4 ? s0[j & 3] : s1[j & 3];
                o1v[j] = x1 * cs - x2 * sn; o2v[j] = x1 * sn + x2 * cs; }
            u32x4 wa, wb; wa.x = cvt_pk_bf16(o1v[0], o1v[1]); wa.y = cvt_pk_bf16(o1v[2], o1v[3]); wa.z = cvt_pk_bf16(o1v[4], o1v[5]); wa.w = cvt_pk_bf16(o1v[6], o1v[7]);
            wb.x = cvt_pk_bf16(o2v[0], o2v[1]); wb.y = cvt_pk_bf16(o2v[2], o2v[3]); wb.z = cvt_pk_bf16(o2v[4], o2v[5]); wb.w = cvt_pk_bf16(o2v[6], o2v[7]);
            qf[NKS - 2] = __builtin_bit_cast(bf16x8, wa); qf[NKS - 1] = __builtin_bit_cast(bf16x8, wb);
        }
    }
    float lgf = 0.f, lgb = 0.f;
    if (IS_RET) { const float* in25 = INF(25); lgf = log2_sigmoid(in25[(l * 2 + 0) * 4 + h]); lgb = log2_sigmoid(in25[(l * 2 + 1) * 4 + h]); }
    const int tq = row0 - sb + n;
    const int q0w = qblk * 256 + C.wid * 32;
    float mrun = -1e30f, lrun = 0.f; f32x16 o0, o1;
#pragma unroll
    for (int r = 0; r < 16; ++r) { o0[r] = 0.f; o1[r] = 0.f; }
    const int skey = C.tid >> 3, sch = C.tid & 7, rkey = C.tid >> 2, rch = C.tid & 3;
    u32x4 gk0, gk1, gr, gv0, gv1;
#define ATT_GLOAD(kt) do { \
        if (IS_RET) { \
            gk0 = *(const u32x4*)(URET + (size_t)(sb + (kt) + skey) * 1024 + 256 + h * 64 + sch * 8); gk1 = *(const u32x4*)(URET + (size_t)(sb + (kt) + skey + 64) * 1024 + 256 + h * 64 + sch * 8); \
            gv0 = *(const u32x4*)(RVT + (size_t)(h * 64 + skey) * M + sb + (kt) + sch * 8); gv1 = *(const u32x4*)(RVT + (size_t)(h * 64 + skey) * M + sb + (kt) + (sch + 8) * 8); \
        } else { \
            gk0 = *(const u32x4*)(KN + (size_t)(key0 + (kt) + skey) * 256 + h * 64 + sch * 8); gk1 = *(const u32x4*)(KN + (size_t)(key0 + (kt) + skey + 64) * 256 + h * 64 + sch * 8); \
            gv0 = *(const u32x4*)(VT + (size_t)(h * 64 + skey) * NKEY + key0 + (kt) + sch * 8); gv1 = *(const u32x4*)(VT + (size_t)(h * 64 + skey) * NKEY + key0 + (kt) + (sch + 8) * 8); \
            gr = *(const u32x4*)(KR + (size_t)(key0 + (kt) + rkey) * 32 + rch * 8); \
        } } while (0)
#define ATT_LSTORE(buf) do { \
        LAS unsigned char* kb_ = C.ldsL + (buf) * SBYTES; LAS unsigned char* vb_ = kb_ + KBYTES; \
        *(LAS u32x4*)(kb_ + skey * KP + sch * 16) = gk0; *(LAS u32x4*)(kb_ + (skey + 64) * KP + sch * 16) = gk1; \
        *(LAS u32x2*)(vb_ + skey * VP + sch * 16) = (u32x2){gv0.x, gv0.y}; *(LAS u32x2*)(vb_ + skey * VP + sch * 16 + 8) = (u32x2){gv0.z, gv0.w}; \
        *(LAS u32x2*)(vb_ + skey * VP + (sch + 8) * 16) = (u32x2){gv1.x, gv1.y}; *(LAS u32x2*)(vb_ + skey * VP + (sch + 8) * 16 + 8) = (u32x2){gv1.z, gv1.w}; \
        if (!IS_RET) *(LAS u32x4*)(kb_ + rkey * KP + 128 + rch * 16) = gr; } while (0)
    __syncthreads();
    ATT_GLOAD(0); ATT_LSTORE(0);
    __syncthreads();
    const int nst = nk >> 7;
    for (int st = 0; st < nst; ++st) {
        if (st + 1 < nst) ATT_GLOAD((st + 1) * 128);
        const LAS unsigned char* kb = C.ldsL + (st & 1) * SBYTES; const LAS unsigned char* vb = kb + KBYTES;
#pragma unroll
        for (int sub = 0; sub < 4; ++sub) {
            f32x16 s;
#pragma unroll
            for (int r = 0; r < 16; ++r) s[r] = 0.f;
#pragma unroll
            for (int ks = 0; ks < NKS; ++ks) { const bf16x8 kf = *(const LAS bf16x8*)(kb + (sub * 32 + n) * KP + ks * 32 + hf * 16); s = __builtin_amdgcn_mfma_f32_32x32x16_bf16(kf, qf[ks], s, 0, 0, 0); }
            if (IS_RET) {
                const int kt = st * 128 + sub * 32;
                if (kt < q0w) {
                    const float base = lgf * (float)(tq - kt - 4 * hf) - 3.0f;
#pragma unroll
                    for (int r = 0; r < 16; ++r) s[r] = s[r] * __builtin_amdgcn_exp2f(fmaxf(base - lgf * (float)(8 * (r >> 2) + (r & 3)), -126.0f));
                } else if (kt > q0w) {
                    const float base = lgb * (float)(kt + 4 * hf - tq) - 3.0f;
#pragma unroll
                    for (int r = 0; r < 16; ++r) s[r] = s[r] * __builtin_amdgcn_exp2f(fmaxf(base + lgb * (float)(8 * (r >> 2) + (r & 3)), -126.0f));
                } else {
#pragma unroll
                    for (int r = 0; r < 16; ++r) { const int sp = kt + 8 * (r >> 2) + 4 * hf + (r & 3); const int dd = tq - sp;
                        const float w = dd > 0 ? exp2f(lgf * (float)dd) : (dd < 0 ? exp2f(lgb * (float)(-dd)) : 2.0f);
                        s[r] = s[r] * w * 0.125f; }
                }
            } else {
                float mx = s[0];
#pragma unroll
                for (int r = 1; r < 16; ++r) mx = fmaxf(mx, s[r]);
                mx = fmaxf(mx, shx(mx, 32, C.lane));
                const float mnew = fmaxf(mrun, mx);
                if (__ballot(mnew > mrun) != 0ull) {
                    const float alpha = __builtin_amdgcn_exp2f(fmaxf(mrun - mnew, -126.0f)); mrun = mnew; lrun *= alpha;
#pragma unroll
                    for (int r = 0; r < 16; ++r) { o0[r] *= alpha; o1[r] *= alpha; }
                }
                float ls = 0.f;
#pragma unroll
                for (int r = 0; r < 16; ++r) { s[r] = __builtin_amdgcn_exp2f(fmaxf(s[r] - mrun, -126.0f)); ls += s[r]; }
                lrun += ls;
            }
#pragma unroll
            for (int s2 = 0; s2 < 2; ++s2) {
                u32x4 pw; pw.x = cvt_pk_bf16(s[8 * s2], s[8 * s2 + 1]); pw.y = cvt_pk_bf16(s[8 * s2 + 2], s[8 * s2 + 3]); pw.z = cvt_pk_bf16(s[8 * s2 + 4], s[8 * s2 + 5]); pw.w = cvt_pk_bf16(s[8 * s2 + 6], s[8 * s2 + 7]);
                const bf16x8 pf = __builtin_bit_cast(bf16x8, pw);
                const LAS unsigned char* v0p = vb + n * VP + (sub * 32 + 16 * s2 + 4 * hf) * 2; const LAS unsigned char* v1p = v0p + 32 * VP;
                const u32x2 a0 = *(const LAS u32x2*)v0p, a1 = *(const LAS u32x2*)(v0p + 16), b0 = *(const LAS u32x2*)v1p, b1 = *(const LAS u32x2*)(v1p + 16);
                const u32x4 va = (u32x4){a0.x, a0.y, a1.x, a1.y}, vbv = (u32x4){b0.x, b0.y, b1.x, b1.y};
                o0 = __builtin_amdgcn_mfma_f32_32x32x16_bf16(__builtin_bit_cast(bf16x8, va), pf, o0, 0, 0, 0);
                o1 = __builtin_amdgcn_mfma_f32_32x32x16_bf16(__builtin_bit_cast(bf16x8, vbv), pf, o1, 0, 0, 0);
            }
        }
        if (st + 1 < nst) ATT_LSTORE((st + 1) & 1);
        __syncthreads();
    }
    if (!IS_RET) {
        bf16_t* Y = (bf16_t*)((unsigned char*)C.out + 33554432) + (size_t)1 * M * 256;
        lrun += shx(lrun, 32, C.lane);
        const float inv = 1.0f / lrun;
        bf16_t* yp = Y + (size_t)(row0 + n) * 256 + h * 64 + 4 * hf;
#pragma unroll
        for (int g4 = 0; g4 < 4; ++g4) {
            u32x2 w0, w1; w0.x = cvt_pk_bf16(o0[4 * g4] * inv, o0[4 * g4 + 1] * inv); w0.y = cvt_pk_bf16(o0[4 * g4 + 2] * inv, o0[4 * g4 + 3] * inv);
            w1.x = cvt_pk_bf16(o1[4 * g4] * inv, o1[4 * g4 + 1] * inv); w1.y = cvt_pk_bf16(o1[4 * g4 + 2] * inv, o1[4 * g4 + 3] * inv);
            *(u32x2*)(yp + 8 * g4) = w0; *(u32x2*)(yp + 32 + 8 * g4) = w1;
        }
    } else {
        bf16_t* Y = (bf16_t*)((unsigned char*)C.out + 33554432) + (size_t)2 * M * 256;
        if (lat) {
            const bf16_t* S0T = (const bf16_t*)(C.ws + WS_S0T);
#pragma unroll
            for (int dir = 0; dir < 2; ++dir) {
                const bf16_t* stp = S0T + ((((size_t)b * 2 + l) * 2 + dir) * 4 + h) * 4096;
                f32x16 a0, a1;
#pragma unroll
                for (int r = 0; r < 16; ++r) { a0[r] = 0.f; a1[r] = 0.f; }
#pragma unroll
                for (int ks = 0; ks < 4; ++ks) {
                    const bf16x8 s0 = *(const bf16x8*)(stp + (size_t)n * 64 + ks * 16 + hf * 8), s1 = *(const bf16x8*)(stp + (size_t)(32 + n) * 64 + ks * 16 + hf * 8);
                    a0 = __builtin_amdgcn_mfma_f32_32x32x16_bf16(s0, qf[ks], a0, 0, 0, 0);
                    a1 = __builtin_amdgcn_mfma_f32_32x32x16_bf16(s1, qf[ks], a1, 0, 0, 0);
                }
                const float w = dir == 0 ? exp2f(lgf * (float)(tq + 1)) : exp2f(lgb * (float)(L - tq));
#pragma unroll
                for (int r = 0; r < 16; ++r) { o0[r] += w * a0[r]; o1[r] += w * a1[r]; }
            }
        }
        float sm = 0.f;
#pragma unroll
        for (int r = 0; r < 16; ++r) sm += o0[r] + o1[r];
        sm += shx(sm, 32, C.lane);
        const float mu = sm * (1.0f / 64.0f);
        float vr = 0.f;
#pragma unroll
        for (int r = 0; r < 16; ++r) { const float d0 = o0[r] - mu, d1 = o1[r] - mu; vr += d0 * d0 + d1 * d1; }
        vr += shx(vr, 32, C.lane);
        const float rs = rsqrtf(vr * (1.0f / 64.0f) + 1e-6f);
        const bf16_t* gp = URET + (size_t)(row0 + n) * 1024 + 768 + h * 64 + 4 * hf;
        bf16_t* yp = Y + (size_t)(row0 + n) * 256 + h * 64 + 4 * hf;
#pragma unroll
        for (int g4 = 0; g4 < 4; ++g4) {
            const u32x2 ga = *(const u32x2*)(gp + 8 * g4), gb = *(const u32x2*)(gp + 32 + 8 * g4);
            const float g0[4] = {bflo(ga.x), bfhi(ga.x), bflo(ga.y), bfhi(ga.y)}, g1[4] = {bflo(gb.x), bfhi(gb.x), bflo(gb.y), bfhi(gb.y)};
            float y0[4], y1[4];
#pragma unroll
            for (int j = 0; j < 4; ++j) { y0[j] = (o0[4 * g4 + j] - mu) * rs * (g0[j] * sigmoidf_(g0[j])); y1[j] = (o1[4 * g4 + j] - mu) * rs * (g1[j] * sigmoidf_(g1[j])); }
            u32x2 w0, w1; w0.x = cvt_pk_bf16(y0[0], y0[1]); w0.y = cvt_pk_bf16(y0[2], y0[3]); w1.x = cvt_pk_bf16(y1[0], y1[1]); w1.y = cvt_pk_bf16(y1[2], y1[3]);
            *(u32x2*)(yp + 8 * g4) = w0; *(u32x2*)(yp + 32 + 8 * g4) = w1;
        }
    }
    __syncthreads();
}

__device__ __forceinline__ void ret_state(const Ctx& C0, int l0) { const int l = launder_s(l0); const Ctx C = launder(C0); const float* in25 = INF(25);
    const bf16_t* URET = (const bf16_t*)(C.ws + WS_AR + A_URET);
    float* out = C.out + 19398656;
    LAS unsigned char* ksm = C.ldsL; LAS unsigned char* vsm = C.ldsL + 256 * 144;
    for (int item = C.bid; item < 256; item += C.G) {
        const int b = item >> 3, h = (item >> 1) & 3, dir = item & 1;
        const float lg = log2_sigmoid(in25[(l * 2 + dir) * 4 + h]);
        __syncthreads();
#pragma unroll
        for (int j = 0; j < 4; ++j) { const int row = (C.tid >> 3) + 64 * j, ch = C.tid & 7; const bf16_t* rp = URET + (size_t)(b * 256 + row) * 1024 + h * 64 + ch * 8;
            *(LAS u32x4*)(ksm + row * 144 + ch * 16) = *(const u32x4*)(rp + 256); *(LAS u32x4*)(vsm + row * 144 + ch * 16) = *(const u32x4*)(rp + 512); }
        __syncthreads();
        const int dk = C.tid >> 3, dv8 = C.tid & 7;
        float a[8];
#pragma unroll
        for (int j = 0; j < 8; ++j) a[j] = 0.f;
#pragma unroll 4
        for (int s = 0; s < 256; ++s) {
            const float w = exp2f(lg * (float)(dir == 0 ? 255 - s : s)) * 0.125f;
            const float kk = bf2f(*(const LAS bf16_t*)(ksm + s * 144 + dk * 2)) * w;
            const u32x4 v = *(const LAS u32x4*)(vsm + s * 144 + dv8 * 16);
            a[0] += kk * bflo(v.x); a[1] += kk * bfhi(v.x); a[2] += kk * bflo(v.y); a[3] += kk * bfhi(v.y);
            a[4] += kk * bflo(v.z); a[5] += kk * bfhi(v.z); a[6] += kk * bflo(v.w); a[7] += kk * bfhi(v.w);
        }
        float* op = out + ((((size_t)b * 2 + l) * 2 + dir) * 4 + h) * 4096 + dk * 64 + dv8 * 8;
        *(f32x4*)op = (f32x4){a[0], a[1], a[2], a[3]}; *(f32x4*)(op + 4) = (f32x4){a[4], a[5], a[6], a[7]};
    }
    __syncthreads();
}

__device__ __forceinline__ void merge_phase(const Ctx& C0, int l0) { const int l = launder_s(l0); const Ctx C = launder(C0); const float* gbias = INF(33) + l * 4096;
    const bf16_t* YB = (const bf16_t*)((unsigned char*)C.out + 33554432); const bf16_t* BO = (const bf16_t*)(C.ws + WS_W + W_BOUT);
    const unsigned char* GT = (const unsigned char*)(C.ws + WS_AR + A_GT); bf16_t* MG = (bf16_t*)C.out;
    constexpr int AP = 72;
    constexpr int ABYTES = 256 * AP * 2, BBYTES = 128 * AP * 2, SBYTES = ABYTES + BBYTES;
    const int wm = C.wid >> 1, wn = C.wid & 1, n = C.lane & 31, hf = C.lane >> 5;
    for (int tile = C.bid; tile < 512; tile += C.G) {
        int pm = tile >> 3, pn = tile & 7;
        if (C.G == 256) { const int x = C.bid & 7, j = C.bid >> 3; pm = x * 4 + (j >> 3) + 32 * (tile >> 8); pn = j & 7; }
        f32x16 acc[2][2], tot[2][2];
#pragma unroll
        for (int a = 0; a < 2; ++a)
#pragma unroll
            for (int b = 0; b < 2; ++b)
#pragma unroll
                for (int r = 0; r < 16; ++r) { acc[a][b][r] = 0.f; tot[a][b][r] = 0.f; }
        u32x4 ra[4], rb[2];
        auto gload = [&](int it) {
            const int br = it >> 2, kc = it & 3;
#pragma unroll
            for (int j = 0; j < 4; ++j) { const int q = C.tid + NT * j, row = q >> 3, kp = q & 7; ra[j] = *(const u32x4*)(YB + ((size_t)br * M + pm * 256 + row) * 256 + kc * 64 + kp * 8); }
#pragma unroll
            for (int j = 0; j < 2; ++j) { const int q = C.tid + NT * j, col = q >> 3, kp = q & 7; rb[j] = *(const u32x4*)(BO + ((size_t)br * 1024 + pn * 128 + col) * 256 + kc * 64 + kp * 8); }
        };
        auto lstore = [&](int buf) {
            LAS unsigned char* sa = C.ldsL + buf * SBYTES; LAS unsigned char* sbp = sa + ABYTES;
#pragma unroll
            for (int j = 0; j < 4; ++j) { const int q = C.tid + NT * j, row = q >> 3, kp = q & 7; *(LAS u32x4*)(sa + (row * AP + kp * 8) * 2) = ra[j]; }
#pragma unroll
            for (int j = 0; j < 2; ++j) { const int q = C.tid + NT * j, col = q >> 3, kp = q & 7; *(LAS u32x4*)(sbp + (col * AP + kp * 8) * 2) = rb[j]; }
        };
        __syncthreads();
        ((LAS float*)(C.ldsL + 2 * SBYTES))[C.tid] = gbias[(C.tid >> 7) * 1024 + pn * 128 + (C.tid & 127)];
        gload(0); lstore(0);
        __syncthreads();
        for (int it = 0; it < 16; ++it) {
            if (it < 15) gload(it + 1);
            unsigned gwq[2][4];
            if ((it & 3) == 3) {
#pragma unroll
                for (int nt = 0; nt < 2; ++nt)
#pragma unroll
                    for (int g4 = 0; g4 < 4; ++g4)
                        gwq[nt][g4] = *(const unsigned*)(GT + ((size_t)pm * 256 + wm * 64 + n) * 4096 + (it >> 2) * 1024 + pn * 128 + wn * 64 + nt * 32 + 4 * hf + 8 * g4);
            }
            const LAS unsigned char* sa = C.ldsL + (it & 1) * SBYTES; const LAS unsigned char* sbp = sa + ABYTES;
#pragma unroll
            for (int kk = 0; kk < 4; ++kk) {
                bf16x8 af[2], bfr[2];
#pragma unroll
                for (int mt = 0; mt < 2; ++mt) af[mt] = *(const LAS bf16x8*)(sa + ((wm * 64 + mt * 32 + n) * AP + kk * 16 + hf * 8) * 2);
#pragma unroll
                for (int nt = 0; nt < 2; ++nt) bfr[nt] = *(const LAS bf16x8*)(sbp + ((wn * 64 + nt * 32 + n) * AP + kk * 16 + hf * 8) * 2);
#pragma unroll
                for (int mt = 0; mt < 2; ++mt)
#pragma unroll
                    for (int nt = 0; nt < 2; ++nt) acc[mt][nt] = __builtin_amdgcn_mfma_f32_32x32x16_bf16(bfr[nt], af[mt], acc[mt][nt], 0, 0, 0);
            }
            if ((it & 3) == 3) {
                const int br = it >> 2;
#pragma unroll
                for (int mt = 0; mt < 2; ++mt) {
                    const size_t R = (size_t)pm * 256 + wm * 64 + mt * 32 + n;
#pragma unroll
                    for (int nt = 0; nt < 2; ++nt) {
#pragma unroll
                        for (int g4 = 0; g4 < 4; ++g4) { const int gw = mt == 0 ? (int)gwq[nt][g4] : (int)*(const unsigned*)(GT + R * 4096 + br * 1024 + pn * 128 + wn * 64 + nt * 32 + 4 * hf + 8 * g4); const f32x4 gb4 = *(const LAS f32x4*)(C.ldsL + 2 * SBYTES + (br * 128 + wn * 64 + nt * 32 + 4 * hf + 8 * g4) * 4);
                            const float q0 = sigmoidf_(__builtin_amdgcn_cvt_f32_fp8(gw, 0) + gb4[0]), q1 = sigmoidf_(__builtin_amdgcn_cvt_f32_fp8(gw, 1) + gb4[1]), q2 = sigmoidf_(__builtin_amdgcn_cvt_f32_fp8(gw, 2) + gb4[2]), q3 = sigmoidf_(__builtin_amdgcn_cvt_f32_fp8(gw, 3) + gb4[3]);
                            tot[mt][nt][4 * g4] += q0 * acc[mt][nt][4 * g4]; tot[mt][nt][4 * g4 + 1] += q1 * acc[mt][nt][4 * g4 + 1];
                            tot[mt][nt][4 * g4 + 2] += q2 * acc[mt][nt][4 * g4 + 2]; tot[mt][nt][4 * g4 + 3] += q3 * acc[mt][nt][4 * g4 + 3]; }
#pragma unroll
                        for (int r = 0; r < 16; ++r) acc[mt][nt][r] = 0.f;
                    }
                }
            }
            if (it < 15) lstore((it + 1) & 1);
            __syncthreads();
        }
#pragma unroll
        for (int mt = 0; mt < 2; ++mt) {
            const size_t R = (size_t)pm * 256 + wm * 64 + mt * 32 + n;
#pragma unroll
            for (int nt = 0; nt < 2; ++nt) {
                bf16_t* op = MG + R * 1024 + pn * 128 + wn * 64 + nt * 32 + 4 * hf;
#pragma unroll
                for (int g4 = 0; g4 < 4; ++g4) { u32x2 w; w.x = cvt_pk_bf16(tot[mt][nt][4 * g4], tot[mt][nt][4 * g4 + 1]); w.y = cvt_pk_bf16(tot[mt][nt][4 * g4 + 2], tot[mt][nt][4 * g4 + 3]); *(u32x2*)(op + 8 * g4) = w; }
            }
        }
    }
    __syncthreads();
}

#define XB_TMO      128
#define XB_XCNT(j)  (256  + 64 * (j))
#define XB_XSUB(j)  (1280 + 64 * (j))
#define XB_XGEN(j)  (2304 + 64 * (j))
#define XB_TOP      3328
#define XB_TOPGEN   3392
#define XCD_BAR_WORDS 3456
#define XB_SPIN_CAP (1u << 20)
__device__ __forceinline__ unsigned xb_ld(unsigned* p)              { return __hip_atomic_load(p, __ATOMIC_RELAXED, __HIP_MEMORY_SCOPE_AGENT); }
__device__ __forceinline__ unsigned xb_add(unsigned* p, unsigned v) { return __hip_atomic_fetch_add(p, v, __ATOMIC_RELAXED, __HIP_MEMORY_SCOPE_AGENT); }
__device__ __forceinline__ unsigned xb_xcc_id() { return (unsigned)__builtin_amdgcn_s_getreg((3 << 11) | 20) & 0xFu; }
#define XB_SPIN(cond, bar) do { unsigned _sp = 0; while (cond) { __builtin_amdgcn_s_sleep(1); \
    if ((++_sp & 255u) == 0u) { if (xb_ld(&(bar)[XB_TMO])) break; if (_sp > XB_SPIN_CAP) { atomicAdd(&(bar)[XB_TMO], 1u); break; } } } } while (0)
__device__ __forceinline__ void xcd_barrier_complete(unsigned* bar, unsigned x, unsigned G, unsigned& nloc, unsigned& nx) {
    unsigned sum, cnt, mine, sp = 0u;
    for (;;) {
        sum = 0u; cnt = 0u; mine = 0u;
#pragma unroll
        for (unsigned j = 0; j < 16; ++j) { const unsigned c = xb_ld(&bar[XB_XCNT(j)]); sum += c; cnt += (c > 0u) ? 1u : 0u; mine = (j == x) ? c : mine; }
        if (sum == G) break;
        __builtin_amdgcn_s_sleep(1);
        if ((++sp & 255u) == 0u) { if (xb_ld(&bar[XB_TMO])) break; if (sp > XB_SPIN_CAP) { atomicAdd(&bar[XB_TMO], 1u); break; } }
    }
    nloc = mine > 0u ? mine : 1u; nx = cnt > 0u ? cnt : 1u;
}
__device__ __forceinline__ void grid_bar(unsigned* bar, volatile LAS unsigned* st, unsigned G, int wid, int lane) {
    asm volatile("s_waitcnt vmcnt(0)" ::: "memory");
    __syncthreads();
    if (wid == 0 && lane == 0) {
        __builtin_amdgcn_s_waitcnt(0);
        const unsigned x = xb_xcc_id();
        unsigned nloc = st[0], nx = st[1];
        if (nloc == 0u) { xcd_barrier_complete(bar, x, G, nloc, nx); st[0] = nloc; st[1] = nx; }
        const unsigned old = xb_add(&bar[XB_XSUB(x)], 1u);
        const unsigned gen = old / nloc;
        if (old + 1u == (gen + 1u) * nloc) {
            __builtin_amdgcn_fence(__ATOMIC_RELEASE, "agent");
            asm volatile("s_waitcnt vmcnt(0)" ::: "memory");
            const unsigned og = xb_add(&bar[XB_TOP], 1u);
            const unsigned tg = og / nx;
            if (og + 1u == (tg + 1u) * nx) xb_add(&bar[XB_TOPGEN], 1u);
            else XB_SPIN(xb_ld(&bar[XB_TOPGEN]) == tg, bar);
            __builtin_amdgcn_fence(__ATOMIC_ACQUIRE, "agent");
            xb_add(&bar[XB_XGEN(x)], 1u);
            asm volatile("s_waitcnt vmcnt(0)" ::: "memory");
        } else {
            XB_SPIN(xb_ld(&bar[XB_XGEN(x)]) == gen, bar);
            __builtin_amdgcn_fence(__ATOMIC_ACQUIRE, "agent");
            asm volatile("s_waitcnt vmcnt(0)" ::: "memory");
        }
    }
    __syncthreads();
}
__global__ void __launch_bounds__(NT, 2) fwd_megakernel(Params prm) {
    extern __shared__ __attribute__((aligned(16))) unsigned char lds[];
    cg::grid_group grid = cg::this_grid();
    LAS unsigned long long* tabw = (LAS unsigned long long*)((LAS unsigned char*)lds + 131072);
    if (threadIdx.x < 39) tabw[threadIdx.x] = (unsigned long long)prm.in[threadIdx.x];
    __syncthreads();
    Ctx Cm; { Ctx& C = Cm; C.tab = (const LAS unsigned*)tabw; C.out = prm.out; C.ws = prm.ws; C.lds = lds; C.ldsL = (LAS unsigned char*)lds; C.tid = threadIdx.x; C.lane = C.tid & 63; C.wid = __builtin_amdgcn_readfirstlane(C.tid >> 6); C.bid = blockIdx.x; C.G = gridDim.x; }
    const Ctx& C = Cm;
    bf16_t* X = (bf16_t*)(prm.ws + WS_HB);
#define PH_PTRS const Ctx C = launder(Cm); const int lq = launder_s(l); (void)lq; unsigned char* ws = C.ws; asm volatile("" : "+s"(ws)); unsigned char* AR = ws + WS_AR; unsigned char* W = ws + WS_W; (void)AR; (void)W;

    const int lo = prm.ph_lo, hi = prm.ph_hi;
    int ph = 0;
    unsigned* barw = (unsigned*)(prm.ws + WS_BAR);
#define GSYNC() do { const Ctx Cb = launder(C); grid_bar(barw, (volatile LAS unsigned*)((LAS unsigned char*)lds + 131072 + 384), (unsigned)Cb.G, Cb.wid, Cb.lane); } while (0)
#define PH_BEGIN if (ph >= lo && ph < hi) { for (int rep_ = 0; rep_ < 1 + (int)((DUP_MASK >> ph) & 1u); ++rep_) { if (rep_) __syncthreads();
#define PH_END } } if (ph >= lo && ph + 1 < hi) { GSYNC(); if (ph == 0) for (int xb_ = 0; xb_ < EXTRA_BAR; ++xb_) GSYNC(); } ++ph;
    if (hi - lo > 1) {
        if (threadIdx.x < 2) ((LAS unsigned*)((LAS unsigned char*)lds + 131072 + 384))[threadIdx.x] = 0u;
        if (blockIdx.x == 0) for (int i = threadIdx.x; i < XCD_BAR_WORDS; i += NT) __hip_atomic_store(barw + i, 0u, __ATOMIC_RELAXED, __HIP_MEMORY_SCOPE_AGENT);
        asm volatile("s_waitcnt vmcnt(0)" ::: "memory"); __builtin_amdgcn_fence(__ATOMIC_RELEASE, "agent"); asm volatile("s_waitcnt vmcnt(0)" ::: "memory");
        grid.sync();
        __builtin_amdgcn_fence(__ATOMIC_ACQUIRE, "agent"); asm volatile("s_waitcnt vmcnt(0)" ::: "memory");
        if (threadIdx.x == 0) (void)xb_add(&barw[XB_XCNT(xb_xcc_id())], 1u);
        __syncthreads();
    }
    PH_BEGIN p0_mod(C); p0_filters(C); p0_misc(C); PH_END
    for (int l = 0; l < 2; ++l) {
        PH_BEGIN
        norm_phase(C, l, 0);
        convert_weights(C, l);
        if (l == 0) build_rg(C);
        PH_END
        PH_BEGIN
        { PH_PTRS pg8::Gemm g{(const bf16_t*)C.out, (const bf16_t*)(W + W_PROJ), M, 2816, 1024}; pg8::StaticOrder S; S.init(M, 2816, C.G, C.bid);
          pg8::EpiProj E{(bf16_t*)(AR + A_UHY), (bf16_t*)(AR + A_UMLA), (bf16_t*)(AR + A_URET), (bf16_t*)(AR + A_UCONF)};
          pg8::gemm_phase<pg8::EpiProj>(C.ldsL, g, S, E, C.wid); }
        PH_END
        PH_BEGIN prep_phase(C, l); PH_END
        PH_BEGIN
        { PH_PTRS pg8::Gemm g{(const bf16_t*)(AR + A_CQN), (const bf16_t*)(W + W_UQ), M, 512, 256}; pg8::StaticOrder S; S.init(M, 512, C.G, C.bid);
          pg8::EpiPlain E{(bf16_t*)(AR + A_Q), 384, 384};
          pg8::gemm_phase<pg8::EpiPlain>(C.ldsL, g, S, E, C.wid); }
        { PH_PTRS pg8::Gemm g{(const bf16_t*)(AR + A_CKN), (const bf16_t*)(W + W_UK), NKEY, 256, 256}; pg8::StaticOrder S; S.init(NKEY, 256, C.G, (C.bid + C.G - 128) % C.G);
          pg8::EpiPlain E{(bf16_t*)(AR + A_KN), 256, 256};
          pg8::gemm_phase<pg8::EpiPlain>(C.ldsL, g, S, E, C.wid); }
        { PH_PTRS pg8::Gemm g{(const bf16_t*)(W + W_UV), (const bf16_t*)(AR + A_CKN), 256, NKEY, 256}; pg8::StaticOrder S; S.init(256, NKEY, C.G, (C.bid + C.G - 196) % C.G);
          pg8::EpiPlain E{(bf16_t*)(AR + A_VT), NKEY, NKEY};
          pg8::gemm_phase<pg8::EpiPlain>(C.ldsL, g, S, E, C.wid); }
        hyena_phase(C, l);
        PH_END
        PH_BEGIN
        { const Ctx Ca = launder(C);
          for (int p0_ = Ca.bid; p0_ < 256; p0_ += Ca.G) {
              const int p = (Ca.G == 256) ? ((p0_ & 7) * 32 + (p0_ >> 3)) : p0_;
              const int q = p & 127; const bool first = p < 128;
              att_block<false>(C, l, first, first ? (q >> 5) : (q >> 2), first ? ((q >> 3) & 3) : (q & 3), first ? (q & 7) : 0);
              att_block<true>(C, l, !first, first ? (q >> 2) : (q >> 5), first ? (q & 3) : ((q >> 3) & 3), first ? 0 : (q & 7));
          }
          ret_state(C, l); }
        PH_END
        PH_BEGIN
        { PH_PTRS pg8::Gemm g{(const bf16_t*)C.out, (const bf16_t*)(W + W_GATE), M, 4096, 1024}; pg8::StaticOrder S; S.init(M, 4096, C.G, C.bid);
          pg8::EpiGate E{(unsigned char*)(AR + A_GT), 4096};
          pg8::gemm_phase<pg8::EpiGate>(C.ldsL, g, S, E, C.wid); }
        PH_END
        PH_BEGIN merge_phase(C, l); PH_END
        PH_BEGIN
        { PH_PTRS pg8::Gemm g{(const bf16_t*)C.out, (const bf16_t*)(W + W_O), M, 1024, 1024}; pg8::StaticOrder S; S.init(M, 1024, C.G, C.bid);
          pg8::EpiResid E{X, (const float*)(ws + WS_MOD) + (size_t)lq * 5 * 6144 + 2048};
          pg8::gemm_phase<pg8::EpiResid>(C.ldsL, g, S, E, C.wid); }
        PH_END
        PH_BEGIN norm_phase(C, l, 1); PH_END
        PH_BEGIN
        { PH_PTRS pg8::Gemm g{(const bf16_t*)C.out, (const bf16_t*)(W + W_1), M, 5632, 1024}; pg8::StaticOrder S; S.init(M, 5632, C.G, C.bid);
          pg8::EpiFfn1 E{(bf16_t*)(AR + A_ACT)};
          pg8::gemm_phase<pg8::EpiFfn1>(C.ldsL, g, S, E, C.wid); }
        PH_END
        PH_BEGIN
        { PH_PTRS pg8::Gemm g{(const bf16_t*)(AR + A_ACT), (const bf16_t*)(W + W_2), M, 1024, 2816}; pg8::StaticOrder S; S.init(M, 1024, C.G, C.bid);
          pg8::EpiResid E{X, (const float*)(ws + WS_MOD) + (size_t)lq * 5 * 6144 + 5120};
          pg8::gemm_phase<pg8::EpiResid>(C.ldsL, g, S, E, C.wid); }
        PH_END
    }
    PH_BEGIN final_norm(C); PH_END
}

extern "C" void kernel_launch(void* const* d_in, const int* in_sizes, int n_in, void* d_out, int out_size, void* d_ws, size_t ws_size, hipStream_t stream) {
    static int grid = 0;
    if (grid == 0) {
        if (n_in != 39 || ws_size < WS_NEED) { fprintf(stderr, "kernel_launch: unexpected n_in %d / ws_size %zu (need %zu)\n", n_in, ws_size, (size_t)WS_NEED); grid = -1; return; }
        int dev = 0, cus = 0, per_cu = 0;
        hipGetDevice(&dev);
        hipDeviceGetAttribute(&cus, hipDeviceAttributeMultiprocessorCount, dev);
        if (hipFuncSetAttribute((const void*)fwd_megakernel, hipFuncAttributeMaxDynamicSharedMemorySize, LDS_BYTES) != hipSuccess) { fprintf(stderr, "kernel_launch: hipFuncSetAttribute failed\n"); grid = -1; return; }
        if (hipOccupancyMaxActiveBlocksPerMultiprocessor(&per_cu, (const void*)fwd_megakernel, NT, LDS_BYTES) != hipSuccess || per_cu < 1) { fprintf(stderr, "kernel_launch: occupancy query gives %d\n", per_cu); per_cu = 1; }
        (void)hipGetLastError();
        grid = cus;
    }
    if (grid < 0) return;
    Params p{};
    for (int i = 0; i < 39; ++i) p.in[i] = (const float*)d_in[i];
    p.out = (float*)d_out; p.ws = (unsigned char*)d_ws;
    if (hipMemsetAsync((unsigned char*)d_ws + WS_BAR, 0, 16384, stream) != hipSuccess) { fprintf(stderr, "memset failed\n"); return; }
#if MK_PER_PHASE
    for (int k = 0; k < 24; ++k) { p.ph_lo = k; p.ph_hi = k + 1; hipLaunchKernelGGL(fwd_megakernel, dim3(grid), dim3(NT), LDS_BYTES, stream, p); }
#else
    p.ph_lo = 0; p.ph_hi = 24;
    void* args[] = {&p};
    hipError_t e = hipLaunchCooperativeKernel((const void*)fwd_megakernel, dim3(grid), dim3(NT), args, LDS_BYTES, stream);
    if (e != hipSuccess) fprintf(stderr, "cooperative launch failed: %s (grid %d)\n", hipGetErrorString(e), grid);
#endif
}
```

```cpp
#include <hip/hip_runtime.h>
#include <hip/hip_cooperative_groups.h>
#include <cstdio>
namespace cg = cooperative_groups;

#define LAS __attribute__((address_space(3)))
typedef unsigned short bf16_t;
typedef short bf16x8 __attribute__((ext_vector_type(8)));
typedef short bf16x4 __attribute__((ext_vector_type(4)));
typedef float f32x4 __attribute__((ext_vector_type(4)));
typedef float f32x2 __attribute__((ext_vector_type(2)));
typedef float f32x16 __attribute__((ext_vector_type(16)));
typedef unsigned u32x4 __attribute__((ext_vector_type(4)));
typedef unsigned u32x2 __attribute__((ext_vector_type(2)));

constexpr int M = 16384, D = 1024, MC = 8192, NKEY = 17408, DFF = 2816;
constexpr int LDS_BYTES = 131072 + 512;
constexpr int NT = 512;
#ifndef DBG_FFN
#define DBG_FFN 1
#define DBG_WO 1
#define DBG_HYCONV 1
#endif
#ifndef MK_PER_PHASE
#define MK_PER_PHASE 0
#endif
#ifndef DUP_MASK
#define DUP_MASK 0u
#endif
#ifndef EXTRA_BAR
#define EXTRA_BAR 0
#endif
#ifndef DBG_MASK
#define DBG_MASK 0
#define DBG_GATEHALF 0
#endif

constexpr size_t WS_BAR = 0;
constexpr size_t WS_MOD = 16384;
constexpr size_t WS_ROPE = WS_MOD + 245760;
constexpr size_t WS_S0T = WS_ROPE + 262144;
constexpr size_t WS_HP = WS_S0T + 524288;
constexpr size_t WS_RG = WS_HP + 294912;
constexpr size_t RG_LAYER = 4718592;
constexpr size_t WS_W = WS_RG + 2 * RG_LAYER;
constexpr size_t W_PROJ = 0, W_GATE = W_PROJ + 5767168, W_O = W_GATE + 8388608, W_1 = W_O + 2097152, W_2 = W_1 + 11534336,
                 W_BOUT = W_2 + 5767168, W_UQ = W_BOUT + 2097152, W_UK = W_UQ + 262144, W_UV = W_UK + 131072, W_TOTAL = W_UV + 131072;
constexpr size_t WS_HB = WS_W + W_TOTAL;
constexpr size_t WS_YB = WS_HB + 33554432;
constexpr size_t WS_AR = WS_YB + 33554432;
constexpr size_t A_UHY = 0, A_UMLA = A_UHY + 25165824, A_UCONF = A_UMLA + 13631488, A_URET = A_UCONF + 16777216,
                 A_ZT = A_URET + 33554432, A_CQN = A_ZT + 25165824, A_CKN = A_CQN + 8388608, A_KR = A_CKN + 8912896,
                 A_RVT = A_KR + 1114112, A_END = A_RVT + 8388608;
constexpr size_t A_Q = 0, A_KN = A_Q + 12582912, A_VT = A_KN + 8912896;
constexpr size_t A_GT = 0, A_ACT = 0, A_HRAW = 0;
constexpr size_t WS_NEED = WS_AR + A_END;
static_assert(A_VT + 8912896 <= A_UCONF, "alias");
static_assert(WS_NEED <= 268435456ull, "ws");

struct Params { const float* in[39]; float* out; unsigned char* ws; int ph_lo, ph_hi; };

__device__ __forceinline__ unsigned cvt_pk_bf16(float lo, float hi) { unsigned r; asm("v_cvt_pk_bf16_f32 %0, %1, %2" : "=v"(r) : "v"(lo), "v"(hi)); return r; }
__device__ __forceinline__ bf16_t f2bf(float f) { return (bf16_t)(cvt_pk_bf16(f, 0.f) & 0xffffu); }
__device__ __forceinline__ float bf2f(bf16_t b) { return __uint_as_float(((unsigned)b) << 16); }
__device__ __forceinline__ float bflo(unsigned w) { return __uint_as_float(w << 16); }
__device__ __forceinline__ float bfhi(unsigned w) { return __uint_as_float(w & 0xffff0000u); }
__device__ __forceinline__ float sigmoidf_(float x) { return __builtin_amdgcn_rcpf(1.0f + __expf(-x)); }
__device__ __forceinline__ int lane_id_v() { int l; asm volatile("v_mbcnt_lo_u32_b32 %0, -1, 0\n\tv_mbcnt_hi_u32_b32 %0, -1, %0" : "=v"(l)); return l; }
__device__ __forceinline__ float shx(float v, int mask, int lane) { return __int_as_float(__builtin_amdgcn_ds_bpermute((lane ^ mask) << 2, __float_as_int(v))); }
__device__ __forceinline__ float wave_sum_l(float v, int lane) {
#pragma unroll
    for (int o = 32; o >= 1; o >>= 1) v += shx(v, o, lane);
    return v;
}
__device__ __forceinline__ int midx_of_row(int row) { return row < MC ? 0 : 1 + ((row - MC) >> 11); }

namespace pg8 {
constexpr int BM = 256, BK = 64, HALF = 128, HTB = HALF * BK * 2, STAGE_BYTES = 8 * HTB, NXCD = 8, WGM = 8;
__host__ __device__ __forceinline__ int lds_byte(int r, int c) { const int st = (r >> 4) * 2 + (c >> 5), rr = r & 15, cc = c & 31, ob = rr * 64 + cc * 2; return st * 1024 + (ob ^ (((ob >> 9) & 1) << 5)); }
__host__ __device__ __forceinline__ void stage_rc(int b, int& R, int& C) { const int st = b / 1024, sb = b % 1024, swz = sb ^ (((sb >> 9) & 1) << 5); R = (st >> 1) * 16 + swz / 64; C = (st & 1) * 32 + (swz % 64) / 2; }
__host__ __device__ __forceinline__ int perm32(int rho) { const int n = rho >> 4, i = rho & 15; return 8 * (i >> 2) + 4 * n + (i & 3); }
struct Unit { int pm, pn; };
struct Gemm { const bf16_t* A; const bf16_t* Bt; int M, N, K; };
struct StaticOrder {
    int nM, nN, nwg, G, c;
    __device__ void init(int M_, int N_, int G_, int c_) { nM = M_ / BM; nN = N_ / BM; nwg = nM * nN; G = G_; c = c_; }
    __device__ bool next(int i, Unit& u) const {
        const long L = (long)i * G + c; if (L >= nwg) return false;
        int wgid = (int)L; { const int q = nwg / NXCD, r = nwg % NXCD, xcd = wgid % NXCD, off = wgid / NXCD; wgid = (xcd < r ? xcd * (q + 1) : r * (q + 1) + (xcd - r) * q) + off; }
        const int nig = WGM * nN, gid = wgid / nig, fm = gid * WGM, gsz = (nM - fm) < WGM ? (nM - fm) : WGM;
        u.pm = fm + ((wgid % nig) % gsz); u.pn = (wgid % nig) / gsz; return true;
    }
};

template <class Epi>
__device__ __forceinline__ void gemm_phase(LAS unsigned char* lds, const Gemm g, const StaticOrder& S, const Epi& E, int wid_in) {
    int ln_ = lane_id_v(); int w_ = wid_in; asm volatile("" : "+s"(w_));
    const int wid = w_, lane = ln_, tid = wid * 64 + lane, wr = wid >> 2, wc = wid & 3, fr = lane & 15, fq = lane >> 4;
    const int K = g.K, nt = K / BK;
    unsigned voffA[2], voffB[2];
#pragma unroll
    for (int i = 0; i < 2; ++i) { int R, C; stage_rc(tid * 16 + i * 8192, R, C); const int Rb = Epi::PERM ? ((R & ~31) + perm32(R & 31)) : R;
        voffA[i] = (unsigned)(R * K + C) * 2u; voffB[i] = (unsigned)(Rb * K + C) * 2u; }
    const size_t kstep = (size_t)(BK * 2);
    const size_t hstep = (size_t)HALF * K * 2;
    const size_t tstep = 2 * hstep;
    const unsigned ldsw = (unsigned)wid * 1024u;
    const int aoff = lds_byte(wr * 64 + fr, fq * 8), boff = lds_byte(wc * 32 + fr, fq * 8);
#define PG8_SA(b, h) (((b) * 2 + (h)) * HTB)
#define PG8_SB(b, h) ((4 + (b) * 2 + (h)) * HTB)
#define PG8_STAGE(bufoff, gbase, voff) do { _Pragma("unroll") for (int _i = 0; _i < 2; ++_i) \
        __builtin_amdgcn_global_load_lds((const unsigned*)((const char*)(gbase) + (voff)[_i]), (LAS unsigned*)(lds + (bufoff) + ldsw + _i * 8192), 16, 0, 0); } while (0)
#define PG8_LDA(dst, b, h) do { _Pragma("unroll") for (int m = 0; m < 4; ++m) _Pragma("unroll") for (int k = 0; k < 2; ++k) dst[m][k] = *(const LAS bf16x8*)(lds + PG8_SA(b, h) + aoff + m * 2048 + k * 1024); } while (0)
#define PG8_LDB(dst, b, h) do { _Pragma("unroll") for (int n = 0; n < 2; ++n) _Pragma("unroll") for (int k = 0; k < 2; ++k) dst[n][k] = *(const LAS bf16x8*)(lds + PG8_SB(b, h) + boff + n * 2048 + k * 1024); } while (0)
#define PG8_MMA(ai, bj, At, Bt) do { __builtin_amdgcn_s_setprio(1); _Pragma("unroll") for (int m = 0; m < 4; ++m) _Pragma("unroll") for (int n = 0; n < 2; ++n) _Pragma("unroll") for (int k = 0; k < 2; ++k) \
        acc[ai][bj][m][n] = __builtin_amdgcn_mfma_f32_16x16x32_bf16(Bt[n][k], At[m][k], acc[ai][bj][m][n], 0, 0, 0); __builtin_amdgcn_s_setprio(0); } while (0)
#define PG8_WAIT_V(n) asm volatile("s_waitcnt vmcnt(" #n ")" ::: "memory")
#define PG8_WAIT_L(n) asm volatile("s_waitcnt lgkmcnt(" #n ")" ::: "memory")
#define PG8_BAR __builtin_amdgcn_s_barrier()
#define PG8_SCHED __builtin_amdgcn_sched_barrier(0)
    Unit cur, nxt; int ui = 0;
    if (!S.next(0, cur)) return;
    f32x4 acc[2][2][4][2];
#pragma unroll
    for (int a = 0; a < 2; ++a)
#pragma unroll
        for (int b = 0; b < 2; ++b)
#pragma unroll
            for (int m = 0; m < 4; ++m)
#pragma unroll
                for (int n = 0; n < 2; ++n) acc[a][b][m][n] = (f32x4){0.f, 0.f, 0.f, 0.f};
    bf16x8 At[4][2], B0[2][2], B1[2][2];
    const char* cA = (const char*)g.A + (size_t)cur.pm * tstep; const char* cB = (const char*)g.Bt + (size_t)cur.pn * tstep;
    PG8_STAGE(PG8_SB(0, 0), cB, voffB); PG8_STAGE(PG8_SA(0, 0), cA, voffA); PG8_STAGE(PG8_SB(0, 1), cB + hstep, voffB); PG8_STAGE(PG8_SA(0, 1), cA + hstep, voffA);
    if (wr == 1) PG8_BAR;
    PG8_WAIT_V(4); PG8_BAR;
    PG8_STAGE(PG8_SB(1, 0), cB + kstep, voffB); PG8_STAGE(PG8_SA(1, 0), cA + kstep, voffA); PG8_STAGE(PG8_SB(1, 1), cB + hstep + kstep, voffB);
    PG8_WAIT_V(6); PG8_BAR;
    for (;;) {
        const bool has_next = S.next(ui + 1, nxt);
        const char* nA = has_next ? (const char*)g.A + (size_t)nxt.pm * tstep : cA; const char* nB = has_next ? (const char*)g.Bt + (size_t)nxt.pn * tstep : cB;
        for (int t = 0; t < nt; t += 2) {
            const bool last = (t == nt - 2);
            const char* a1 = cA + (size_t)(t + 1) * kstep;
            const char* a2 = last ? nA : cA + (size_t)(t + 2) * kstep; const char* b2 = last ? nB : cB + (size_t)(t + 2) * kstep;
            const char* a3 = a2 + kstep; const char* b3 = b2 + kstep;
            PG8_LDB(B0, 0, 0); PG8_SCHED; PG8_LDA(At, 0, 0); PG8_STAGE(PG8_SA(1, 1), a1 + hstep, voffA);
            PG8_WAIT_L(8); PG8_BAR; PG8_WAIT_L(0); PG8_MMA(0, 0, At, B0); PG8_BAR; PG8_SCHED;
            PG8_LDB(B1, 0, 1); PG8_STAGE(PG8_SB(0, 0), b2, voffB);
            PG8_BAR; PG8_WAIT_L(0); PG8_MMA(0, 1, At, B1); PG8_BAR;
            PG8_LDA(At, 0, 1); PG8_STAGE(PG8_SA(0, 0), a2, voffA);
            PG8_BAR; PG8_WAIT_L(0); PG8_MMA(1, 0, At, B0); PG8_BAR; PG8_SCHED;
            PG8_STAGE(PG8_SB(0, 1), b2 + hstep, voffB);
            PG8_WAIT_V(6); PG8_BAR; PG8_MMA(1, 1, At, B1); PG8_BAR;
            PG8_LDB(B0, 1, 0); PG8_SCHED; PG8_LDA(At, 1, 0); PG8_STAGE(PG8_SA(0, 1), a2 + hstep, voffA);
            PG8_WAIT_L(8); PG8_BAR; PG8_WAIT_L(0); PG8_MMA(0, 0, At, B0); PG8_BAR; PG8_SCHED;
            PG8_LDB(B1, 1, 1); PG8_STAGE(PG8_SB(1, 0), b3, voffB);
            PG8_BAR; PG8_WAIT_L(0); PG8_MMA(0, 1, At, B1); PG8_BAR;
            PG8_LDA(At, 1, 1); PG8_STAGE(PG8_SA(1, 0), a3, voffA);
            PG8_BAR; PG8_WAIT_L(0); PG8_MMA(1, 0, At, B0); PG8_BAR; PG8_SCHED;
            PG8_STAGE(PG8_SB(1, 1), b3 + hstep, voffB);
            PG8_WAIT_V(6); PG8_BAR; PG8_MMA(1, 1, At, B1); PG8_BAR;
        }
        { const int ln2 = lane_id_v(); E(acc, cur, wr, wc, ln2 & 15, ln2 >> 4); }
        if (!has_next) break;
#pragma unroll
        for (int a = 0; a < 2; ++a)
#pragma unroll
            for (int b = 0; b < 2; ++b)
#pragma unroll
                for (int m = 0; m < 4; ++m)
#pragma unroll
                    for (int n = 0; n < 2; ++n) acc[a][b][m][n] = (f32x4){0.f, 0.f, 0.f, 0.f};
        cur = nxt; cA = nA; cB = nB; ++ui;
    }
    PG8_WAIT_V(0);
    if (wr == 0) PG8_BAR;
    PG8_BAR;
#undef PG8_SA
#undef PG8_SB
#undef PG8_STAGE
#undef PG8_LDA
#undef PG8_LDB
#undef PG8_MMA
#undef PG8_WAIT_V
#undef PG8_WAIT_L
#undef PG8_BAR
#undef PG8_SCHED
}

typedef f32x4 Acc[2][2][4][2];

struct EpiProj {
    static constexpr bool PERM = true;
    bf16_t *uhy, *umla, *uret, *uconf;
    __device__ __forceinline__ void operator()(const Acc& acc, const Unit& u, int wr, int wc, int fr, int fq) const {
        const int row0 = u.pm * BM + wr * 64 + fr;
#pragma unroll
        for (int bj = 0; bj < 2; ++bj) {
            const int c0 = u.pn * BM + bj * HALF + wc * 32 + 8 * fq;
            bf16_t* p; int pitch;
            if (c0 < 768) { p = uhy + c0; pitch = 768; }
            else if (c0 < 1184) { p = umla + (c0 - 768); pitch = 416; }
            else if (c0 < 2208) { p = uret + (c0 - 1184); pitch = 1024; }
            else if (c0 < 2720) { p = uconf + (c0 - 2208); pitch = 512; }
            else continue;
#pragma unroll
            for (int ai = 0; ai < 2; ++ai)
#pragma unroll
                for (int m = 0; m < 4; ++m) {
                    const f32x4 v0 = acc[ai][bj][m][0], v1 = acc[ai][bj][m][1];
                    u32x4 w; w.x = cvt_pk_bf16(v0[0], v0[1]); w.y = cvt_pk_bf16(v0[2], v0[3]); w.z = cvt_pk_bf16(v1[0], v1[1]); w.w = cvt_pk_bf16(v1[2], v1[3]);
                    *(u32x4*)(p + (size_t)(row0 + ai * HALF + m * 16) * pitch) = w;
                }
        }
    }
};
struct EpiGate {
    static constexpr bool PERM = true;
    unsigned char* O; int ldc;
    __device__ __forceinline__ void operator()(const Acc& acc, const Unit& u, int wr, int wc, int fr, int fq) const {
        const int row0 = u.pm * BM + wr * 64 + fr;
#pragma unroll
        for (int bj = 0; bj < 2; ++bj) {
            const int c0 = u.pn * BM + bj * HALF + wc * 32 + 8 * fq;
#pragma unroll
            for (int ai = 0; ai < 2; ++ai)
#pragma unroll
                for (int m = 0; m < 4; ++m) {
                    f32x4 v0 = acc[ai][bj][m][0], v1 = acc[ai][bj][m][1];
#pragma unroll
                    for (int j = 0; j < 4; ++j) { v0[j] = fminf(fmaxf(v0[j], -240.f), 240.f); v1[j] = fminf(fmaxf(v1[j], -240.f), 240.f); }
                    int w0 = 0, w1 = 0;
                    w0 = __builtin_amdgcn_cvt_pk_fp8_f32(v0[0], v0[1], w0, false); w0 = __builtin_amdgcn_cvt_pk_fp8_f32(v0[2], v0[3], w0, true);
                    w1 = __builtin_amdgcn_cvt_pk_fp8_f32(v1[0], v1[1], w1, false); w1 = __builtin_amdgcn_cvt_pk_fp8_f32(v1[2], v1[3], w1, true);
                    *(u32x2*)(O + (size_t)(row0 + ai * HALF + m * 16) * ldc + c0) = (u32x2){(unsigned)w0, (unsigned)w1};
                }
        }
    }
};
struct EpiPlain {
    static constexpr bool PERM = false;
    bf16_t* O; int ldc; int ncols;
    __device__ __forceinline__ void operator()(const Acc& acc, const Unit& u, int wr, int wc, int fr, int fq) const {
        const int row0 = u.pm * BM + wr * 64 + fr;
#pragma unroll
        for (int bj = 0; bj < 2; ++bj) {
            const int c0 = u.pn * BM + bj * HALF + wc * 32 + 4 * fq;
            if (c0 >= ncols) continue;
#pragma unroll
            for (int ai = 0; ai < 2; ++ai)
#pragma unroll
                for (int m = 0; m < 4; ++m) {
                    bf16_t* p = O + (size_t)(row0 + ai * HALF + m * 16) * ldc + c0;
#pragma unroll
                    for (int n = 0; n < 2; ++n) { const f32x4 v = acc[ai][bj][m][n]; u32x2 w; w.x = cvt_pk_bf16(v[0], v[1]); w.y = cvt_pk_bf16(v[2], v[3]); *(u32x2*)(p + 16 * n) = w; }
                }
        }
    }
};
struct EpiFfn1 {
    static constexpr bool PERM = true;
    bf16_t* O;
    __device__ __forceinline__ void operator()(const Acc& acc, const Unit& u, int wr, int wc, int fr, int fq) const {
        const int row0 = u.pm * BM + wr * 64 + fr;
#pragma unroll
        for (int bj = 0; bj < 2; ++bj) {
            const int c0 = (u.pn * BM + bj * HALF + wc * 32 + 8 * fq) >> 1;
#pragma unroll
            for (int ai = 0; ai < 2; ++ai)
#pragma unroll
                for (int m = 0; m < 4; ++m) {
                    const f32x4 a = acc[ai][bj][m][0], b = acc[ai][bj][m][1];
                    float o[4];
#pragma unroll
                    for (int j = 0; j < 4; ++j) o[j] = a[j] * sigmoidf_(a[j]) * b[j];
                    u32x2 w; w.x = cvt_pk_bf16(o[0], o[1]); w.y = cvt_pk_bf16(o[2], o[3]);
                    *(u32x2*)(O + (size_t)(row0 + ai * HALF + m * 16) * DFF + c0) = w;
                }
        }
    }
};
struct EpiResid {
    static constexpr bool PERM = false;
    bf16_t* X; const float* gmod;
    __device__ __forceinline__ void operator()(const Acc& acc, const Unit& u, int wr, int wc, int fr, int fq) const {
        const int row0 = u.pm * BM + wr * 64 + fr, col0 = u.pn * BM + wc * 32 + 4 * fq;
        const float* gp = gmod + (size_t)midx_of_row(u.pm * BM) * 6144;
        f32x4 gv[2][2];
#pragma unroll
        for (int bj = 0; bj < 2; ++bj)
#pragma unroll
            for (int n = 0; n < 2; ++n) gv[bj][n] = *(const f32x4*)(gp + col0 + bj * HALF + n * 16);
#pragma unroll
        for (int ai = 0; ai < 2; ++ai) {
            u32x2 xw[4][2][2];
#pragma unroll
            for (int m = 0; m < 4; ++m)
#pragma unroll
                for (int bj = 0; bj < 2; ++bj)
#pragma unroll
                    for (int n = 0; n < 2; ++n) xw[m][bj][n] = *(const u32x2*)(X + (size_t)(row0 + ai * HALF + m * 16) * D + col0 + bj * HALF + n * 16);
#pragma unroll
            for (int m = 0; m < 4; ++m)
#pragma unroll
                for (int bj = 0; bj < 2; ++bj)
#pragma unroll
                    for (int n = 0; n < 2; ++n) { const u32x2 w = xw[m][bj][n];
                        const f32x4 xv = (f32x4){bflo(w.x), bfhi(w.x), bflo(w.y), bfhi(w.y)} + gv[bj][n] * acc[ai][bj][m][n];
                        u32x2 o; o.x = cvt_pk_bf16(xv[0], xv[1]); o.y = cvt_pk_bf16(xv[2], xv[3]);
                        *(u32x2*)(X + (size_t)(row0 + ai * HALF + m * 16) * D + col0 + bj * HALF + n * 16) = o; }
        }
    }
};
}

struct Ctx {
    const LAS unsigned* tab; float* out; unsigned char* ws; LAS unsigned char* ldsL; unsigned char* lds; int tid, lane, wid, bid, G;
};
__device__ __forceinline__ const float* tab_ptr(const LAS unsigned* tab, int i) { unsigned lo = tab[2 * i], hi = tab[2 * i + 1]; lo = __builtin_amdgcn_readfirstlane(lo); hi = __builtin_amdgcn_readfirstlane(hi); return (const float*)(((unsigned long long)hi << 32) | lo); }
#define INF(i) tab_ptr(C.tab, (i))
__device__ __forceinline__ int launder_s(int v0) { int v = __builtin_amdgcn_readfirstlane(v0); asm volatile("" : "+s"(v)); return v; }
__device__ __forceinline__ int uni(int v) { return __builtin_amdgcn_readfirstlane(v); }
__device__ __forceinline__ Ctx launder(const Ctx& C0) { Ctx C = C0; int ln = lane_id_v(); int w = uni(C0.wid); asm volatile("" : "+s"(w)); C.lane = ln; C.wid = w; C.tid = w * 64 + ln;
    unsigned long long pw = (unsigned long long)C0.ws; unsigned plo = (unsigned)uni((int)(unsigned)pw), phi = (unsigned)uni((int)(unsigned)(pw >> 32)); asm volatile("" : "+s"(plo), "+s"(phi)); C.ws = (unsigned char*)(((unsigned long long)phi << 32) | plo);
    int b = uni(C0.bid), g = uni(C0.G); asm volatile("" : "+s"(b), "+s"(g)); C.bid = b; C.G = g;
    unsigned tb = (unsigned)uni((int)(unsigned)(unsigned long long)C0.tab); asm volatile("" : "+s"(tb)); C.tab = (const LAS unsigned*)(unsigned long long)tb; return C; }

__device__ __forceinline__ void p0_mod(const Ctx& C0) { const Ctx C = launder(C0); const float* in5 = INF(5); const float* in6 = INF(6); const float* in7 = INF(7); const float* in8 = INF(8);
    LAS float* scond = (LAS float*)C.ldsL;
    LAS float* part = scond + 5 * 1024;
    float* MOD = (float*)(C.ws + WS_MOD);
    bool have = false;
    for (int task = C.bid; task < 192; task += C.G) {
        if (!have) {
            for (int i = C.tid; i < 5 * 1024; i += NT) { const int m = i >> 10, k = i & 1023; const float x = (m == 0) ? in6[k] : in5[(m - 1) * 1024 + k]; scond[i] = x * sigmoidf_(x); }
            have = true; __syncthreads();
        }
        const int l = task / 96, j0 = (task % 96) * 64;
        const float* aw = in7 + (size_t)l * 1024 * 6144 + j0 + C.lane;
        float a[5] = {0.f, 0.f, 0.f, 0.f, 0.f};
        const int k0 = C.wid * 128;
#pragma unroll 8
        for (int k = 0; k < 128; ++k) { const float w = aw[(size_t)(k0 + k) * 6144];
#pragma unroll
            for (int m = 0; m < 5; ++m) a[m] += scond[m * 1024 + k0 + k] * w; }
#pragma unroll
        for (int m = 0; m < 5; ++m) part[(C.wid * 5 + m) * 64 + C.lane] = a[m];
        __syncthreads();
        if (C.tid < 320) { const int m = C.tid >> 6, j = C.tid & 63; float s = in8[l * 6144 + j0 + j];
#pragma unroll
            for (int w = 0; w < 8; ++w) s += part[(w * 5 + m) * 64 + j];
            MOD[((size_t)l * 5 + m) * 6144 + j0 + j] = s; }
        __syncthreads();
    }
    __syncthreads();
}

__device__ __forceinline__ void p0_filters(const Ctx& C0) { const Ctx C = launder(C0); const float* in13 = INF(13); const float* in14 = INF(14); const float* in15 = INF(15); const float* in16 = INF(16); const float* in17 = INF(17);
    LAS float* zs = (LAS float*)C.ldsL;
    LAS float* h1s = zs + 8 * 4 * 64;
    LAS float* h2s = h1s + 8 * 4 * 64;
    LAS float* red = h2s + 8 * 4 * 64;
    float* HR = (float*)(C.ws + WS_AR + A_HRAW);
    float* HP = (float*)(C.ws + WS_HP);
    for (int task = (C.bid + 64) % C.G; task < 144; task += C.G) {
        const int l = task / 72, ch = task % 72, Lsel = ch < 8 ? 0 : 1, chunk = Lsel ? ch - 8 : ch, L = Lsel ? 2048 : 256;
        const int tb = chunk * 32 + C.wid * 4;
        LAS float* zw = zs + C.wid * 256; LAS float* h1w = h1s + C.wid * 256; LAS float* h2w = h2s + C.wid * 256;
        if (C.lane < 33) {
#pragma unroll
            for (int tt = 0; tt < 4; ++tt) {
                const int t = tb + tt; const float w = (6.2831855f * (float)t) / (float)L;
                float z;
                if (C.lane == 0) z = (float)t / (float)(L - 1);
                else { const int bi = (C.lane - 1) & 15; const float f = 1e-4f + (float)bi * ((15.0f - 1e-4f) / 15.0f); const float a = f * w; z = (C.lane <= 16) ? cosf(a) : -sinf(a); }
                zw[tt * 64 + C.lane] = z;
            }
        }
        __builtin_amdgcn_wave_barrier();
        { float a[4]; const float b = in14[l * 64 + C.lane];
#pragma unroll
          for (int tt = 0; tt < 4; ++tt) a[tt] = b;
#pragma unroll 3
          for (int k = 0; k < 33; ++k) { const float w = in13[(l * 33 + k) * 64 + C.lane];
#pragma unroll
              for (int tt = 0; tt < 4; ++tt) a[tt] += zw[tt * 64 + k] * w; }
#pragma unroll
          for (int tt = 0; tt < 4; ++tt) h1w[tt * 64 + C.lane] = sinf(a[tt]); }
        __builtin_amdgcn_wave_barrier();
        { float a[4]; const float b = in16[l * 64 + C.lane];
#pragma unroll
          for (int tt = 0; tt < 4; ++tt) a[tt] = b;
#pragma unroll 4
          for (int k = 0; k < 64; ++k) { const float w = in15[(l * 64 + k) * 64 + C.lane];
#pragma unroll
              for (int tt = 0; tt < 4; ++tt) a[tt] += h1w[tt * 64 + k] * w; }
#pragma unroll
          for (int tt = 0; tt < 4; ++tt) h2w[tt * 64 + C.lane] = sinf(a[tt]); }
        __builtin_amdgcn_wave_barrier();
        const float* w3 = in17 + (size_t)l * 64 * 1024;
        float* hr = HR + ((size_t)l * 2304 + (Lsel ? 256 : 0)) * 1024;
#pragma unroll 1
        for (int q = 0; q < 8; ++q) {
            float psum = 0.f;
#pragma unroll 1
            for (int dir = 0; dir < 2; ++dir) {
                float a[4] = {0.f, 0.f, 0.f, 0.f};
                const int col = C.lane + 64 * ((q >> 2) * 8 + dir * 4 + (q & 3));
#pragma unroll 8
                for (int k = 0; k < 64; ++k) { const float w = w3[k * 1024 + col];
#pragma unroll
                    for (int tt = 0; tt < 4; ++tt) a[tt] += h2w[tt * 64 + k] * w; }
                const int c = col & 255;
                const float delta = fabsf(-3.0701134573f + (float)c * ((-15.3505672866f + 3.0701134573f) / 255.0f));
#pragma unroll
                for (int tt = 0; tt < 4; ++tt) {
                    const int t = tb + tt; const float tl = (float)t / (float)(L - 1);
                    const float v = a[tt] * __expf(-tl * delta);
                    hr[(size_t)t * 1024 + col] = v;
                    psum += fabsf(v);
                }
            }
            red[(C.wid * 8 + q) * 64 + C.lane] = psum;
        }
        __syncthreads();
        { const int o = C.tid >> 8, c = C.tid & 255, r4 = c >> 6, ln = c & 63; float s = 0.f;
#pragma unroll
          for (int w = 0; w < 8; ++w) s += red[(w * 8 + o * 4 + r4) * 64 + ln];
          HP[((size_t)l * 72 + ch) * 512 + C.tid] = s; }
        __syncthreads();
    }
    __syncthreads();
}

__device__ __forceinline__ void p0_misc(const Ctx& C0) { const Ctx C = launder(C0); const float* in4 = INF(4);
    float* rope = (float*)(C.ws + WS_ROPE);
    const int gt = C.bid * NT + C.tid, gs = C.G * NT;
    for (int i = gt; i < 32768; i += gs) {
        const int t = i >> 4, k = i & 15; const int pos = (k < 8) ? (t >> 6) : (t & 63);
        const float inv = powf(10000.0f, -(float)(k & 7) / 8.0f);
        const float a = (float)pos * inv;
        rope[i] = cosf(a); rope[32768 + i] = sinf(a);
    }
    bf16_t* s0t = (bf16_t*)(C.ws + WS_S0T);
    for (int i = gt; i < 64 * 4096; i += gs) { const int mat = i >> 12, dv = (i >> 6) & 63, dk = i & 63; s0t[i] = f2bf(in4[mat * 4096 + dk * 64 + dv]); }
}

__device__ __forceinline__ void conv_tile(const float* src, int ld, int kvalid, int k0, int colsrc  , bf16_t* dstrow  , float scale) {
    float vv[64];
    const int cs = colsrc < 0 ? 0 : colsrc;
#pragma unroll
    for (int j = 0; j < 64; ++j) { const int k = k0 + j, kc = k < kvalid ? k : kvalid - 1; vv[j] = src[(size_t)kc * ld + cs]; }
    unsigned w[32];
#pragma unroll
    for (int j = 0; j < 32; ++j) {
        const float a = (colsrc >= 0 && k0 + 2 * j < kvalid) ? vv[2 * j] : 0.f, b = (colsrc >= 0 && k0 + 2 * j + 1 < kvalid) ? vv[2 * j + 1] : 0.f;
        w[j] = cvt_pk_bf16(a * scale, b * scale);
    }
#pragma unroll
    for (int j = 0; j < 8; ++j) { u32x4 v; v.x = w[4 * j]; v.y = w[4 * j + 1]; v.z = w[4 * j + 2]; v.w = w[4 * j + 3]; *(u32x4*)(dstrow + 8 * j) = v; }
}
__device__ __forceinline__ void convert_weights(const Ctx& C0, int l0) { const int l = launder_s(l0); const Ctx C = launder(C0);
    unsigned char* W = C.ws + WS_W;
    constexpr int T0 = 704, T1 = T0 + 1024, T2 = T1 + 256, T3 = T2 + 1408, T4 = T3 + 704, T5 = T4 + 256, T6 = T5 + 32, T7 = T6 + 16, T8 = T7 + 16;
    for (int t = C.bid * 8 + C.wid; t < T8; t += C.G * 8) {
        const float* src; int ld, kvalid, k0, col; bf16_t* dst; float scale = 1.0f;
        if (t < T0) { const int nt = t % 44, kt = t / 44, n = nt * 64 + C.lane; src = INF(10) + (size_t)l * 1024 * 2720; ld = 2720; kvalid = 1024; k0 = kt * 64; col = n < 2720 ? n : -1; dst = (bf16_t*)(W + W_PROJ) + (size_t)n * 1024 + k0; }
        else if (t < T1) { const int u = t - T0, nt = u % 64, kt = u / 64, n = nt * 64 + C.lane; src = INF(32) + (size_t)l * 1024 * 4096; ld = 4096; kvalid = 1024; k0 = kt * 64; col = n; dst = (bf16_t*)(W + W_GATE) + (size_t)n * 1024 + k0; }
        else if (t < T2) { const int u = t - T1, nt = u % 16, kt = u / 16, n = nt * 64 + C.lane; src = INF(34) + (size_t)l * 1024 * 1024; ld = 1024; kvalid = 1024; k0 = kt * 64; col = n; dst = (bf16_t*)(W + W_O) + (size_t)n * 1024 + k0; }
        else if (t < T3) { const int u = t - T2, nt = u % 88, kt = u / 88, n = nt * 64 + C.lane; src = INF(36) + (size_t)l * 1024 * 5632; ld = 5632; kvalid = 1024; k0 = kt * 64;
            const int g = n >> 3, e = n & 7; col = (e < 4) ? 4 * g + e : 2816 + 4 * g + (e - 4); dst = (bf16_t*)(W + W_1) + (size_t)n * 1024 + k0; }
        else if (t < T4) { const int u = t - T3, nt = u % 16, kt = u / 16, n = nt * 64 + C.lane; src = INF(37) + (size_t)l * 2816 * 1024; ld = 1024; kvalid = 2816; k0 = kt * 64; col = n; dst = (bf16_t*)(W + W_2) + (size_t)n * 2816 + k0; }
        else if (t < T5) { const int u = t - T4, br = u / 64, v = u % 64, nt = v / 4, kt = v % 4, n = nt * 64 + C.lane; const int ii = (br == 0) ? 19 : (br == 1) ? 24 : (br == 2) ? 26 : 31;
            src = INF(ii) + (size_t)l * 256 * 1024; ld = 1024; kvalid = 256; k0 = kt * 64; col = n; dst = (bf16_t*)(W + W_BOUT) + ((size_t)br * 1024 + n) * 256 + k0; }
        else if (t < T6) { const int u = t - T5, nt = u / 4, kt = u % 4, n = nt * 64 + C.lane; src = INF(21) + (size_t)l * 256 * 384; ld = 384; kvalid = 256; k0 = kt * 64; col = n < 384 ? n : -1; dst = (bf16_t*)(W + W_UQ) + (size_t)n * 256 + k0; scale = 0.10206207261596577f * 1.4426950408889634f; }
        else if (t < T7) { const int u = t - T6, nt = u / 4, kt = u % 4, n = nt * 64 + C.lane; src = INF(23) + (size_t)l * 128 * 512; ld = 512; kvalid = 128; k0 = kt * 64; col = (n >> 6) * 128 + (n & 63); dst = (bf16_t*)(W + W_UK) + (size_t)n * 256 + k0; }
        else { const int u = t - T7, nt = u / 4, kt = u % 4, n = nt * 64 + C.lane; src = INF(23) + (size_t)l * 128 * 512; ld = 512; kvalid = 128; k0 = kt * 64; col = (n >> 6) * 128 + 64 + (n & 63); dst = (bf16_t*)(W + W_UV) + (size_t)n * 256 + k0; }
        conv_tile(src, ld, kvalid, k0, col, dst, scale);
    }
}

__device__ __forceinline__ bf16_t* rg_ptr(unsigned char* ws, int l, int p, int o, int c) {
    return (bf16_t*)(ws + WS_RG + (size_t)l * RG_LAYER) + (p ? (size_t)2 * 256 * 512 : 0) + (size_t)(o * 256 + c) * (p ? 4096 : 512);
}
__device__ __forceinline__ void build_rg(const Ctx& C0) { const Ctx C = launder(C0);
    LAS float* tile = (LAS float*)C.ldsL;
    LAS float* invn = tile + 64 * 65;
    const float* HR = (const float*)(C.ws + WS_AR + A_HRAW);
    const float* HP = (const float*)(C.ws + WS_HP);
    for (int task = C.bid; task < 1152; task += C.G) {
        const int l = task / 576, u = task % 576;
        int p, o, cg, mc;
        if (u < 64) { p = 0; o = u / 32; cg = (u / 8) % 4; mc = u % 8; } else { const int v = u - 64; p = 1; o = v / 256; cg = (v / 64) % 4; mc = v % 64; }
        const int L = p ? 2048 : 256, nch = p ? 64 : 8, chb = p ? 8 : 0, c0 = cg * 64, m0 = mc * 64;
        {
          const int cch_ = C.tid & 63, part = C.tid >> 6; float hv[8];
#pragma unroll
          for (int q = 0; q < 8; ++q) { const int k = part + 8 * q; hv[q] = (k < nch) ? HP[((size_t)l * 72 + chb + k) * 512 + o * 256 + c0 + cch_] : 0.f; }
          invn[part * 64 + cch_] = ((hv[0] + hv[1]) + (hv[2] + hv[3])) + ((hv[4] + hv[5]) + (hv[6] + hv[7])); }
        const float* hr = HR + ((size_t)l * 2304 + (p ? 256 : 0)) * 1024;
#pragma unroll
        for (int jj = 0; jj < 8; ++jj) {
            const int j = C.wid * 8 + jj, m = m0 + j, n = L - m;
            float v = 0.f;
            if (m != 0) { const int t = n >= 0 ? n : -n, dir = n >= 0 ? 0 : 1; v = hr[(size_t)t * 1024 + o * 512 + dir * 256 + c0 + C.lane]; }
            tile[j * 65 + C.lane] = v;
        }
        __syncthreads();
        { const int cc = C.tid >> 3, jg = C.tid & 7;
          float sn = 0.f;
#pragma unroll
          for (int q = 0; q < 8; ++q) sn += invn[q * 64 + cc];
          const float s = 1.0f / sn;
          u32x4 w; float f[8];
#pragma unroll
          for (int e = 0; e < 8; ++e) f[e] = tile[(jg * 8 + e) * 65 + cc] * s;
          w.x = cvt_pk_bf16(f[0], f[1]); w.y = cvt_pk_bf16(f[2], f[3]); w.z = cvt_pk_bf16(f[4], f[5]); w.w = cvt_pk_bf16(f[6], f[7]);
          *(u32x4*)(rg_ptr(C.ws, l, p, o, c0 + cc) + m0 + jg * 8) = w; }
        __syncthreads();
    }
}

__device__ __forceinline__ void norm_phase(const Ctx& C0, int l0, int which) { const int l = launder_s(l0); const Ctx C = launder(C0); const float* in0 = INF(0); const float* in1 = INF(1); const float* in9 = INF(9); const float* in35 = INF(35);
    bf16_t* X = (bf16_t*)(C.ws + WS_HB);
    bf16_t* Hb = (bf16_t*)C.out;
    const float* MOD = (const float*)(C.ws + WS_MOD) + (size_t)l * 5 * 6144;
    const float* g = (which == 0 ? in9 : in35) + l * 1024;
    const int shoff = which == 0 ? 0 : 3072, scoff = shoff + 1024;
    const bool first = (which == 0 && l == 0);
    f32x4 gg[4];
#pragma unroll
    for (int i = 0; i < 4; ++i) gg[i] = *(const f32x4*)(g + i * 256 + C.lane * 4);
    for (int rp = C.bid * 8 + C.wid; rp < M / 2; rp += C.G * 8) {
        f32x4 v[2][4]; float ss[2] = {0.f, 0.f};
#pragma unroll
        for (int q = 0; q < 2; ++q) { const int row = rp + q * (M / 2);
            if (first) { const float* src = row < MC ? in0 + (size_t)row * D : in1 + (size_t)(row - MC) * D;
#pragma unroll
                for (int i = 0; i < 4; ++i) v[q][i] = *(const f32x4*)(src + i * 256 + C.lane * 4);
            } else { const bf16_t* src = X + (size_t)row * D;
#pragma unroll
                for (int i = 0; i < 4; ++i) { const u32x2 w = *(const u32x2*)(src + i * 256 + C.lane * 4); v[q][i] = (f32x4){bflo(w.x), bfhi(w.x), bflo(w.y), bfhi(w.y)}; } } }
#pragma unroll
        for (int q = 0; q < 2; ++q)
#pragma unroll
            for (int i = 0; i < 4; ++i) ss[q] += v[q][i][0] * v[q][i][0] + v[q][i][1] * v[q][i][1] + v[q][i][2] * v[q][i][2] + v[q][i][3] * v[q][i][3];
#pragma unroll
        for (int o = 32; o >= 1; o >>= 1) { const float t0 = shx(ss[0], o, C.lane), t1 = shx(ss[1], o, C.lane); ss[0] += t0; ss[1] += t1; }
#pragma unroll
        for (int q = 0; q < 2; ++q) { const int row = rp + q * (M / 2);
            const float rstd = rsqrtf(ss[q] * (1.0f / 1024.0f) + 1e-6f);
            const float* mp = MOD + (size_t)midx_of_row(row) * 6144;
#pragma unroll
            for (int i = 0; i < 4; ++i) {
                const int c = i * 256 + C.lane * 4;
                if (first) { u32x2 xw; xw.x = cvt_pk_bf16(v[q][i][0], v[q][i][1]); xw.y = cvt_pk_bf16(v[q][i][2], v[q][i][3]); *(u32x2*)(X + (size_t)row * D + c) = xw; }
                const f32x4 sh = *(const f32x4*)(mp + shoff + c), sc = *(const f32x4*)(mp + scoff + c);
                const f32x4 y = (v[q][i] * rstd * gg[i]) * (sc + 1.0f) + sh;
                u32x2 w; w.x = cvt_pk_bf16(y[0], y[1]); w.y = cvt_pk_bf16(y[2], y[3]);
                *(u32x2*)(Hb + (size_t)row * D + c) = w;
            } }
    }
}
__device__ __forceinline__ void final_norm(const Ctx& C0) { const Ctx C = launder(C0); const float* in38 = INF(38);
    const bf16_t* X = (const bf16_t*)(C.ws + WS_HB); float* Y = C.out; const float* g = in38;
    for (int row = C.bid * 8 + C.wid; row < M; row += C.G * 8) {
        const bf16_t* src = X + (size_t)row * D;
        f32x4 v[4]; float ss = 0.f;
#pragma unroll
        for (int i = 0; i < 4; ++i) { const u32x2 w = *(const u32x2*)(src + i * 256 + C.lane * 4); v[i] = (f32x4){bflo(w.x), bfhi(w.x), bflo(w.y), bfhi(w.y)}; ss += v[i][0] * v[i][0] + v[i][1] * v[i][1] + v[i][2] * v[i][2] + v[i][3] * v[i][3]; }
        ss = wave_sum_l(ss, C.lane);
        const float rstd = rsqrtf(ss * (1.0f / 1024.0f) + 1e-6f);
#pragma unroll
        for (int i = 0; i < 4; ++i) { const int c = i * 256 + C.lane * 4; *(f32x4*)(Y + (size_t)row * D + c) = v[i] * rstd * *(const f32x4*)(g + c); }
    }
}

__device__ __forceinline__ void prep_phase(const Ctx& C0, int l0) { const int l = launder_s(l0); const Ctx C = launder(C0); const float* in2 = INF(2); const float* in3 = INF(3); const float* in11 = INF(11); const float* in12 = INF(12); const float* in20 = INF(20); const float* in22 = INF(22); const float* in27 = INF(27); const float* in28 = INF(28); const float* in29 = INF(29); const float* in30 = INF(30);
    unsigned char* AR = C.ws + WS_AR;
    const bf16_t* UHY = (const bf16_t*)(AR + A_UHY); const bf16_t* UMLA = (const bf16_t*)(AR + A_UMLA);
    const bf16_t* UCONF = (const bf16_t*)(AR + A_UCONF); const bf16_t* URET = (const bf16_t*)(AR + A_URET);
    bf16_t* ZT = (bf16_t*)(AR + A_ZT); bf16_t* CQN = (bf16_t*)(AR + A_CQN); bf16_t* CKN = (bf16_t*)(AR + A_CKN);
    bf16_t* KR = (bf16_t*)(AR + A_KR); bf16_t* RVT = (bf16_t*)(AR + A_RVT);
    bf16_t* YCONF = (bf16_t*)((unsigned char*)C.out + 33554432) + (size_t)3 * M * 256;
    const float* rope = (const float*)(C.ws + WS_ROPE);
    float* out = C.out;
    for (int ti = C.bid; ti < M / 64; ti += C.G) {
        const int r0 = ti * 64; const bool lat = r0 >= MC;
        const int L = lat ? 2048 : 256, sb = lat ? MC + ((r0 - MC) >> 11) * 2048 : (r0 >> 8) * 256, t0 = r0 - sb, b = lat ? (r0 - MC) >> 11 : r0 >> 8;
        {
            bf16_t* us = (bf16_t*)C.lds;
#pragma unroll 4
            for (int q = C.tid; q < 66 * 96; q += NT) { const int rr = q / 96, cc = q % 96; const int t = t0 + rr - 1;
                u32x4 v = (u32x4){0u, 0u, 0u, 0u}; if (t >= 0 && t < L) v = *(const u32x4*)(UHY + (size_t)(sb + t) * 768 + cc * 8);
                *(u32x4*)(us + rr * 768 + cc * 8) = v; }
            __syncthreads();
            const float* cw = in11 + l * 3 * 768; const float* cb = in12 + l * 768;
            for (int it = C.tid; it < 768 * 8; it += NT) { const int ch = it % 768, tg = it / 768;
                const float w0 = cw[ch], w1 = cw[768 + ch], w2 = cw[1536 + ch], bb = cb[ch];
                float u[10];
#pragma unroll
                for (int e = 0; e < 10; ++e) u[e] = bf2f(us[(tg * 8 + e) * 768 + ch]);
                float z[8];
#pragma unroll
                for (int e = 0; e < 8; ++e) z[e] = w0 * u[e] + w1 * u[e + 1] + w2 * u[e + 2] + bb;
                u32x4 w; w.x = cvt_pk_bf16(z[0], z[1]); w.y = cvt_pk_bf16(z[2], z[3]); w.z = cvt_pk_bf16(z[4], z[5]); w.w = cvt_pk_bf16(z[6], z[7]);
                *(u32x4*)(ZT + ((size_t)(lat ? 768 : 0) + ch) * 8192 + (r0 - (lat ? MC : 0)) + tg * 8) = w; }
            __syncthreads();
        }
        {
            const int rw0 = r0 + C.wid * 8;
            u32x2 cqv[8]; unsigned ckw[8]; float krx[8], rcs[8], rsn[8];
#pragma unroll
            for (int tt = 0; tt < 8; ++tt) { const bf16_t* um = UMLA + (size_t)(rw0 + tt) * 416;
                cqv[tt] = *(const u32x2*)(um + C.lane * 4); ckw[tt] = *(const unsigned*)(um + 256 + C.lane * 2); krx[tt] = bf2f(um[384 + (C.lane & 31)]);
                rcs[tt] = 1.f; rsn[tt] = 0.f;
                if (lat) { const int t = rw0 + tt - sb; rcs[tt] = rope[t * 16 + (C.lane & 15)]; rsn[tt] = rope[32768 + t * 16 + (C.lane & 15)]; } }
            const f32x4 gq = *(const f32x4*)(in20 + l * 256 + C.lane * 4); const f32x2 gk = *(const f32x2*)(in22 + l * 128 + C.lane * 2);
            float s1[8], s2[8], oth[8];
#pragma unroll
            for (int tt = 0; tt < 8; ++tt) { const float x0 = bflo(cqv[tt].x), x1 = bfhi(cqv[tt].x), x2 = bflo(cqv[tt].y), x3 = bfhi(cqv[tt].y), k0 = bflo(ckw[tt]), k1 = bfhi(ckw[tt]);
                s1[tt] = x0 * x0 + x1 * x1 + x2 * x2 + x3 * x3; s2[tt] = k0 * k0 + k1 * k1; oth[tt] = shx(krx[tt], 16, C.lane); }
#pragma unroll
            for (int o = 32; o >= 1; o >>= 1) {
                float t1[8], t2[8];
#pragma unroll
                for (int tt = 0; tt < 8; ++tt) { t1[tt] = shx(s1[tt], o, C.lane); t2[tt] = shx(s2[tt], o, C.lane); }
#pragma unroll
                for (int tt = 0; tt < 8; ++tt) { s1[tt] += t1[tt]; s2[tt] += t2[tt]; }
            }
#pragma unroll
            for (int tt = 0; tt < 8; ++tt) {
                const int row = rw0 + tt, t = row - sb; const size_t keyrow = lat ? (size_t)MC + b * 2304 + t : (size_t)row;
                { const float x0 = bflo(cqv[tt].x), x1 = bfhi(cqv[tt].x), x2 = bflo(cqv[tt].y), x3 = bfhi(cqv[tt].y); const float rs = rsqrtf(s1[tt] * (1.0f / 256.0f) + 1e-6f);
                  u32x2 o; o.x = cvt_pk_bf16(x0 * rs * gq[0], x1 * rs * gq[1]); o.y = cvt_pk_bf16(x2 * rs * gq[2], x3 * rs * gq[3]);
                  *(u32x2*)(CQN + (size_t)row * 256 + C.lane * 4) = o; }
                { const float x0 = bflo(ckw[tt]), x1 = bfhi(ckw[tt]); const float rs = rsqrtf(s2[tt] * (1.0f / 128.0f) + 1e-6f);
                  const float y0 = x0 * rs * gk[0], y1 = x1 * rs * gk[1];
                  *(unsigned*)(CKN + keyrow * 256 + C.lane * 2) = cvt_pk_bf16(y0, y1);
                  *(unsigned*)(CKN + keyrow * 256 + 128 + C.lane * 2) = 0u;
                  if (!lat) *(f32x2*)(out + 16777216 + (((size_t)b * 2 + l) * 256 + t) * 128 + C.lane * 2) = (f32x2){y0, y1}; }
                { const float x = krx[tt]; float y = x;
                  if (lat) y = (C.lane & 16) ? (oth[tt] * rsn[tt] + x * rcs[tt]) : (x * rcs[tt] - oth[tt] * rsn[tt]);
                  if (C.lane < 32) { KR[keyrow * 32 + C.lane] = f2bf(y); if (!lat) out[18874368 + (((size_t)b * 2 + l) * 256 + t) * 32 + C.lane] = x; } }
            }
        }
        {
            bf16_t* vs = (bf16_t*)C.lds;
#pragma unroll 4
            for (int q = C.tid; q < 64 * 32; q += NT) { const int rr = q >> 5, cc = q & 31; *(u32x4*)(vs + rr * 264 + cc * 8) = *(const u32x4*)(URET + (size_t)(r0 + rr) * 1024 + 512 + cc * 8); }
            __syncthreads();
            for (int it = C.tid; it < 256 * 8; it += NT) { const int col = it & 255, tg = it >> 8; unsigned short e[8];
#pragma unroll
                for (int k = 0; k < 8; ++k) e[k] = vs[(tg * 8 + k) * 264 + col];
                u32x4 w; w.x = e[0] | ((unsigned)e[1] << 16); w.y = e[2] | ((unsigned)e[3] << 16); w.z = e[4] | ((unsigned)e[5] << 16); w.w = e[6] | ((unsigned)e[7] << 16);
                *(u32x4*)(RVT + (size_t)col * M + r0 + tg * 8) = w; }
            __syncthreads();
        }
        {
            bf16_t* zb = (bf16_t*)C.lds;
            float* cbuf = (float*)(C.lds + 94 * 256 * 2);
#pragma unroll 4
            for (int q = C.tid; q < 94 * 64; q += NT) { const int rr = q >> 6, cc = q & 63; const int t = t0 + rr - 15;
                u32x2 o = (u32x2){0u, 0u};
                if (t >= 0 && t < L) { const bf16_t* up = UCONF + (size_t)(sb + t) * 512 + cc * 4; const u32x2 a = *(const u32x2*)up, g = *(const u32x2*)(up + 256);
                    o.x = cvt_pk_bf16(bflo(a.x) * sigmoidf_(bflo(g.x)), bfhi(a.x) * sigmoidf_(bfhi(g.x))); o.y = cvt_pk_bf16(bflo(a.y) * sigmoidf_(bflo(g.y)), bfhi(a.y) * sigmoidf_(bfhi(g.y))); }
                *(u32x2*)(zb + rr * 256 + cc * 4) = o; }
            __syncthreads();
            { const int c = C.tid & 255, th = C.tid >> 8; const float* dw = in27 + (size_t)l * 31 * 256 + c; const float bb = in28[l * 256 + c];
              float a[32];
#pragma unroll
              for (int i = 0; i < 32; ++i) a[i] = bb;
              for (int j = 0; j < 31; ++j) { const float w = dw[j * 256];
#pragma unroll
                  for (int i = 0; i < 32; ++i) a[i] += w * bf2f(zb[(th * 32 + i + j) * 256 + c]); }
#pragma unroll
              for (int i = 0; i < 32; ++i) cbuf[(th * 32 + i) * 256 + c] = a[i]; }
            __syncthreads();
            for (int tt = 0; tt < 8; ++tt) { const int tr = C.wid * 8 + tt; const f32x4 v = *(const f32x4*)(cbuf + tr * 256 + C.lane * 4);
                const float mu = wave_sum_l(v[0] + v[1] + v[2] + v[3], C.lane) * (1.0f / 256.0f);
                const f32x4 d = v - mu; const float var = wave_sum_l(d[0] * d[0] + d[1] * d[1] + d[2] * d[2] + d[3] * d[3], C.lane) * (1.0f / 256.0f);
                const float rs = rsqrtf(var + 1e-6f);
                const f32x4 g = *(const f32x4*)(in29 + l * 256 + C.lane * 4), be = *(const f32x4*)(in30 + l * 256 + C.lane * 4);
                f32x4 y = d * rs * g + be;
#pragma unroll
                for (int j = 0; j < 4; ++j) y[j] = y[j] * sigmoidf_(y[j]);
                u32x2 w; w.x = cvt_pk_bf16(y[0], y[1]); w.y = cvt_pk_bf16(y[2], y[3]);
                *(u32x2*)(YCONF + (size_t)(r0 + tr) * 256 + C.lane * 4) = w; }
            __syncthreads();
        }
    }
    for (int r = C.bid * 8 + C.wid; r < 1024; r += C.G * 8) { const int b = r >> 8, j = r & 255; const size_t keyrow = (size_t)MC + b * 2304 + 2048 + j;
        const f32x2 v = *(const f32x2*)(in2 + (((size_t)b * 2 + l) * 256 + j) * 128 + C.lane * 2);
        *(unsigned*)(CKN + keyrow * 256 + C.lane * 2) = cvt_pk_bf16(v[0], v[1]); *(unsigned*)(CKN + keyrow * 256 + 128 + C.lane * 2) = 0u;
        if (C.lane < 32) KR[keyrow * 32 + C.lane] = f2bf(in3[(((size_t)b * 2 + l) * 256 + j) * 32 + C.lane]); }
}

__device__ __forceinline__ void hyena_phase(const Ctx& C0, int l0) { const int l = launder_s(l0); const Ctx C = launder(C0); const float* in18 = INF(18);
    const bf16_t* ZT = (const bf16_t*)(C.ws + WS_AR + A_ZT);
    bf16_t* YHY = (bf16_t*)((unsigned char*)C.out + 33554432);
    LAS unsigned char* vS = C.ldsL;
    LAS unsigned char* R0 = C.ldsL + 20480;
    LAS unsigned char* R1 = R0 + 8256;
    const int n = C.lane & 31, hf = C.lane >> 5;
    const int Bk = 32 * C.wid + n;
    for (int item = C.bid; item < 256; item += C.G) {
      u32x4 pd; unsigned pe;
#define HY_RLOAD(P_, O_) do { const bf16_t* rg_ = rg_ptr(C.ws, l, (P_), (O_), item); const int nch_ = ((P_) ? 4096 : 512) >> 3; pd = (u32x4){0u, 0u, 0u, 0u}; pe = 0u; \
          if (C.tid < nch_) { pd = *(const u32x4*)(rg_ + C.tid * 8); if (C.tid + 1 < nch_) pe = *(const unsigned*)(rg_ + C.tid * 8 + 8); } } while (0)
      HY_RLOAD(1, 0);
      for (int s = 0; s < 4; ++s) {
        const int p = 1 - (s >> 1), o = s & 1, c = item;
        const int L = p ? 2048 : 256, Lb = L >> 5, L2 = 2 * L;
        const bf16_t* zv = ZT + ((size_t)p * 768 + c) * 8192;
        const bf16_t* zx1 = zv + (size_t)256 * 8192; const bf16_t* zx2 = zv + (size_t)512 * 8192;
        if (o == 0) {
            __syncthreads();
            for (int q = C.tid; q < 1024; q += NT) *(LAS u32x4*)(vS + (q >> 2) * 80 + (q & 3) * 16) = *(const u32x4*)(zv + q * 8);
        }
        {
            if (C.tid <= (L2 >> 3)) {
                *(LAS u32x4*)(R0 + C.tid * 16) = pd;
                u32x4 sft; sft.x = (pd.x >> 16) | (pd.y << 16); sft.y = (pd.y >> 16) | (pd.z << 16); sft.z = (pd.z >> 16) | (pd.w << 16); sft.w = (pd.w >> 16) | (pe << 16);
                *(LAS u32x4*)(R1 + C.tid * 16) = sft;
            }
            __syncthreads();
            if (s < 3) HY_RLOAD(1 - ((s + 1) >> 1), (s + 1) & 1);
            f32x16 acc;
#pragma unroll
            for (int r = 0; r < 16; ++r) acc[r] = 0.f;
            const LAS unsigned* Rc = (const LAS unsigned*)((n & 1) ? R1 : R0);
            const int T = Bk & (Lb - 1);
            const int Tlo = (32 * C.wid) & (Lb - 1), Thi = Lb >= 32 ? Tlo + 31 : Lb - 1, Tl0 = Lb >= 32 ? Tlo : 0;
            const int dlo = Tl0 - (Lb - 1), dhi = Thi;
            for (int d = dlo; d <= dhi; ++d) {
                const int s0 = L - 32 * d - n + 8 * hf, dw = s0 >> 1;
                u32x4 a0, a1;
                a0.x = Rc[dw]; a0.y = Rc[dw + 1]; a0.z = Rc[dw + 2]; a0.w = Rc[dw + 3];
                a1.x = Rc[dw + 8]; a1.y = Rc[dw + 9]; a1.z = Rc[dw + 10]; a1.w = Rc[dw + 11];
                const int Ts = T - d;
                const bool valid = (Ts >= 0) && (Ts < Lb);
                const int sblk = valid ? (Bk - d) : 0;
                u32x4 b0 = *(const LAS u32x4*)(vS + sblk * 80 + hf * 16), b1 = *(const LAS u32x4*)(vS + sblk * 80 + 32 + hf * 16);
                if (!valid) { b0 = (u32x4){0u, 0u, 0u, 0u}; b1 = b0; }
                acc = __builtin_amdgcn_mfma_f32_32x32x16_bf16(__builtin_bit_cast(bf16x8, a0), __builtin_bit_cast(bf16x8, b0), acc, 0, 0, 0);
                acc = __builtin_amdgcn_mfma_f32_32x32x16_bf16(__builtin_bit_cast(bf16x8, a1), __builtin_bit_cast(bf16x8, b1), acc, 0, 0, 0);
            }
            __syncthreads();
            const float bias = in18[((size_t)l * 2 + o) * 256 + c];
            const bf16_t* zg = o == 0 ? zx1 : zx2;
#pragma unroll
            for (int g4 = 0; g4 < 4; ++g4) {
                const int i0 = 8 * g4 + 4 * hf; const int tf = 32 * Bk + i0;
                LAS u32x2* vp = (LAS u32x2*)(vS + Bk * 80 + i0 * 2);
                const u32x2 vv = *vp; const u32x2 gg = *(const u32x2*)(zg + tf);
                const float y0 = (acc[4 * g4 + 0] + bias * bflo(vv.x)) * bflo(gg.x), y1 = (acc[4 * g4 + 1] + bias * bfhi(vv.x)) * bfhi(gg.x);
                const float y2 = (acc[4 * g4 + 2] + bias * bflo(vv.y)) * bflo(gg.y), y3 = (acc[4 * g4 + 3] + bias * bfhi(vv.y)) * bfhi(gg.y);
                if (o == 0) { u32x2 w; w.x = cvt_pk_bf16(y0, y1); w.y = cvt_pk_bf16(y2, y3); *vp = w; }
                else { bf16_t* yp = YHY + (size_t)((p ? MC : 0) + tf) * 256 + c; yp[0] = f2bf(y0); yp[256] = f2bf(y1); yp[512] = f2bf(y2); yp[768] = f2bf(y3); }
            }
            __syncthreads();
        }
      }
    }
#undef HY_RLOAD
    __syncthreads();
}

__device__ void mla_item(const Ctx& C0, int item, bool lat) { const Ctx C = launder(C0);
    const unsigned char* AR = C.ws + WS_AR;
    const bf16_t* Q = (const bf16_t*)(AR + A_Q); const bf16_t* KN = (const bf16_t*)(AR + A_KN); const bf16_t* KR = (const bf16_t*)(AR + A_KR); const bf16_t* VT = (const bf16_t*)(AR + A_VT);
    bf16_t* Y = (bf16_t*)((unsigned char*)C.out + 33554432) + (size_t)1 * M * 256;
    int b, h, qt; if (lat) { b = item >> 8; h = (item >> 6) & 3; qt = item & 63; } else { b = item >> 5; h = (item >> 3) & 3; qt = item & 7; }
    const int row0 = (lat ? MC + b * 2048 : b * 256) + qt * 32, key0 = lat ? MC + b * 2304 : b * 256, nk = lat ? 2304 : 256;
    const int n = C.lane & 31, hf = C.lane >> 5;
    bf16x8 qf[6];
#pragma unroll
    for (int ks = 0; ks < 6; ++ks) qf[ks] = *(const bf16x8*)(Q + (size_t)(row0 + n) * 384 + h * 96 + ks * 16 + hf * 8);
    if (lat) {
        const float* rope = (const float*)(C.ws + WS_ROPE); const int t = qt * 32 + n;
        const f32x4 c0 = *(const f32x4*)(rope + t * 16 + hf * 8), c1 = *(const f32x4*)(rope + t * 16 + hf * 8 + 4);
        const f32x4 s0 = *(const f32x4*)(rope + 32768 + t * 16 + hf * 8), s1 = *(const f32x4*)(rope + 32768 + t * 16 + hf * 8 + 4);
        bf16x8 a = qf[4], bq = qf[5]; float o1v[8], o2v[8];
#pragma unroll
        for (int j = 0; j < 8; ++j) { const float x1 = bf2f((bf16_t)a[j]), x2 = bf2f((bf16_t)bq[j]); const float cs = j < 4 ? c0[j & 3] : c1[j & 3], sn = j < 4 ? s0[j & 3] : s1[j & 3];
            o1v[j] = x1 * cs - x2 * sn; o2v[j] = x1 * sn + x2 * cs; }
        u32x4 wa, wb; wa.x = cvt_pk_bf16(o1v[0], o1v[1]); wa.y = cvt_pk_bf16(o1v[2], o1v[3]); wa.z = cvt_pk_bf16(o1v[4], o1v[5]); wa.w = cvt_pk_bf16(o1v[6], o1v[7]);
        wb.x = cvt_pk_bf16(o2v[0], o2v[1]); wb.y = cvt_pk_bf16(o2v[2], o2v[3]); wb.z = cvt_pk_bf16(o2v[4], o2v[5]); wb.w = cvt_pk_bf16(o2v[6], o2v[7]);
        qf[4] = __builtin_bit_cast(bf16x8, wa); qf[5] = __builtin_bit_cast(bf16x8, wb);
    }
    float mrun = -1e30f, lrun = 0.f; f32x16 o0, o1;
#pragma unroll
    for (int r = 0; r < 16; ++r) { o0[r] = 0.f; o1[r] = 0.f; }
    const bf16_t* vt0 = VT + (size_t)(h * 64 + n) * NKEY + key0 + 4 * hf; const bf16_t* vt1 = vt0 + (size_t)32 * NKEY;
    for (int kt = 0; kt < nk; kt += 32) {
        const size_t key = (size_t)key0 + kt + n;
        bf16x8 kf[6];
#pragma unroll
        for (int ks = 0; ks < 4; ++ks) kf[ks] = *(const bf16x8*)(KN + key * 256 + h * 64 + ks * 16 + hf * 8);
        kf[4] = *(const bf16x8*)(KR + key * 32 + hf * 8); kf[5] = *(const bf16x8*)(KR + key * 32 + 16 + hf * 8);
        bf16x4 va[2][2][2];
#pragma unroll
        for (int s2 = 0; s2 < 2; ++s2) { va[0][s2][0] = *(const bf16x4*)(vt0 + kt + 16 * s2); va[0][s2][1] = *(const bf16x4*)(vt0 + kt + 16 * s2 + 8);
                                         va[1][s2][0] = *(const bf16x4*)(vt1 + kt + 16 * s2); va[1][s2][1] = *(const bf16x4*)(vt1 + kt + 16 * s2 + 8); }
        f32x16 s;
#pragma unroll
        for (int r = 0; r < 16; ++r) s[r] = 0.f;
#pragma unroll
        for (int ks = 0; ks < 6; ++ks) s = __builtin_amdgcn_mfma_f32_32x32x16_bf16(kf[ks], qf[ks], s, 0, 0, 0);
        float mx = s[0];
#pragma unroll
        for (int r = 1; r < 16; ++r) mx = fmaxf(mx, s[r]);
        mx = fmaxf(mx, shx(mx, 32, C.lane));
        const float mnew = fmaxf(mrun, mx), alpha = exp2f(mrun - mnew); mrun = mnew;
        float ls = 0.f;
#pragma unroll
        for (int r = 0; r < 16; ++r) { s[r] = exp2f(s[r] - mnew); ls += s[r]; }
        lrun = lrun * alpha + ls;
#pragma unroll
        for (int r = 0; r < 16; ++r) { o0[r] *= alpha; o1[r] *= alpha; }
#pragma unroll
        for (int s2 = 0; s2 < 2; ++s2) {
            u32x4 pw; pw.x = cvt_pk_bf16(s[8 * s2], s[8 * s2 + 1]); pw.y = cvt_pk_bf16(s[8 * s2 + 2], s[8 * s2 + 3]); pw.z = cvt_pk_bf16(s[8 * s2 + 4], s[8 * s2 + 5]); pw.w = cvt_pk_bf16(s[8 * s2 + 6], s[8 * s2 + 7]);
            const bf16x8 pf = __builtin_bit_cast(bf16x8, pw);
            const bf16x8 v0 = __builtin_shufflevector(va[0][s2][0], va[0][s2][1], 0, 1, 2, 3, 4, 5, 6, 7), v1 = __builtin_shufflevector(va[1][s2][0], va[1][s2][1], 0, 1, 2, 3, 4, 5, 6, 7);
            o0 = __builtin_amdgcn_mfma_f32_32x32x16_bf16(v0, pf, o0, 0, 0, 0);
            o1 = __builtin_amdgcn_mfma_f32_32x32x16_bf16(v1, pf, o1, 0, 0, 0);
        }
    }
    lrun += shx(lrun, 32, C.lane);
    const float inv = 1.0f / lrun;
    bf16_t* yp = Y + (size_t)(row0 + n) * 256 + h * 64 + 4 * hf;
#pragma unroll
    for (int g4 = 0; g4 < 4; ++g4) {
        u32x2 w0, w1; w0.x = cvt_pk_bf16(o0[4 * g4] * inv, o0[4 * g4 + 1] * inv); w0.y = cvt_pk_bf16(o0[4 * g4 + 2] * inv, o0[4 * g4 + 3] * inv);
        w1.x = cvt_pk_bf16(o1[4 * g4] * inv, o1[4 * g4 + 1] * inv); w1.y = cvt_pk_bf16(o1[4 * g4 + 2] * inv, o1[4 * g4 + 3] * inv);
        *(u32x2*)(yp + 8 * g4) = w0; *(u32x2*)(yp + 32 + 8 * g4) = w1;
    }
}

__device__ __forceinline__ float log2_sigmoid(float x) { return -log1pf(__expf(-x)) * 1.4426950408889634f; }
__device__ void ret_item(const Ctx& C0, int l0, int item, bool lat) { const int l = launder_s(l0); const Ctx C = launder(C0); const float* in25 = INF(25);
    const unsigned char* AR = C.ws + WS_AR;
    const bf16_t* URET = (const bf16_t*)(AR + A_URET); const bf16_t* RVT = (const bf16_t*)(AR + A_RVT);
    const bf16_t* S0T = (const bf16_t*)(C.ws + WS_S0T);
    bf16_t* Y = (bf16_t*)((unsigned char*)C.out + 33554432) + (size_t)2 * M * 256;
    int b, h, qt; if (lat) { b = item >> 8; h = (item >> 6) & 3; qt = item & 63; } else { b = item >> 5; h = (item >> 3) & 3; qt = item & 7; }
    const int L = lat ? 2048 : 256, sb = lat ? MC + b * 2048 : b * 256, row0 = sb + qt * 32;
    const int n = C.lane & 31, hf = C.lane >> 5;
    const float lgf = log2_sigmoid(in25[(l * 2 + 0) * 4 + h]), lgb = log2_sigmoid(in25[(l * 2 + 1) * 4 + h]);
    bf16x8 qf[4];
#pragma unroll
    for (int ks = 0; ks < 4; ++ks) qf[ks] = *(const bf16x8*)(URET + (size_t)(row0 + n) * 1024 + h * 64 + ks * 16 + hf * 8);
    f32x16 o0, o1;
#pragma unroll
    for (int r = 0; r < 16; ++r) { o0[r] = 0.f; o1[r] = 0.f; }
    const int tq = qt * 32 + n;
    const bf16_t* vt0 = RVT + (size_t)(h * 64 + n) * M + sb + 4 * hf; const bf16_t* vt1 = vt0 + (size_t)32 * M;
    for (int kt = 0; kt < L; kt += 32) {
        bf16x8 kf[4];
#pragma unroll
        for (int ks = 0; ks < 4; ++ks) kf[ks] = *(const bf16x8*)(URET + (size_t)(sb + kt + n) * 1024 + 256 + h * 64 + ks * 16 + hf * 8);
        bf16x4 va[2][2][2];
#pragma unroll
        for (int s2 = 0; s2 < 2; ++s2) { va[0][s2][0] = *(const bf16x4*)(vt0 + kt + 16 * s2); va[0][s2][1] = *(const bf16x4*)(vt0 + kt + 16 * s2 + 8);
                                         va[1][s2][0] = *(const bf16x4*)(vt1 + kt + 16 * s2); va[1][s2][1] = *(const bf16x4*)(vt1 + kt + 16 * s2 + 8); }
        f32x16 s;
#pragma unroll
        for (int r = 0; r < 16; ++r) s[r] = 0.f;
#pragma unroll
        for (int ks = 0; ks < 4; ++ks) s = __builtin_amdgcn_mfma_f32_32x32x16_bf16(kf[ks], qf[ks], s, 0, 0, 0);
#pragma unroll
        for (int r = 0; r < 16; ++r) { const int sp = kt + 8 * (r >> 2) + 4 * hf + (r & 3); const int dd = tq - sp;
            const float w = dd > 0 ? exp2f(lgf * (float)dd) : (dd < 0 ? exp2f(lgb * (float)(-dd)) : 2.0f);
            s[r] = s[r] * w * 0.125f; }
#pragma unroll
        for (int s2 = 0; s2 < 2; ++s2) {
            u32x4 pw; pw.x = cvt_pk_bf16(s[8 * s2], s[8 * s2 + 1]); pw.y = cvt_pk_bf16(s[8 * s2 + 2], s[8 * s2 + 3]); pw.z = cvt_pk_bf16(s[8 * s2 + 4], s[8 * s2 + 5]); pw.w = cvt_pk_bf16(s[8 * s2 + 6], s[8 * s2 + 7]);
            const bf16x8 pf = __builtin_bit_cast(bf16x8, pw);
            const bf16x8 v0 = __builtin_shufflevector(va[0][s2][0], va[0][s2][1], 0, 1, 2, 3, 4, 5, 6, 7), v1 = __builtin_shufflevector(va[1][s2][0], va[1][s2][1], 0, 1, 2, 3, 4, 5, 6, 7);
            o0 = __builtin_amdgcn_mfma_f32_32x32x16_bf16(v0, pf, o0, 0, 0, 0);
            o1 = __builtin_amdgcn_mfma_f32_32x32x16_bf16(v1, pf, o1, 0, 0, 0);
        }
    }
    if (lat) {
#pragma unroll
        for (int dir = 0; dir < 2; ++dir) {
            const bf16_t* st = S0T + ((((size_t)b * 2 + l) * 2 + dir) * 4 + h) * 4096;
            f32x16 a0, a1;
#pragma unroll
            for (int r = 0; r < 16; ++r) { a0[r] = 0.f; a1[r] = 0.f; }
#pragma unroll
            for (int ks = 0; ks < 4; ++ks) {
                const bf16x8 s0 = *(const bf16x8*)(st + (size_t)n * 64 + ks * 16 + hf * 8), s1 = *(const bf16x8*)(st + (size_t)(32 + n) * 64 + ks * 16 + hf * 8);
                a0 = __builtin_amdgcn_mfma_f32_32x32x16_bf16(s0, qf[ks], a0, 0, 0, 0);
                a1 = __builtin_amdgcn_mfma_f32_32x32x16_bf16(s1, qf[ks], a1, 0, 0, 0);
            }
            const float w = dir == 0 ? exp2f(lgf * (float)(tq + 1)) : exp2f(lgb * (float)(L - tq));
#pragma unroll
            for (int r = 0; r < 16; ++r) { o0[r] += w * a0[r]; o1[r] += w * a1[r]; }
        }
    }
    float sm = 0.f;
#pragma unroll
    for (int r = 0; r < 16; ++r) sm += o0[r] + o1[r];
    sm += shx(sm, 32, C.lane);
    const float mu = sm * (1.0f / 64.0f);
    float vr = 0.f;
#pragma unroll
    for (int r = 0; r < 16; ++r) { const float d0 = o0[r] - mu, d1 = o1[r] - mu; vr += d0 * d0 + d1 * d1; }
    vr += shx(vr, 32, C.lane);
    const float rs = rsqrtf(vr * (1.0f / 64.0f) + 1e-6f);
    const bf16_t* gp = URET + (size_t)(row0 + n) * 1024 + 768 + h * 64 + 4 * hf;
    bf16_t* yp = Y + (size_t)(row0 + n) * 256 + h * 64 + 4 * hf;
#pragma unroll
    for (int g4 = 0; g4 < 4; ++g4) {
        const u32x2 ga = *(const u32x2*)(gp + 8 * g4), gb = *(const u32x2*)(gp + 32 + 8 * g4);
        const float g0[4] = {bflo(ga.x), bfhi(ga.x), bflo(ga.y), bfhi(ga.y)}, g1[4] = {bflo(gb.x), bfhi(gb.x), bflo(gb.y), bfhi(gb.y)};
        float y0[4], y1[4];
#pragma unroll
        for (int j = 0; j < 4; ++j) { y0[j] = (o0[4 * g4 + j] - mu) * rs * (g0[j] * sigmoidf_(g0[j])); y1[j] = (o1[4 * g4 + j] - mu) * rs * (g1[j] * sigmoidf_(g1[j])); }
        u32x2 w0, w1; w0.x = cvt_pk_bf16(y0[0], y0[1]); w0.y = cvt_pk_bf16(y0[2], y0[3]); w1.x = cvt_pk_bf16(y1[0], y1[1]); w1.y = cvt_pk_bf16(y1[2], y1[3]);
        *(u32x2*)(yp + 8 * g4) = w0; *(u32x2*)(yp + 32 + 8 * g4) = w1;
    }
}


template <bool IS_RET>
__device__ __forceinline__ void att_block(const Ctx& C0, int l0, bool lat, int b, int h, int qblk) { const int l = launder_s(l0); const Ctx C = launder(C0);
    const unsigned char* AR = C.ws + WS_AR;
    const bf16_t* Q = (const bf16_t*)(AR + A_Q); const bf16_t* KN = (const bf16_t*)(AR + A_KN); const bf16_t* KR = (const bf16_t*)(AR + A_KR); const bf16_t* VT = (const bf16_t*)(AR + A_VT);
    const bf16_t* URET = (const bf16_t*)(AR + A_URET); const bf16_t* RVT = (const bf16_t*)(AR + A_RVT);
    constexpr int KP = 208, VP = 264, KBYTES = 128 * KP, SBYTES = KBYTES + 64 * VP;
    const int L = lat ? 2048 : 256, sb = lat ? MC + b * 2048 : b * 256;
    const int row0 = sb + qblk * 256 + C.wid * 32;
    const int key0 = IS_RET ? sb : (lat ? MC + b * 2304 : b * 256), nk = IS_RET ? L : (lat ? 2304 : 256);
    const int n = C.lane & 31, hf = C.lane >> 5;
    constexpr int NKS = IS_RET ? 4 : 6;
    bf16x8 qf[NKS];
    if (IS_RET) {
#pragma unroll
        for (int ks = 0; ks < 4; ++ks) qf[ks] = *(const bf16x8*)(URET + (size_t)(row0 + n) * 1024 + h * 64 + ks * 16 + hf * 8);
    } else {
#pragma unroll
        for (int ks = 0; ks < NKS; ++ks) qf[ks] = *(const bf16x8*)(Q + (size_t)(row0 + n) * 384 + h * 96 + ks * 16 + hf * 8);
        if (lat) {
            const float* rope = (const float*)(C.ws + WS_ROPE); const int t = row0 - sb + n;
            const f32x4 c0 = *(const f32x4*)(rope + t * 16 + hf * 8), c1 = *(const f32x4*)(rope + t * 16 + hf * 8 + 4);
            const f32x4 s0 = *(const f32x4*)(rope + 32768 + t * 16 + hf * 8), s1 = *(const f32x4*)(rope + 32768 + t * 16 + hf * 8 + 4);
            bf16x8 a = qf[NKS - 2], bq = qf[NKS - 1]; float o1v[8], o2v[8];
#pragma unroll
            for (int j = 0; j < 8; ++j) { const float x1 = bf2f((bf16_t)a[j]), x2 = bf2f((bf16_t)bq[j]); const float cs = j < 4 ? c0[j & 3] : c1[j & 3], sn = j < 4 ? s0[j & 3] : s1[j & 3];
                o1v[j] = x1 * cs - x2 * sn; o2v[j] = x1 * sn + x2 * cs; }
            u32x4 wa, wb; wa.x = cvt_pk_bf16(o1v[0], o1v[1]); wa.y = cvt_pk_bf16(o1v[2], o1v[3]); wa.z = cvt_pk_bf16(o1v[4], o1v[5]); wa.w = cvt_pk_bf16(o1v[6], o1v[7]);
            wb.x = cvt_pk_bf16(o2v[0], o2v[1]); wb.y = cvt_pk_bf16(o2v[2], o2v[3]); wb.z = cvt_pk_bf16(o2v[4], o2v[5]); wb.w = cvt_pk_bf16(o2v[6], o2v[7]);
            qf[NKS - 2] = __builtin_bit_cast(bf16x8, wa); qf[NKS - 1] = __builtin_bit_cast(bf16x8, wb);
        }
    }
    float lgf = 0.f, lgb = 0.f;
    if (IS_RET) { const float* in25 = INF(25); lgf = log2_sigmoid(in25[(l * 2 + 0) * 4 + h]); lgb = log2_sigmoid(in25[(l * 2 + 1) * 4 + h]); }
    const int tq = row0 - sb + n;
    const int q0w = qblk * 256 + C.wid * 32;
    float mrun = -1e30f, lrun = 0.f; f32x16 o0, o1;
#pragma unroll
    for (int r = 0; r < 16; ++r) { o0[r] = 0.f; o1[r] = 0.f; }
    const int skey = C.tid >> 3, sch = C.tid & 7, rkey = C.tid >> 2, rch = C.tid & 3;
    u32x4 gk0, gk1, gr, gv0, gv1;
#define ATT_GLOAD(kt) do { \
        if (IS_RET) { \
            gk0 = *(const u32x4*)(URET + (size_t)(sb + (kt) + skey) * 1024 + 256 + h * 64 + sch * 8); gk1 = *(const u32x4*)(URET + (size_t)(sb + (kt) + skey + 64) * 1024 + 256 + h * 64 + sch * 8); \
            gv0 = *(const u32x4*)(RVT + (size_t)(h * 64 + skey) * M + sb + (kt) + sch * 8); gv1 = *(const u32x4*)(RVT + (size_t)(h * 64 + skey) * M + sb + (kt) + (sch + 8) * 8); \
        } else { \
            gk0 = *(const u32x4*)(KN + (size_t)(key0 + (kt) + skey) * 256 + h * 64 + sch * 8); gk1 = *(const u32x4*)(KN + (size_t)(key0 + (kt) + skey + 64) * 256 + h * 64 + sch * 8); \
            gv0 = *(const u32x4*)(VT + (size_t)(h * 64 + skey) * NKEY + key0 + (kt) + sch * 8); gv1 = *(const u32x4*)(VT + (size_t)(h * 64 + skey) * NKEY + key0 + (kt) + (sch + 8) * 8); \
            gr = *(const u32x4*)(KR + (size_t)(key0 + (kt) + rkey) * 32 + rch * 8); \
        } } while (0)
#define ATT_LSTORE(buf) do { \
        LAS unsigned char* kb_ = C.ldsL + (buf) * SBYTES; LAS unsigned char* vb_ = kb_ + KBYTES; \
        *(LAS u32x4*)(kb_ + skey * KP + sch * 16) = gk0; *(LAS u32x4*)(kb_ + (skey + 64) * KP + sch * 16) = gk1; \
        *(LAS u32x2*)(vb_ + skey * VP + sch * 16) = (u32x2){gv0.x, gv0.y}; *(LAS u32x2*)(vb_ + skey * VP + sch * 16 + 8) = (u32x2){gv0.z, gv0.w}; \
        *(LAS u32x2*)(vb_ + skey * VP + (sch + 8) * 16) = (u32x2){gv1.x, gv1.y}; *(LAS u32x2*)(vb_ + skey * VP + (sch + 8) * 16 + 8) = (u32x2){gv1.z, gv1.w}; \
        if (!IS_RET) *(LAS u32x4*)(kb_ + rkey * KP + 128 + rch * 16) = gr; } while (0)
    __syncthreads();
    ATT_GLOAD(0); ATT_LSTORE(0);
    __syncthreads();
    const int nst = nk >> 7;
    for (int st = 0; st < nst; ++st) {
        if (st + 1 < nst) ATT_GLOAD((st + 1) * 128);
        const LAS unsigned char* kb = C.ldsL + (st & 1) * SBYTES; const LAS unsigned char* vb = kb + KBYTES;
#pragma unroll
        for (int sub = 0; sub < 4; ++sub) {
            f32x16 s;
#pragma unroll
            for (int r = 0; r < 16; ++r) s[r] = 0.f;
#pragma unroll
            for (int ks = 0; ks < NKS; ++ks) { const bf16x8 kf = *(const LAS bf16x8*)(kb + (sub * 32 + n) * KP + ks * 32 + hf * 16); s = __builtin_amdgcn_mfma_f32_32x32x16_bf16(kf, qf[ks], s, 0, 0, 0); }
            if (IS_RET) {
                const int kt = st * 128 + sub * 32;
                if (kt < q0w) {
                    const float base = lgf * (float)(tq - kt - 4 * hf) - 3.0f;
#pragma unroll
                    for (int r = 0; r < 16; ++r) s[r] = s[r] * __builtin_amdgcn_exp2f(fmaxf(base - lgf * (float)(8 * (r >> 2) + (r & 3)), -126.0f));
                } else if (kt > q0w) {
                    const float base = lgb * (float)(kt + 4 * hf - tq) - 3.0f;
#pragma unroll
                    for (int r = 0; r < 16; ++r) s[r] = s[r] * __builtin_amdgcn_exp2f(fmaxf(base + lgb * (float)(8 * (r >> 2) + (r & 3)), -126.0f));
                } else {
#pragma unroll
                    for (int r = 0; r < 16; ++r) { const int sp = kt + 8 * (r >> 2) + 4 * hf + (r & 3); const int dd = tq - sp;
                        const float w = dd > 0 ? exp2f(lgf * (float)dd) : (dd < 0 ? exp2f(lgb * (float)(-dd)) : 2.0f);
                        s[r] = s[r] * w * 0.125f; }
                }
            } else {
                float mx = s[0];
#pragma unroll
                for (int r = 1; r < 16; ++r) mx = fmaxf(mx, s[r]);
                mx = fmaxf(mx, shx(mx, 32, C.lane));
                const float mnew = fmaxf(mrun, mx);
                if (__ballot(mnew > mrun) != 0ull) {
                    const float alpha = __builtin_amdgcn_exp2f(fmaxf(mrun - mnew, -126.0f)); mrun = mnew; lrun *= alpha;
#pragma unroll
                    for (int r = 0; r < 16; ++r) { o0[r] *= alpha; o1[r] *= alpha; }
                }
                float ls = 0.f;
#pragma unroll
                for (int r = 0; r < 16; ++r) { s[r] = __builtin_amdgcn_exp2f(fmaxf(s[r] - mrun, -126.0f)); ls += s[r]; }
                lrun += ls;
            }
#pragma unroll
            for (int s2 = 0; s2 < 2; ++s2) {
                u32x4 pw; pw.x = cvt_pk_bf16(s[8 * s2], s[8 * s2 + 1]); pw.y = cvt_pk_bf16(s[8 * s2 + 2], s[8 * s2 + 3]); pw.z = cvt_pk_bf16(s[8 * s2 + 4], s[8 * s2 + 5]); pw.w = cvt_pk_bf16(s[8 * s2 + 6], s[8 * s2 + 7]);
                const bf16x8 pf = __builtin_bit_cast(bf16x8, pw);
                const LAS unsigned char* v0p = vb + n * VP + (sub * 32 + 16 * s2 + 4 * hf) * 2; const LAS unsigned char* v1p = v0p + 32 * VP;
                const u32x2 a0 = *(const LAS u32x2*)v0p, a1 = *(const LAS u32x2*)(v0p + 16), b0 = *(const LAS u32x2*)v1p, b1 = *(const LAS u32x2*)(v1p + 16);
                const u32x4 va = (u32x4){a0.x, a0.y, a1.x, a1.y}, vbv = (u32x4){b0.x, b0.y, b1.x, b1.y};
                o0 = __builtin_amdgcn_mfma_f32_32x32x16_bf16(__builtin_bit_cast(bf16x8, va), pf, o0, 0, 0, 0);
                o1 = __builtin_amdgcn_mfma_f32_32x32x16_bf16(__builtin_bit_cast(bf16x8, vbv), pf, o1, 0, 0, 0);
            }
        }
        if (st + 1 < nst) ATT_LSTORE((st + 1) & 1);
        __syncthreads();
    }
    if (!IS_RET) {
        bf16_t* Y = (bf16_t*)((unsigned char*)C.out + 33554432) + (size_t)1 * M * 256;
        lrun += shx(lrun, 32, C.lane);
        const float inv = 1.0f / lrun;
        bf16_t* yp = Y + (size_t)(row0 + n) * 256 + h * 64 + 4 * hf;
#pragma unroll
        for (int g4 = 0; g4 < 4; ++g4) {
            u32x2 w0, w1; w0.x = cvt_pk_bf16(o0[4 * g4] * inv, o0[4 * g4 + 1] * inv); w0.y = cvt_pk_bf16(o0[4 * g4 + 2] * inv, o0[4 * g4 + 3] * inv);
            w1.x = cvt_pk_bf16(o1[4 * g4] * inv, o1[4 * g4 + 1] * inv); w1.y = cvt_pk_bf16(o1[4 * g4 + 2] * inv, o1[4 * g4 + 3] * inv);
            *(u32x2*)(yp + 8 * g4) = w0; *(u32x2*)(yp + 32 + 8 * g4) = w1;
        }
    } else {
        bf16_t* Y = (bf16_t*)((unsigned char*)C.out + 33554432) + (size_t)2 * M * 256;
        if (lat) {
            const bf16_t* S0T = (const bf16_t*)(C.ws + WS_S0T);
#pragma unroll
            for (int dir = 0; dir < 2; ++dir) {
                const bf16_t* stp = S0T + ((((size_t)b * 2 + l) * 2 + dir) * 4 + h) * 4096;
                f32x16 a0, a1;
#pragma unroll
                for (int r = 0; r < 16; ++r) { a0[r] = 0.f; a1[r] = 0.f; }
#pragma unroll
                for (int ks = 0; ks < 4; ++ks) {
                    const bf16x8 s0 = *(const bf16x8*)(stp + (size_t)n * 64 + ks * 16 + hf * 8), s1 = *(const bf16x8*)(stp + (size_t)(32 + n) * 64 + ks * 16 + hf * 8);
                    a0 = __builtin_amdgcn_mfma_f32_32x32x16_bf16(s0, qf[ks], a0, 0, 0, 0);
                    a1 = __builtin_amdgcn_mfma_f32_32x32x16_bf16(s1, qf[ks], a1, 0, 0, 0);
                }
                const float w = dir == 0 ? exp2f(lgf * (float)(tq + 1)) : exp2f(lgb * (float)(L - tq));
#pragma unroll
                for (int r = 0; r < 16; ++r) { o0[r] += w * a0[r]; o1[r] += w * a1[r]; }
            }
        }
        float sm = 0.f;
#pragma unroll
        for (int r = 0; r < 16; ++r) sm += o0[r] + o1[r];
        sm += shx(sm, 32, C.lane);
        const float mu = sm * (1.0f / 64.0f);
        float vr = 0.f;
#pragma unroll
        for (int r = 0; r < 16; ++r) { const float d0 = o0[r] - mu, d1 = o1[r] - mu; vr += d0 * d0 + d1 * d1; }
        vr += shx(vr, 32, C.lane);
        const float rs = rsqrtf(vr * (1.0f / 64.0f) + 1e-6f);
        const bf16_t* gp = URET + (size_t)(row0 + n) * 1024 + 768 + h * 64 + 4 * hf;
        bf16_t* yp = Y + (size_t)(row0 + n) * 256 + h * 64 + 4 * hf;
#pragma unroll
        for (int g4 = 0; g4 < 4; ++g4) {
            const u32x2 ga = *(const u32x2*)(gp + 8 * g4), gb = *(const u32x2*)(gp + 32 + 8 * g4);
            const float g0[4] = {bflo(ga.x), bfhi(ga.x), bflo(ga.y), bfhi(ga.y)}, g1[4] = {bflo(gb.x), bfhi(gb.x), bflo(gb.y), bfhi(gb.y)};
            float y0[4], y1[4];
#pragma unroll
            for (int j = 0; j < 4; ++j) { y0[j] = (o0[4 * g4 + j] - mu) * rs * (g0[j] * sigmoidf_(g0[j])); y1[j] = (o1[4 * g4 + j] - mu) * rs * (g1[j] * sigmoidf_(g1[j])); }
            u32x2 w0, w1; w0.x = cvt_pk_bf16(y0[0], y0[1]); w0.y = cvt_pk_bf16(y0[2], y0[3]); w1.x = cvt_pk_bf16(y1[0], y1[1]); w1.y = cvt_pk_bf16(y1[2], y1[3]);
            *(u32x2*)(yp + 8 * g4) = w0; *(u32x2*)(yp + 32 + 8 * g4) = w1;
        }
    }
    __syncthreads();
}

__device__ __forceinline__ void ret_state(const Ctx& C0, int l0) { const int l = launder_s(l0); const Ctx C = launder(C0); const float* in25 = INF(25);
    const bf16_t* URET = (const bf16_t*)(C.ws + WS_AR + A_URET);
    float* out = C.out + 19398656;
    LAS unsigned char* ksm = C.ldsL; LAS unsigned char* vsm = C.ldsL + 256 * 144;
    for (int item = C.bid; item < 256; item += C.G) {
        const int b = item >> 3, h = (item >> 1) & 3, dir = item & 1;
        const float lg = log2_sigmoid(in25[(l * 2 + dir) * 4 + h]);
        __syncthreads();
#pragma unroll
        for (int j = 0; j < 4; ++j) { const int row = (C.tid >> 3) + 64 * j, ch = C.tid & 7; const bf16_t* rp = URET + (size_t)(b * 256 + row) * 1024 + h * 64 + ch * 8;
            *(LAS u32x4*)(ksm + row * 144 + ch * 16) = *(const u32x4*)(rp + 256); *(LAS u32x4*)(vsm + row * 144 + ch * 16) = *(const u32x4*)(rp + 512); }
        __syncthreads();
        const int dk = C.tid >> 3, dv8 = C.tid & 7;
        float a[8];
#pragma unroll
        for (int j = 0; j < 8; ++j) a[j] = 0.f;
#pragma unroll 4
        for (int s = 0; s < 256; ++s) {
            const float w = exp2f(lg * (float)(dir == 0 ? 255 - s : s)) * 0.125f;
            const float kk = bf2f(*(const LAS bf16_t*)(ksm + s * 144 + dk * 2)) * w;
            const u32x4 v = *(const LAS u32x4*)(vsm + s * 144 + dv8 * 16);
            a[0] += kk * bflo(v.x); a[1] += kk * bfhi(v.x); a[2] += kk * bflo(v.y); a[3] += kk * bfhi(v.y);
            a[4] += kk * bflo(v.z); a[5] += kk * bfhi(v.z); a[6] += kk * bflo(v.w); a[7] += kk * bfhi(v.w);
        }
        float* op = out + ((((size_t)b * 2 + l) * 2 + dir) * 4 + h) * 4096 + dk * 64 + dv8 * 8;
        *(f32x4*)op = (f32x4){a[0], a[1], a[2], a[3]}; *(f32x4*)(op + 4) = (f32x4){a[4], a[5], a[6], a[7]};
    }
    __syncthreads();
}

__device__ __forceinline__ void merge_phase(const Ctx& C0, int l0) { const int l = launder_s(l0); const Ctx C = launder(C0); const float* gbias = INF(33) + l * 4096;
    const bf16_t* YB = (const bf16_t*)((unsigned char*)C.out + 33554432); const bf16_t* BO = (const bf16_t*)(C.ws + WS_W + W_BOUT);
    const unsigned char* GT = (const unsigned char*)(C.ws + WS_AR + A_GT); bf16_t* MG = (bf16_t*)C.out;
    constexpr int AP = 72;
    constexpr int ABYTES = 256 * AP * 2, BBYTES = 128 * AP * 2, SBYTES = ABYTES + BBYTES;
    const int wm = C.wid >> 1, wn = C.wid & 1, n = C.lane & 31, hf = C.lane >> 5;
    for (int tile = C.bid; tile < 512; tile += C.G) {
        int pm = tile >> 3, pn = tile & 7;
        if (C.G == 256) { const int x = C.bid & 7, j = C.bid >> 3; pm = x * 4 + (j >> 3) + 32 * (tile >> 8); pn = j & 7; }
        f32x16 acc[2][2], tot[2][2];
#pragma unroll
        for (int a = 0; a < 2; ++a)
#pragma unroll
            for (int b = 0; b < 2; ++b)
#pragma unroll
                for (int r = 0; r < 16; ++r) { acc[a][b][r] = 0.f; tot[a][b][r] = 0.f; }
        u32x4 ra[4], rb[2];
        auto gload = [&](int it) {
            const int br = it >> 2, kc = it & 3;
#pragma unroll
            for (int j = 0; j < 4; ++j) { const int q = C.tid + NT * j, row = q >> 3, kp = q & 7; ra[j] = *(const u32x4*)(YB + ((size_t)br * M + pm * 256 + row) * 256 + kc * 64 + kp * 8); }
#pragma unroll
            for (int j = 0; j < 2; ++j) { const int q = C.tid + NT * j, col = q >> 3, kp = q & 7; rb[j] = *(const u32x4*)(BO + ((size_t)br * 1024 + pn * 128 + col) * 256 + kc * 64 + kp * 8); }
        };
        auto lstore = [&](int buf) {
            LAS unsigned char* sa = C.ldsL + buf * SBYTES; LAS unsigned char* sbp = sa + ABYTES;
#pragma unroll
            for (int j = 0; j < 4; ++j) { const int q = C.tid + NT * j, row = q >> 3, kp = q & 7; *(LAS u32x4*)(sa + (row * AP + kp * 8) * 2) = ra[j]; }
#pragma unroll
            for (int j = 0; j < 2; ++j) { const int q = C.tid + NT * j, col = q >> 3, kp = q & 7; *(LAS u32x4*)(sbp + (col * AP + kp * 8) * 2) = rb[j]; }
        };
        __syncthreads();
        ((LAS float*)(C.ldsL + 2 * SBYTES))[C.tid] = gbias[(C.tid >> 7) * 1024 + pn * 128 + (C.tid & 127)];
        gload(0); lstore(0);
        __syncthreads();
        for (int it = 0; it < 16; ++it) {
            if (it < 15) gload(it + 1);
            unsigned gwq[2][4];
            if ((it & 3) == 3) {
#pragma unroll
                for (int nt = 0; nt < 2; ++nt)
#pragma unroll
                    for (int g4 = 0; g4 < 4; ++g4)
                        gwq[nt][g4] = *(const unsigned*)(GT + ((size_t)pm * 256 + wm * 64 + n) * 4096 + (it >> 2) * 1024 + pn * 128 + wn * 64 + nt * 32 + 4 * hf + 8 * g4);
            }
            const LAS unsigned char* sa = C.ldsL + (it & 1) * SBYTES; const LAS unsigned char* sbp = sa + ABYTES;
#pragma unroll
            for (int kk = 0; kk < 4; ++kk) {
                bf16x8 af[2], bfr[2];
#pragma unroll
                for (int mt = 0; mt < 2; ++mt) af[mt] = *(const LAS bf16x8*)(sa + ((wm * 64 + mt * 32 + n) * AP + kk * 16 + hf * 8) * 2);
#pragma unroll
                for (int nt = 0; nt < 2; ++nt) bfr[nt] = *(const LAS bf16x8*)(sbp + ((wn * 64 + nt * 32 + n) * AP + kk * 16 + hf * 8) * 2);
#pragma unroll
                for (int mt = 0; mt < 2; ++mt)
#pragma unroll
                    for (int nt = 0; nt < 2; ++nt) acc[mt][nt] = __builtin_amdgcn_mfma_f32_32x32x16_bf16(bfr[nt], af[mt], acc[mt][nt], 0, 0, 0);
            }
            if ((it & 3) == 3) {
                const int br = it >> 2;
#pragma unroll
                for (int mt = 0; mt < 2; ++mt) {
                    const size_t R = (size_t)pm * 256 + wm * 64 + mt * 32 + n;
#pragma unroll
                    for (int nt = 0; nt < 2; ++nt) {
#pragma unroll
                        for (int g4 = 0; g4 < 4; ++g4) { const int gw = mt == 0 ? (int)gwq[nt][g4] : (int)*(const unsigned*)(GT + R * 4096 + br * 1024 + pn * 128 + wn * 64 + nt * 32 + 4 * hf + 8 * g4); const f32x4 gb4 = *(const LAS f32x4*)(C.ldsL + 2 * SBYTES + (br * 128 + wn * 64 + nt * 32 + 4 * hf + 8 * g4) * 4);
                            const float q0 = sigmoidf_(__builtin_amdgcn_cvt_f32_fp8(gw, 0) + gb4[0]), q1 = sigmoidf_(__builtin_amdgcn_cvt_f32_fp8(gw, 1) + gb4[1]), q2 = sigmoidf_(__builtin_amdgcn_cvt_f32_fp8(gw, 2) + gb4[2]), q3 = sigmoidf_(__builtin_amdgcn_cvt_f32_fp8(gw, 3) + gb4[3]);
                            tot[mt][nt][4 * g4] += q0 * acc[mt][nt][4 * g4]; tot[mt][nt][4 * g4 + 1] += q1 * acc[mt][nt][4 * g4 + 1];
                            tot[mt][nt][4 * g4 + 2] += q2 * acc[mt][nt][4 * g4 + 2]; tot[mt][nt][4 * g4 + 3] += q3 * acc[mt][nt][4 * g4 + 3]; }
#pragma unroll
                        for (int r = 0; r < 16; ++r) acc[mt][nt][r] = 0.f;
                    }
                }
            }
            if (it < 15) lstore((it + 1) & 1);
            __syncthreads();
        }
#pragma unroll
        for (int mt = 0; mt < 2; ++mt) {
            const size_t R = (size_t)pm * 256 + wm * 64 + mt * 32 + n;
#pragma unroll
            for (int nt = 0; nt < 2; ++nt) {
                bf16_t* op = MG + R * 1024 + pn * 128 + wn * 64 + nt * 32 + 4 * hf;
#pragma unroll
                for (int g4 = 0; g4 < 4; ++g4) { u32x2 w; w.x = cvt_pk_bf16(tot[mt][nt][4 * g4], tot[mt][nt][4 * g4 + 1]); w.y = cvt_pk_bf16(tot[mt][nt][4 * g4 + 2], tot[mt][nt][4 * g4 + 3]); *(u32x2*)(op + 8 * g4) = w; }
            }
        }
    }
    __syncthreads();
}

#define XB_TMO      128
#define XB_XCNT(j)  (256  + 64 * (j))
#define XB_XSUB(j)  (1280 + 64 * (j))
#define XB_XGEN(j)  (2304 + 64 * (j))
#define XB_TOP      3328
#define XB_TOPGEN   3392
#define XCD_BAR_WORDS 3456
#define XB_SPIN_CAP (1u << 20)
__device__ __forceinline__ unsigned xb_ld(unsigned* p)              { return __hip_atomic_load(p, __ATOMIC_RELAXED, __HIP_MEMORY_SCOPE_AGENT); }
__device__ __forceinline__ unsigned xb_add(unsigned* p, unsigned v) { return __hip_atomic_fetch_add(p, v, __ATOMIC_RELAXED, __HIP_MEMORY_SCOPE_AGENT); }
__device__ __forceinline__ unsigned xb_xcc_id() { return (unsigned)__builtin_amdgcn_s_getreg((3 << 11) | 20) & 0xFu; }
#define XB_SPIN(cond, bar) do { unsigned _sp = 0; while (cond) { __builtin_amdgcn_s_sleep(1); \
    if ((++_sp & 255u) == 0u) { if (xb_ld(&(bar)[XB_TMO])) break; if (_sp > XB_SPIN_CAP) { atomicAdd(&(bar)[XB_TMO], 1u); break; } } } } while (0)
__device__ __forceinline__ void xcd_barrier_complete(unsigned* bar, unsigned x, unsigned G, unsigned& nloc, unsigned& nx) {
    unsigned sum, cnt, mine, sp = 0u;
    for (;;) {
        sum = 0u; cnt = 0u; mine = 0u;
#pragma unroll
        for (unsigned j = 0; j < 16; ++j) { const unsigned c = xb_ld(&bar[XB_XCNT(j)]); sum += c; cnt += (c > 0u) ? 1u : 0u; mine = (j == x) ? c : mine; }
        if (sum == G) break;
        __builtin_amdgcn_s_sleep(1);
        if ((++sp & 255u) == 0u) { if (xb_ld(&bar[XB_TMO])) break; if (sp > XB_SPIN_CAP) { atomicAdd(&bar[XB_TMO], 1u); break; } }
    }
    nloc = mine > 0u ? mine : 1u; nx = cnt > 0u ? cnt : 1u;
}
__device__ __forceinline__ void grid_bar(unsigned* bar, volatile LAS unsigned* st, unsigned G, int wid, int lane) {
    asm volatile("s_waitcnt vmcnt(0)" ::: "memory");
    __syncthreads();
    if (wid == 0 && lane == 0) {
        __builtin_amdgcn_s_waitcnt(0);
        const unsigned x = xb_xcc_id();
        unsigned nloc = st[0], nx = st[1];
        if (nloc == 0u) { xcd_barrier_complete(bar, x, G, nloc, nx); st[0] = nloc; st[1] = nx; }
        const unsigned old = xb_add(&bar[XB_XSUB(x)], 1u);
        const unsigned gen = old / nloc;
        if (old + 1u == (gen + 1u) * nloc) {
            __builtin_amdgcn_fence(__ATOMIC_RELEASE, "agent");
            asm volatile("s_waitcnt vmcnt(0)" ::: "memory");
            const unsigned og = xb_add(&bar[XB_TOP], 1u);
            const unsigned tg = og / nx;
            if (og + 1u == (tg + 1u) * nx) xb_add(&bar[XB_TOPGEN], 1u);
            else XB_SPIN(xb_ld(&bar[XB_TOPGEN]) == tg, bar);
            __builtin_amdgcn_fence(__ATOMIC_ACQUIRE, "agent");
            xb_add(&bar[XB_XGEN(x)], 1u);
            asm volatile("s_waitcnt vmcnt(0)" ::: "memory");
        } else {
            XB_SPIN(xb_ld(&bar[XB_XGEN(x)]) == gen, bar);
            __builtin_amdgcn_fence(__ATOMIC_ACQUIRE, "agent");
            asm volatile("s_waitcnt vmcnt(0)" ::: "memory");
        }
    }
    __syncthreads();
}
__global__ void __launch_bounds__(NT, 2) fwd_megakernel(Params prm) {
    extern __shared__ __attribute__((aligned(16))) unsigned char lds[];
    cg::grid_group grid = cg::this_grid();
    LAS unsigned long long* tabw = (LAS unsigned long long*)((LAS unsigned char*)lds + 131072);
    if (threadIdx.x < 39) tabw[threadIdx.x] = (unsigned long long)prm.in[threadIdx.x];
    __syncthreads();
    Ctx Cm; { Ctx& C = Cm; C.tab = (const LAS unsigned*)tabw; C.out = prm.out; C.ws = prm.ws; C.lds = lds; C.ldsL = (LAS unsigned char*)lds; C.tid = threadIdx.x; C.lane = C.tid & 63; C.wid = __builtin_amdgcn_readfirstlane(C.tid >> 6); C.bid = blockIdx.x; C.G = gridDim.x; }
    const Ctx& C = Cm;
    bf16_t* X = (bf16_t*)(prm.ws + WS_HB);
#define PH_PTRS const Ctx C = launder(Cm); const int lq = launder_s(l); (void)lq; unsigned char* ws = C.ws; asm volatile("" : "+s"(ws)); unsigned char* AR = ws + WS_AR; unsigned char* W = ws + WS_W; (void)AR; (void)W;

    const int lo = prm.ph_lo, hi = prm.ph_hi;
    int ph = 0;
    unsigned* barw = (unsigned*)(prm.ws + WS_BAR);
#define GSYNC() do { const Ctx Cb = launder(C); grid_bar(barw, (volatile LAS unsigned*)((LAS unsigned char*)lds + 131072 + 384), (unsigned)Cb.G, Cb.wid, Cb.lane); } while (0)
#define PH_BEGIN if (ph >= lo && ph < hi) { for (int rep_ = 0; rep_ < 1 + (int)((DUP_MASK >> ph) & 1u); ++rep_) { if (rep_) __syncthreads();
#define PH_END } } if (ph >= lo && ph + 1 < hi) { GSYNC(); if (ph == 0) for (int xb_ = 0; xb_ < EXTRA_BAR; ++xb_) GSYNC(); } ++ph;
    if (hi - lo > 1) {
        if (threadIdx.x < 2) ((LAS unsigned*)((LAS unsigned char*)lds + 131072 + 384))[threadIdx.x] = 0u;
        if (blockIdx.x == 0) for (int i = threadIdx.x; i < XCD_BAR_WORDS; i += NT) __hip_atomic_store(barw + i, 0u, __ATOMIC_RELAXED, __HIP_MEMORY_SCOPE_AGENT);
        asm volatile("s_waitcnt vmcnt(0)" ::: "memory"); __builtin_amdgcn_fence(__ATOMIC_RELEASE, "agent"); asm volatile("s_waitcnt vmcnt(0)" ::: "memory");
        grid.sync();
        __builtin_amdgcn_fence(__ATOMIC_ACQUIRE, "agent"); asm volatile("s_waitcnt vmcnt(0)" ::: "memory");
        if (threadIdx.x == 0) (void)xb_add(&barw[XB_XCNT(xb_xcc_id())], 1u);
        __syncthreads();
    }
    PH_BEGIN p0_mod(C); p0_filters(C); p0_misc(C); PH_END
    for (int l = 0; l < 2; ++l) {
        PH_BEGIN
        norm_phase(C, l, 0);
        convert_weights(C, l);
        if (l == 0) build_rg(C);
        PH_END
        PH_BEGIN
        { PH_PTRS pg8::Gemm g{(const bf16_t*)C.out, (const bf16_t*)(W + W_PROJ), M, 2816, 1024}; pg8::StaticOrder S; S.init(M, 2816, C.G, C.bid);
          pg8::EpiProj E{(bf16_t*)(AR + A_UHY), (bf16_t*)(AR + A_UMLA), (bf16_t*)(AR + A_URET), (bf16_t*)(AR + A_UCONF)};
          pg8::gemm_phase<pg8::EpiProj>(C.ldsL, g, S, E, C.wid); }
        PH_END
        PH_BEGIN prep_phase(C, l); PH_END
        PH_BEGIN
        { PH_PTRS pg8::Gemm g{(const bf16_t*)(AR + A_CQN), (const bf16_t*)(W + W_UQ), M, 512, 256}; pg8::StaticOrder S; S.init(M, 512, C.G, C.bid);
          pg8::EpiPlain E{(bf16_t*)(AR + A_Q), 384, 384};
          pg8::gemm_phase<pg8::EpiPlain>(C.ldsL, g, S, E, C.wid); }
        { PH_PTRS pg8::Gemm g{(const bf16_t*)(AR + A_CKN), (const bf16_t*)(W + W_UK), NKEY, 256, 256}; pg8::StaticOrder S; S.init(NKEY, 256, C.G, (C.bid + C.G - 128) % C.G);
          pg8::EpiPlain E{(bf16_t*)(AR + A_KN), 256, 256};
          pg8::gemm_phase<pg8::EpiPlain>(C.ldsL, g, S, E, C.wid); }
        { PH_PTRS pg8::Gemm g{(const bf16_t*)(W + W_UV), (const bf16_t*)(AR + A_CKN), 256, NKEY, 256}; pg8::StaticOrder S; S.init(256, NKEY, C.G, (C.bid + C.G - 196) % C.G);
          pg8::EpiPlain E{(bf16_t*)(AR + A_VT), NKEY, NKEY};
          pg8::gemm_phase<pg8::EpiPlain>(C.ldsL, g, S, E, C.wid); }
        hyena_phase(C, l);
        PH_END
        PH_BEGIN
        { const Ctx Ca = launder(C);
          for (int p0_ = Ca.bid; p0_ < 256; p0_ += Ca.G) {
              const int p = (Ca.G == 256) ? ((p0_ & 7) * 32 + (p0_ >> 3)) : p0_;
              const int q = p & 127; const bool first = p < 128;
              att_block<false>(C, l, first, first ? (q >> 5) : (q >> 2), first ? ((q >> 3) & 3) : (q & 3), first ? (q & 7) : 0);
              att_block<true>(C, l, !first, first ? (q >> 2) : (q >> 5), first ? (q & 3) : ((q >> 3) & 3), first ? 0 : (q & 7));
          }
          ret_state(C, l); }
        PH_END
        PH_BEGIN
        { PH_PTRS pg8::Gemm g{(const bf16_t*)C.out, (const bf16_t*)(W + W_GATE), M, 4096, 1024}; pg8::StaticOrder S; S.init(M, 4096, C.G, C.bid);
          pg8::EpiGate E{(unsigned char*)(AR + A_GT), 4096};
          pg8::gemm_phase<pg8::EpiGate>(C.ldsL, g, S, E, C.wid); }
        PH_END
        PH_BEGIN merge_phase(C, l); PH_END
        PH_BEGIN
        { PH_PTRS pg8::Gemm g{(const bf16_t*)C.out, (const bf16_t*)(W + W_O), M, 1024, 1024}; pg8::StaticOrder S; S.init(M, 1024, C.G, C.bid);
          pg8::EpiResid E{X, (const float*)(ws + WS_MOD) + (size_t)lq * 5 * 6144 + 2048};
          pg8::gemm_phase<pg8::EpiResid>(C.ldsL, g, S, E, C.wid); }
        PH_END
        PH_BEGIN norm_phase(C, l, 1); PH_END
        PH_BEGIN
        { PH_PTRS pg8::Gemm g{(const bf16_t*)C.out, (const bf16_t*)(W + W_1), M, 5632, 1024}; pg8::StaticOrder S; S.init(M, 5632, C.G, C.bid);
          pg8::EpiFfn1 E{(bf16_t*)(AR + A_ACT)};
          pg8::gemm_phase<pg8::EpiFfn1>(C.ldsL, g, S, E, C.wid); }
        PH_END
        PH_BEGIN
        { PH_PTRS pg8::Gemm g{(const bf16_t*)(AR + A_ACT), (const bf16_t*)(W + W_2), M, 1024, 2816}; pg8::StaticOrder S; S.init(M, 1024, C.G, C.bid);
          pg8::EpiResid E{X, (const float*)(ws + WS_MOD) + (size_t)lq * 5 * 6144 + 5120};
          pg8::gemm_phase<pg8::EpiResid>(C.ldsL, g, S, E, C.wid); }
        PH_END
    }
    PH_BEGIN final_norm(C); PH_END
}

extern "C" void kernel_launch(void* const* d_in, const int* in_sizes, int n_in, void* d_out, int out_size, void* d_ws, size_t ws_size, hipStream_t stream) {
    static int grid = 0;
    if (grid == 0) {
        if (n_in != 39 || ws_size < WS_NEED) { fprintf(stderr, "kernel_launch: unexpected n_in %d / ws_size %zu (need %zu)\n", n_in, ws_size, (size_t)WS_NEED); grid = -1; return; }
        int dev = 0, cus = 0, per_cu = 0;
        hipGetDevice(&dev);
        hipDeviceGetAttribute(&cus, hipDeviceAttributeMultiprocessorCount, dev);
        if (hipFuncSetAttribute((const void*)fwd_megakernel, hipFuncAttributeMaxDynamicSharedMemorySize, LDS_BYTES) != hipSuccess) { fprintf(stderr, "kernel_launch: hipFuncSetAttribute failed\n"); grid = -1; return; }
        if (hipOccupancyMaxActiveBlocksPerMultiprocessor(&per_cu, (const void*)fwd_megakernel, NT, LDS_BYTES) != hipSuccess || per_cu < 1) { fprintf(stderr, "kernel_launch: occupancy query gives %d\n", per_cu); per_cu = 1; }
        (void)hipGetLastError();
        grid = cus;
    }
    if (grid < 0) return;
    Params p{};
    for (int i = 0; i < 39; ++i) p.in[i] = (const float*)d_in[i];
    p.out = (float*)d_out; p.ws = (unsigned char*)d_ws;
    if (hipMemsetAsync((unsigned char*)d_ws + WS_BAR, 0, 16384, stream) != hipSuccess) { fprintf(stderr, "memset failed\n"); return; }
#if MK_PER_PHASE
    for (int k = 0; k < 24; ++k) { p.ph_lo = k; p.ph_hi = k + 1; hipLaunchKernelGGL(fwd_megakernel, dim3(grid), dim3(NT), LDS_BYTES, stream, p); }
#else
    p.ph_lo = 0; p.ph_hi = 24;
    void* args[] = {&p};
    hipError_t e = hipLaunchCooperativeKernel((const void*)fwd_megakernel, dim3(grid), dim3(NT), args, LDS_BYTES, stream);
    if (e != hipSuccess) fprintf(stderr, "cooperative launch failed: %s (grid %d)\n", hipGetErrorString(e), grid);
#endif
}
```
